# Optimizing an MI355X kernel written in HIP

```python
import math
import jax, jax.numpy as jnp
from jax import lax
import numpy as np

D_MODEL = 2048
BATCH = 2
SEQ = 16384
DEPTH = 1

CONV_WIDTH = 1024
CONV_TAPS = 3
ATT_HEADS = 4
ATT_HEAD_DIM = 128
ATT_WIDTH = ATT_HEADS * 2 * ATT_HEAD_DIM
IN_WIDTH = 3 * CONV_WIDTH + 3 * ATT_WIDTH
IN_SPLITS = [CONV_WIDTH, 2 * CONV_WIDTH, 3 * CONV_WIDTH,
             3 * CONV_WIDTH + ATT_WIDTH, 3 * CONV_WIDTH + 2 * ATT_WIDTH]
N_BRANCHES = 2
D_FF = 5632
PLE_DIM = 256
N_BUCKETS = 32
MAX_DISTANCE = 128
Q_BLOCK = 128
EPS = 1e-6

kernel_name = 'hybrid_conv_diffattn_macaron_encoder'


def rms_norm(x, g):
    xf = x.astype(jnp.float32)
    y = xf * lax.rsqrt(jnp.mean(xf * xf, axis=-1, keepdims=True) + EPS)
    return (y * g.astype(jnp.float32)).astype(x.dtype)


def swiglu(x, w1, w3, w2):
    return (jax.nn.silu(x @ w1) * (x @ w3)) @ w2


def short_conv(z, w):
    zp = jnp.pad(z, ((0, 0), (1, 1), (0, 0)))
    return zp[:, :-2] * w[0] + zp[:, 1:-1] * w[1] + zp[:, 2:] * w[2]


def t5_bucket(rel):
    nb = N_BUCKETS // 2
    max_exact = nb // 2
    ret = jnp.where(rel > 0, nb, 0).astype(jnp.int32)
    n = jnp.abs(rel)
    nf = jnp.maximum(n, 1).astype(jnp.float32)
    large = max_exact + (jnp.log(nf / max_exact) / math.log(MAX_DISTANCE / max_exact)
                         * (nb - max_exact)).astype(jnp.int32)
    large = jnp.minimum(large, nb - 1)
    return ret + jnp.where(n < max_exact, n, large)


def diff_attention(q, k, v, lam, rel_bias):
    B, S = q.shape[0], q.shape[1]
    nblk = S // Q_BLOCK
    q_blocks = q.reshape(B, nblk, Q_BLOCK, ATT_HEADS, 2, ATT_HEAD_DIM).swapaxes(0, 1)
    k_pos = jnp.arange(S, dtype=jnp.int32)
    bias_table = rel_bias.T.astype(jnp.float32)
    scale = ATT_HEAD_DIM ** -0.5

    def block(args):
        q_blk, i = args
        q_pos = i * Q_BLOCK + jnp.arange(Q_BLOCK, dtype=jnp.int32)
        bias = bias_table[:, t5_bucket(k_pos[None, :] - q_pos[:, None])]
        logits = jnp.einsum('bqhcd,bkhcd->bchqk', q_blk, k).astype(jnp.float32) * scale + bias
        probs = jax.nn.softmax(logits, axis=-1)
        w = probs[:, 0] - lam.astype(jnp.float32) * probs[:, 1]
        return jnp.einsum('bhqk,bkhe->bqhe', w.astype(v.dtype), v)

    out = lax.map(block, (q_blocks, jnp.arange(nblk, dtype=jnp.int32)))
    return out.swapaxes(0, 1).reshape(B, S, ATT_HEADS, 2 * ATT_HEAD_DIM)


def setup_inputs(seed: int = 0) -> dict:
    key = jax.random.key(seed)
    ks = iter(jax.random.split(key, 32))

    def lin(fan_in, fan_out):
        return jax.random.normal(next(ks), (DEPTH, fan_in, fan_out), jnp.float32) * fan_in ** -0.5

    def gain(dim):
        return 1.0 + 0.02 * jax.random.normal(next(ks), (DEPTH, dim), jnp.float32)

    def small(shape, s):
        return s * jax.random.normal(next(ks), shape, jnp.float32)

    return {
        'x': jax.random.normal(next(ks), (BATCH, SEQ, D_MODEL), jnp.float32),
        'p': jax.random.normal(next(ks), (DEPTH, BATCH, SEQ, PLE_DIM), jnp.float32),
        'ffn1_norm': gain(D_MODEL),
        'ffn1_w1': lin(D_MODEL, D_FF),
        'ffn1_w3': lin(D_MODEL, D_FF),
        'ffn1_w2': lin(D_FF, D_MODEL),
        'mix_norm': gain(D_MODEL),
        'w_in': lin(D_MODEL, IN_WIDTH),
        'conv_w': small((DEPTH, CONV_TAPS, CONV_WIDTH), CONV_TAPS ** -0.5),
        'q_norm': gain(ATT_HEAD_DIM),
        'k_norm': gain(ATT_HEAD_DIM),
        'lam_q1': small((DEPTH, ATT_HEAD_DIM), 0.1),
        'lam_k1': small((DEPTH, ATT_HEAD_DIM), 0.1),
        'lam_q2': small((DEPTH, ATT_HEAD_DIM), 0.1),
        'lam_k2': small((DEPTH, ATT_HEAD_DIM), 0.1),
        'sub_norm': gain(2 * ATT_HEAD_DIM),
        'rel_bias': small((N_BUCKETS, ATT_HEADS), 0.5),
        'w_branch_a': lin(CONV_WIDTH, D_MODEL),
        'w_branch_b': lin(ATT_WIDTH, D_MODEL),
        'w_gate': lin(D_MODEL, N_BRANCHES * D_MODEL),
        'w_out': lin(D_MODEL, D_MODEL),
        'ffn2_norm': gain(D_MODEL),
        'ffn2_w1': lin(D_MODEL, D_FF),
        'ffn2_w3': lin(D_MODEL, D_FF),
        'ffn2_w2': lin(D_FF, D_MODEL),
        'ple_norm': gain(D_MODEL),
        'w_ple_gate': lin(D_MODEL, D_MODEL),
        'w_ple_proj': lin(PLE_DIM, D_MODEL),
    }


def reference(x, p, ffn1_norm, ffn1_w1, ffn1_w3, ffn1_w2, mix_norm, w_in, conv_w,
              q_norm, k_norm, lam_q1, lam_k1, lam_q2, lam_k2, sub_norm, rel_bias,
              w_branch_a, w_branch_b, w_gate, w_out, ffn2_norm, ffn2_w1, ffn2_w3, ffn2_w2,
              ple_norm, w_ple_gate, w_ple_proj):
    B, S = x.shape[0], x.shape[1]
    h = x
    for l in range(DEPTH):
        h = h + 0.5 * swiglu(rms_norm(h, ffn1_norm[l]), ffn1_w1[l], ffn1_w3[l], ffn1_w2[l])

        u = rms_norm(h, mix_norm[l])
        a_in, c_gate, b_gate, q, k, v = jnp.split(u @ w_in[l], IN_SPLITS, axis=-1)

        y_a = (b_gate * short_conv(c_gate * a_in, conv_w[l])) @ w_branch_a[l]

        q = rms_norm(q.reshape(B, S, ATT_HEADS, 2, ATT_HEAD_DIM), q_norm[l])
        k = rms_norm(k.reshape(B, S, ATT_HEADS, 2, ATT_HEAD_DIM), k_norm[l])
        v = v.reshape(B, S, ATT_HEADS, 2 * ATT_HEAD_DIM)
        lam_init = 0.8 - 0.6 * math.exp(-0.3 * l)
        lam = (jnp.exp(jnp.sum(lam_q1[l] * lam_k1[l])) - jnp.exp(jnp.sum(lam_q2[l] * lam_k2[l]))
               + lam_init)
        o = diff_attention(q, k, v, lam, rel_bias)
        o = rms_norm(o, sub_norm[l]) * (1.0 - lam_init)
        y_b = o.reshape(B, S, ATT_WIDTH) @ w_branch_b[l]

        g_a, g_b = jnp.split(jax.nn.sigmoid(u @ w_gate[l]), N_BRANCHES, axis=-1)
        h = h + (g_a * y_a + g_b * y_b) @ w_out[l]

        h = h + 0.5 * swiglu(rms_norm(h, ffn2_norm[l]), ffn2_w1[l], ffn2_w3[l], ffn2_w2[l])

        gate = jax.nn.sigmoid(rms_norm(h, ple_norm[l]) @ w_ple_gate[l])
        h = h + gate * (p[l] @ w_ple_proj[l])
    return h
```

```cpp
#include <hip/hip_runtime.h>
#include <hip/hip_cooperative_groups.h>
#include <cstdio>
#include <cstdint>
namespace cg = cooperative_groups;

#define LAS __attribute__((address_space(3)))
typedef unsigned short bf16_t;
typedef short bf16x8 __attribute__((ext_vector_type(8)));
typedef short s16x4 __attribute__((ext_vector_type(4)));
typedef float f32x2 __attribute__((ext_vector_type(2)));
typedef float f32x4 __attribute__((ext_vector_type(4)));
typedef float f32x16 __attribute__((ext_vector_type(16)));
typedef unsigned u32x2 __attribute__((ext_vector_type(2)));
typedef unsigned u32x4 __attribute__((ext_vector_type(4)));

constexpr int DM = 2048, NB = 2, SEQ = 16384, T = NB * SEQ, FF = 5632, CW = 1024, AW = 1024, INW = 6144, PLE = 256, NH = 4;
constexpr float EPS = 1e-6f;
constexpr int LDS_XB = 2 * 16384 + 3 * 32768 + 2048 + 768 * 4;
constexpr int LDS_BYTES = LDS_XB + 16;

constexpr size_t SZ_W13 = (size_t)2 * FF * DM * 2, SZ_W2 = (size_t)DM * FF * 2;
constexpr size_t WS_W13_1 = 0, WS_W2_1 = WS_W13_1 + SZ_W13, WS_W13_2 = WS_W2_1 + SZ_W2, WS_W2_2 = WS_W13_2 + SZ_W13;
constexpr size_t WS_WIG = WS_W2_2 + SZ_W2;
constexpr size_t WS_WA = WS_WIG + (size_t)(INW + 2 * DM) * DM * 2;
constexpr size_t WS_WB = WS_WA + (size_t)DM * CW * 2;
constexpr size_t WS_WO = WS_WB + (size_t)DM * AW * 2;
constexpr size_t WS_WPG = WS_WO + (size_t)DM * DM * 2;
constexpr size_t WS_WPP = WS_WPG + (size_t)DM * DM * 2;
constexpr size_t WS_A = WS_WPP + (size_t)DM * PLE * 2;
constexpr size_t WS_BIG = WS_A + (size_t)T * DM * 2;
constexpr size_t WS_PROJ = WS_BIG;
constexpr size_t WS_GATES = WS_PROJ + (size_t)T * INW * 2;
constexpr size_t WS_G = WS_BIG;
constexpr size_t WS_PP = WS_GATES + (size_t)T * DM * 2;
constexpr size_t WS_RB = WS_GATES;
constexpr size_t WS_P16 = WS_GATES + (size_t)T * 2 * DM * 2;
constexpr size_t WS_RSS = WS_P16 + (size_t)T * PLE * 2;
constexpr size_t WS_XBAR = WS_RSS + (size_t)3 * T * 4;
constexpr size_t WS_END = WS_XBAR + 16384;

struct Params { const float* in[28]; float* out; unsigned char* ws; int ph_lo, ph_hi; };

__device__ __forceinline__ unsigned cvt_pk_bf16(float lo, float hi) { unsigned r; asm volatile("v_cvt_pk_bf16_f32 %0, %1, %2" : "=v"(r) : "v"(lo), "v"(hi)); return r; }
__device__ __forceinline__ float bf_lo(unsigned w) { return __uint_as_float(w << 16); }
__device__ __forceinline__ float bf_hi(unsigned w) { return __uint_as_float(w & 0xffff0000u); }
__device__ __forceinline__ float sigmoidf_(float x) { return __builtin_amdgcn_rcpf(1.0f + __expf(-x)); }
__device__ __forceinline__ void unpack8(const u32x4 w, float* f) { f[0] = bf_lo(w.x); f[1] = bf_hi(w.x); f[2] = bf_lo(w.y); f[3] = bf_hi(w.y); f[4] = bf_lo(w.z); f[5] = bf_hi(w.z); f[6] = bf_lo(w.w); f[7] = bf_hi(w.w); }
__device__ __forceinline__ float wave_sum(float s) {
    s += __shfl_xor(s, 32); s += __shfl_xor(s, 16); s += __shfl_xor(s, 8); s += __shfl_xor(s, 4); s += __shfl_xor(s, 2); s += __shfl_xor(s, 1); return s; }

namespace pg8 {
constexpr int BM = 256, BK = 64, HALF = 128, HTB = HALF * BK * 2, STAGE_BYTES = 8 * HTB, NXCD = 8, WGM = 8;
__device__ __forceinline__ int lds_byte(int r, int c) { const int st = (r >> 4) * 2 + (c >> 5), rr = r & 15, cc = c & 31, ob = rr * 64 + cc * 2; return st * 1024 + (ob ^ (((ob >> 9) & 1) << 5)); }
__device__ __forceinline__ void stage_rc(int b, int& R, int& C) { const int st = b / 1024, sb = b % 1024, swz = sb ^ (((sb >> 9) & 1) << 5); R = (st >> 1) * 16 + swz / 64; C = (st & 1) * 32 + (swz % 64) / 2; }
__device__ __forceinline__ int perm32(int rho) { const int n = rho >> 4, i = rho & 15; return 8 * (i >> 2) + 4 * n + (i & 3); }

struct Unit { int pm, pn; };
struct Gemm { const bf16_t* A; const bf16_t* Bt; int M, N, K, lda; };

struct StaticOrder {
    int nM, nN, nwg, G, c, wgm;
    __device__ void init(int M, int N, int G_, int c_) { nM = M / BM; nN = N / BM; nwg = nM * nN; G = G_; c = c_; wgm = nN <= 8 ? 4 : WGM; }
    __device__ bool next(int i, Unit& u) const {
        const long L = (long)i * G + c; if (L >= nwg) return false;
        int wgid = (int)L; { const int q = nwg / NXCD, r = nwg % NXCD, xcd = wgid % NXCD, off = wgid / NXCD; wgid = (xcd < r ? xcd * (q + 1) : r * (q + 1) + (xcd - r) * q) + off; }
        const int nig = wgm * nN, gid = wgid / nig, fm = gid * wgm, gsz = (nM - fm) < wgm ? (nM - fm) : wgm;
        u.pm = fm + ((wgid % nig) % gsz); u.pn = (wgid % nig) / gsz; return true;
    }
};

typedef f32x4 Acc[2][2][4][2];

struct EpiSwiGLU {
    static constexpr bool PERM = true;
    bf16_t* O; int ldc; const float* rss;
    __device__ __forceinline__ void operator()(const Acc& acc, const Unit& u, int wr, int wc, int fr, int fq) const {
        const int row0 = u.pm * BM + wr * 64 + fr, col0 = u.pn * HALF + wc * 32 + 8 * fq;
        float rsv[2][4];
#pragma unroll
        for (int ai = 0; ai < 2; ++ai)
#pragma unroll
            for (int m = 0; m < 4; ++m) rsv[ai][m] = rss ? rss[row0 + ai * HALF + m * 16] : 0.f;
#pragma unroll
        for (int ai = 0; ai < 2; ++ai)
#pragma unroll
            for (int m = 0; m < 4; ++m) {
                const int row = row0 + ai * HALF + m * 16;
                const float rs = rss ? rsqrtf(rsv[ai][m] * (1.0f / DM) + EPS) : 1.0f;
                bf16_t* rowp = O + (size_t)row * ldc + col0;
                float v[8];
#pragma unroll
                for (int n = 0; n < 2; ++n)
#pragma unroll
                    for (int j = 0; j < 4; ++j) { const float g = acc[ai][0][m][n][j] * rs, up = acc[ai][1][m][n][j] * rs; v[n * 4 + j] = g * sigmoidf_(g) * up; }
                u32x4 w; w.x = cvt_pk_bf16(v[0], v[1]); w.y = cvt_pk_bf16(v[2], v[3]); w.z = cvt_pk_bf16(v[4], v[5]); w.w = cvt_pk_bf16(v[6], v[7]);
                *(u32x4*)rowp = w;
            }
    }
};
template <bool BASE_BF16> struct EpiRes {
    static constexpr bool PERM = true;
    const void* base; int ldc; float alpha; bf16_t* obf; float* rss;
    __device__ __forceinline__ void operator()(const Acc& acc, const Unit& u, int wr, int wc, int fr, int fq) const {
        const int row0 = u.pm * BM + wr * 64 + fr, col0 = u.pn * BM + wc * 32 + 8 * fq;
#pragma unroll
        for (int ai = 0; ai < 2; ++ai) {
            u32x4 wb[4][2]; f32x4 fb0[4][2], fb1[4][2];
#pragma unroll
            for (int m = 0; m < 4; ++m) { const size_t off = (size_t)(row0 + ai * HALF + m * 16) * ldc + col0;
#pragma unroll
                for (int bj = 0; bj < 2; ++bj) {
                    if (BASE_BF16) wb[m][bj] = *(const u32x4*)((const bf16_t*)base + off + bj * HALF);
                    else { fb0[m][bj] = *(const f32x4*)((const float*)base + off + bj * HALF); fb1[m][bj] = *(const f32x4*)((const float*)base + off + bj * HALF + 4); } } }
#pragma unroll
            for (int m = 0; m < 4; ++m) { const int row = row0 + ai * HALF + m * 16; const size_t off = (size_t)row * ldc + col0; float ss = 0.f;
#pragma unroll
                for (int bj = 0; bj < 2; ++bj) {
                    f32x4 b0, b1;
                    if (BASE_BF16) { const u32x4 w = wb[m][bj]; b0 = (f32x4){bf_lo(w.x), bf_hi(w.x), bf_lo(w.y), bf_hi(w.y)}; b1 = (f32x4){bf_lo(w.z), bf_hi(w.z), bf_lo(w.w), bf_hi(w.w)}; }
                    else { b0 = fb0[m][bj]; b1 = fb1[m][bj]; }
                    const f32x4 r0 = b0 + alpha * acc[ai][bj][m][0], r1 = b1 + alpha * acc[ai][bj][m][1];
                    ss += ((r0[0] * r0[0] + r0[1] * r0[1]) + (r0[2] * r0[2] + r0[3] * r0[3])) + ((r1[0] * r1[0] + r1[1] * r1[1]) + (r1[2] * r1[2] + r1[3] * r1[3]));
                    u32x4 w; w.x = cvt_pk_bf16(r0[0], r0[1]); w.y = cvt_pk_bf16(r0[2], r0[3]); w.z = cvt_pk_bf16(r1[0], r1[1]); w.w = cvt_pk_bf16(r1[2], r1[3]);
                    *(u32x4*)(obf + off + bj * HALF) = w; }
                ss += __shfl_xor(ss, 16); ss += __shfl_xor(ss, 32);
                if (fq == 0) atomicAdd(rss + row, ss); }
            asm volatile("" ::: "memory"); }
    }
};
struct EpiProjGate {
    static constexpr bool PERM = true;
    bf16_t* O0; int ld0; bf16_t* O1; int ld1; int nsplit; const float* rss;
    __device__ __forceinline__ void operator()(const Acc& acc, const Unit& u, int wr, int wc, int fr, int fq) const {
        const bool gate = u.pn >= nsplit;
        bf16_t* base = gate ? O1 : O0; const int ldc = gate ? ld1 : ld0;
        const int row0 = u.pm * BM + wr * 64 + fr, col0 = (gate ? u.pn - nsplit : u.pn) * BM + wc * 32 + 8 * fq;
        float rsv[2][4];
#pragma unroll
        for (int ai = 0; ai < 2; ++ai)
#pragma unroll
            for (int m = 0; m < 4; ++m) rsv[ai][m] = rss[row0 + ai * HALF + m * 16];
#pragma unroll
        for (int ai = 0; ai < 2; ++ai)
#pragma unroll
            for (int m = 0; m < 4; ++m) { const int row = row0 + ai * HALF + m * 16; bf16_t* rowp = base + (size_t)row * ldc + col0;
                const float rs = rsqrtf(rsv[ai][m] * (1.0f / DM) + EPS);
                if (u.pn < 8) {
                    const float rs2 = rs * rs; const f32x4 z0 = acc[ai][0][m][0] * acc[ai][1][m][0] * rs2, z1 = acc[ai][0][m][1] * acc[ai][1][m][1] * rs2;
                    u32x4 w; w.x = cvt_pk_bf16(z0[0], z0[1]); w.y = cvt_pk_bf16(z0[2], z0[3]); w.z = cvt_pk_bf16(z1[0], z1[1]); w.w = cvt_pk_bf16(z1[2], z1[3]);
                    *(u32x4*)(O0 + (size_t)row * ld0 + u.pn * HALF + wc * 32 + 8 * fq) = w;
                    continue; }
#pragma unroll
                for (int bj = 0; bj < 2; ++bj) { f32x4 v0 = acc[ai][bj][m][0] * rs, v1 = acc[ai][bj][m][1] * rs;
                    if (gate) {
                        unsigned q[8];
#pragma unroll
                        for (int j = 0; j < 4; ++j) { q[j] = (unsigned)(sigmoidf_(v0[j]) * 255.0f + 0.5f); q[4 + j] = (unsigned)(sigmoidf_(v1[j]) * 255.0f + 0.5f); }
                        u32x2 w8; w8.x = q[0] | (q[1] << 8) | (q[2] << 16) | (q[3] << 24); w8.y = q[4] | (q[5] << 8) | (q[6] << 16) | (q[7] << 24);
                        *(u32x2*)((unsigned char*)O1 + (size_t)row * ld1 + col0 + bj * HALF) = w8;
                        continue; }
                    u32x4 w; w.x = cvt_pk_bf16(v0[0], v0[1]); w.y = cvt_pk_bf16(v0[2], v0[3]); w.z = cvt_pk_bf16(v1[0], v1[1]); w.w = cvt_pk_bf16(v1[2], v1[3]);
                    *(u32x4*)(rowp + bj * HALF) = w; } }
    }
};
template <bool ADD> struct EpiGated {
    static constexpr bool PERM = true;
    bf16_t* O; int ldc; const unsigned char* gate; int ldg; int goff;
    __device__ __forceinline__ void operator()(const Acc& acc, const Unit& u, int wr, int wc, int fr, int fq) const {
        const int row0 = u.pm * BM + wr * 64 + fr, col0 = u.pn * BM + wc * 32 + 8 * fq;
#pragma unroll
        for (int ai = 0; ai < 2; ++ai) {
            u32x2 g[4][2]; u32x4 pv[4][2];
#pragma unroll
            for (int m = 0; m < 4; ++m) { const size_t r = (size_t)(row0 + ai * HALF + m * 16);
#pragma unroll
                for (int bj = 0; bj < 2; ++bj) { g[m][bj] = *(const u32x2*)(gate + r * ldg + goff + col0 + bj * HALF); if (ADD) pv[m][bj] = *(const u32x4*)(O + r * ldc + col0 + bj * HALF); } }
#pragma unroll
            for (int m = 0; m < 4; ++m) { const size_t r = (size_t)(row0 + ai * HALF + m * 16);
#pragma unroll
                for (int bj = 0; bj < 2; ++bj) { const f32x4 v0 = acc[ai][bj][m][0] * (1.0f / 255.0f), v1 = acc[ai][bj][m][1] * (1.0f / 255.0f); const u32x2 gg = g[m][bj];
                    float o[8] = {(float)(gg.x & 0xffu) * v0[0], (float)((gg.x >> 8) & 0xffu) * v0[1], (float)((gg.x >> 16) & 0xffu) * v0[2], (float)(gg.x >> 24) * v0[3],
                                  (float)(gg.y & 0xffu) * v1[0], (float)((gg.y >> 8) & 0xffu) * v1[1], (float)((gg.y >> 16) & 0xffu) * v1[2], (float)(gg.y >> 24) * v1[3]};
                    if (ADD) { const u32x4 p = pv[m][bj];
                        o[0] += bf_lo(p.x); o[1] += bf_hi(p.x); o[2] += bf_lo(p.y); o[3] += bf_hi(p.y); o[4] += bf_lo(p.z); o[5] += bf_hi(p.z); o[6] += bf_lo(p.w); o[7] += bf_hi(p.w); }
                    u32x4 w; w.x = cvt_pk_bf16(o[0], o[1]); w.y = cvt_pk_bf16(o[2], o[3]); w.z = cvt_pk_bf16(o[4], o[5]); w.w = cvt_pk_bf16(o[6], o[7]);
                    *(u32x4*)(O + r * ldc + col0 + bj * HALF) = w; } }
            asm volatile("" ::: "memory"); }
    }
};
struct EpiBf16NP {
    static constexpr bool PERM = true;
    bf16_t* O; int ldc;
    __device__ __forceinline__ void operator()(const Acc& acc, const Unit& u, int wr, int wc, int fr, int fq) const {
        const int row0 = u.pm * BM + wr * 64 + fr, col0 = u.pn * BM + wc * 32 + 8 * fq;
#pragma unroll
        for (int ai = 0; ai < 2; ++ai)
#pragma unroll
            for (int m = 0; m < 4; ++m) { const size_t off = (size_t)(row0 + ai * HALF + m * 16) * ldc + col0;
#pragma unroll
                for (int bj = 0; bj < 2; ++bj) { const f32x4 v0 = acc[ai][bj][m][0], v1 = acc[ai][bj][m][1];
                    u32x4 w; w.x = cvt_pk_bf16(v0[0], v0[1]); w.y = cvt_pk_bf16(v0[2], v0[3]); w.z = cvt_pk_bf16(v1[0], v1[1]); w.w = cvt_pk_bf16(v1[2], v1[3]);
                    *(u32x4*)(O + off + bj * HALF) = w; } }
    }
};
struct EpiFinal {
    static constexpr bool PERM = true;
    const bf16_t* base; float* out; int ldc; const bf16_t* pp; const float* rss;
    __device__ __forceinline__ void operator()(const Acc& acc, const Unit& u, int wr, int wc, int fr, int fq) const {
        const int row0 = u.pm * BM + wr * 64 + fr, col0 = u.pn * BM + wc * 32 + 8 * fq;
        float rsv[2][4];
#pragma unroll
        for (int ai = 0; ai < 2; ++ai)
#pragma unroll
            for (int m = 0; m < 4; ++m) rsv[ai][m] = rss[row0 + ai * HALF + m * 16];
#pragma unroll
        for (int ai = 0; ai < 2; ++ai) {
            u32x4 bs[4][2], pw[4][2];
#pragma unroll
            for (int m = 0; m < 4; ++m) { const size_t off = (size_t)(row0 + ai * HALF + m * 16) * ldc + col0;
#pragma unroll
                for (int bj = 0; bj < 2; ++bj) { bs[m][bj] = *(const u32x4*)(base + off + bj * HALF); pw[m][bj] = *(const u32x4*)(pp + off + bj * HALF); } }
#pragma unroll
            for (int m = 0; m < 4; ++m) { const int row = row0 + ai * HALF + m * 16; const size_t off = (size_t)row * ldc + col0; const float rs = rsqrtf(rsv[ai][m] * (1.0f / DM) + EPS);
#pragma unroll
                for (int bj = 0; bj < 2; ++bj) { const u32x4 bw = bs[m][bj], q = pw[m][bj]; const f32x4 a0 = acc[ai][bj][m][0] * rs, a1 = acc[ai][bj][m][1] * rs;
                    f32x4 r0, r1;
                    r0[0] = bf_lo(bw.x) + sigmoidf_(a0[0]) * bf_lo(q.x); r0[1] = bf_hi(bw.x) + sigmoidf_(a0[1]) * bf_hi(q.x); r0[2] = bf_lo(bw.y) + sigmoidf_(a0[2]) * bf_lo(q.y); r0[3] = bf_hi(bw.y) + sigmoidf_(a0[3]) * bf_hi(q.y);
                    r1[0] = bf_lo(bw.z) + sigmoidf_(a1[0]) * bf_lo(q.z); r1[1] = bf_hi(bw.z) + sigmoidf_(a1[1]) * bf_hi(q.z); r1[2] = bf_lo(bw.w) + sigmoidf_(a1[2]) * bf_lo(q.w); r1[3] = bf_hi(bw.w) + sigmoidf_(a1[3]) * bf_hi(q.w);
                    *(f32x4*)(out + off + bj * HALF) = r0; *(f32x4*)(out + off + bj * HALF + 4) = r1; } }
            asm volatile("" ::: "memory"); }
    }
};

template <class Epi>
__device__ __forceinline__ void gemm_phase(LAS unsigned char* lds, const Gemm g, const StaticOrder& S, const Epi& E) {
    const int tid = threadIdx.x, wid = __builtin_amdgcn_readfirstlane(tid >> 6), lane = tid & 63, wr = wid >> 2, wc = wid & 3, fr = lane & 15, fq = lane >> 4;
    const int K = g.K, nt = K / BK, lda = g.lda;
    unsigned voffA[2], voffB[2];
#pragma unroll
    for (int i = 0; i < 2; ++i) { int R, C; stage_rc(tid * 16 + i * 8192, R, C); const int Rb = Epi::PERM ? ((R & ~31) + perm32(R & 31)) : R;
        voffA[i] = (unsigned)(R * lda + C) * 2u; voffB[i] = (unsigned)(Rb * K + C) * 2u; }
    const size_t kstep = (size_t)(BK * 2);
    const size_t hstepA = (size_t)HALF * lda * 2, hstepB = (size_t)HALF * K * 2;
    const size_t tstepA = 2 * hstepA, tstepB = 2 * hstepB;
    const unsigned ldsw = (unsigned)wid * 1024u;
    const int aoff = lds_byte(wr * 64 + fr, fq * 8), boff = lds_byte(wc * 32 + fr, fq * 8);
#define PG8_SA(b, h) (((b) * 2 + (h)) * HTB)
#define PG8_SB(b, h) ((4 + (b) * 2 + (h)) * HTB)
#define PG8_STAGE(bufoff, gbase, voff) do { _Pragma("unroll") for (int _i = 0; _i < 2; ++_i) \
        __builtin_amdgcn_global_load_lds((const unsigned*)((const char*)(gbase) + (voff)[_i]), (LAS unsigned*)(lds + (bufoff) + ldsw + _i * 8192), 16, 0, 0); } while (0)
#define PG8_LDA(dst, b, h) do { _Pragma("unroll") for (int m = 0; m < 4; ++m) _Pragma("unroll") for (int k = 0; k < 2; ++k) dst[m][k] = *(const LAS bf16x8*)(lds + PG8_SA(b, h) + aoff + m * 2048 + k * 1024); } while (0)
#define PG8_LDB(dst, b, h) do { _Pragma("unroll") for (int n = 0; n < 2; ++n) _Pragma("unroll") for (int k = 0; k < 2; ++k) dst[n][k] = *(const LAS bf16x8*)(lds + PG8_SB(b, h) + boff + n * 2048 + k * 1024); } while (0)
#define PG8_MMA(ai, bj, At, Bt) do { __builtin_amdgcn_s_setprio(1); _Pragma("unroll") for (int m = 0; m < 4; ++m) _Pragma("unroll") for (int n = 0; n < 2; ++n) _Pragma("unroll") for (int k = 0; k < 2; ++k) \
        acc[ai][bj][m][n] = __builtin_amdgcn_mfma_f32_16x16x32_bf16(Bt[n][k], At[m][k], acc[ai][bj][m][n], 0, 0, 0); __builtin_amdgcn_s_setprio(0); } while (0)
#define PG8_WAIT_V(n) asm volatile("s_waitcnt vmcnt(" #n ")" ::: "memory")
#define PG8_WAIT_L(n) asm volatile("s_waitcnt lgkmcnt(" #n ")" ::: "memory")
#define PG8_BAR __builtin_amdgcn_s_barrier()
#define PG8_SCHED __builtin_amdgcn_sched_barrier(0)
    Unit cur, nxt; int ui = 0;
    if (!S.next(0, cur)) return;
    f32x4 acc[2][2][4][2];
#pragma unroll
    for (int a = 0; a < 2; ++a)
#pragma unroll
        for (int b = 0; b < 2; ++b)
#pragma unroll
            for (int m = 0; m < 4; ++m)
#pragma unroll
                for (int n = 0; n < 2; ++n) acc[a][b][m][n] = (f32x4){0.f, 0.f, 0.f, 0.f};
    bf16x8 At[4][2], B0[2][2], B1[2][2];
    const char* cA = (const char*)g.A + (size_t)cur.pm * tstepA; const char* cB = (const char*)g.Bt + (size_t)cur.pn * tstepB;
    PG8_STAGE(PG8_SB(0, 0), cB, voffB); PG8_STAGE(PG8_SA(0, 0), cA, voffA); PG8_STAGE(PG8_SB(0, 1), cB + hstepB, voffB); PG8_STAGE(PG8_SA(0, 1), cA + hstepA, voffA);
    if (wr == 1) PG8_BAR;
    PG8_WAIT_V(4); PG8_BAR;
    PG8_STAGE(PG8_SB(1, 0), cB + kstep, voffB); PG8_STAGE(PG8_SA(1, 0), cA + kstep, voffA); PG8_STAGE(PG8_SB(1, 1), cB + hstepB + kstep, voffB);
    PG8_WAIT_V(6); PG8_BAR;
    for (;;) {
        const bool has_next = S.next(ui + 1, nxt);
        const char* nA = has_next ? (const char*)g.A + (size_t)nxt.pm * tstepA : cA; const char* nB = has_next ? (const char*)g.Bt + (size_t)nxt.pn * tstepB : cB;
        for (int t = 0; t < nt; t += 2) {
            const bool last = (t == nt - 2);
            const char* a1 = cA + (size_t)(t + 1) * kstep;
            const char* a2 = last ? nA : cA + (size_t)(t + 2) * kstep; const char* b2 = last ? nB : cB + (size_t)(t + 2) * kstep;
            const char* a3 = a2 + kstep; const char* b3 = b2 + kstep;
            PG8_LDB(B0, 0, 0); PG8_SCHED; PG8_LDA(At, 0, 0); PG8_STAGE(PG8_SA(1, 1), a1 + hstepA, voffA);
            PG8_WAIT_L(8); PG8_BAR; PG8_WAIT_L(0); PG8_MMA(0, 0, At, B0); PG8_BAR; PG8_SCHED;
            PG8_LDB(B1, 0, 1); PG8_STAGE(PG8_SB(0, 0), b2, voffB);
            PG8_BAR; PG8_WAIT_L(0); PG8_MMA(0, 1, At, B1); PG8_BAR;
            PG8_LDA(At, 0, 1); PG8_STAGE(PG8_SA(0, 0), a2, voffA);
            PG8_BAR; PG8_WAIT_L(0); PG8_MMA(1, 0, At, B0); PG8_BAR; PG8_SCHED;
            PG8_STAGE(PG8_SB(0, 1), b2 + hstepB, voffB);
            PG8_WAIT_V(6); PG8_BAR; PG8_MMA(1, 1, At, B1); PG8_BAR;
            PG8_LDB(B0, 1, 0); PG8_SCHED; PG8_LDA(At, 1, 0); PG8_STAGE(PG8_SA(0, 1), a2 + hstepA, voffA);
            PG8_WAIT_L(8); PG8_BAR; PG8_WAIT_L(0); PG8_MMA(0, 0, At, B0); PG8_BAR; PG8_SCHED;
            PG8_LDB(B1, 1, 1); PG8_STAGE(PG8_SB(1, 0), b3, voffB);
            PG8_BAR; PG8_WAIT_L(0); PG8_MMA(0, 1, At, B1); PG8_BAR;
            PG8_LDA(At, 1, 1); PG8_STAGE(PG8_SA(1, 0), a3, voffA);
            PG8_BAR; PG8_WAIT_L(0); PG8_MMA(1, 0, At, B0); PG8_BAR; PG8_SCHED;
            PG8_STAGE(PG8_SB(1, 1), b3 + hstepB, voffB);
            PG8_WAIT_V(6); PG8_BAR; PG8_MMA(1, 1, At, B1); PG8_BAR;
        }
        E(acc, cur, wr, wc, fr, fq);
        if (!has_next) break;
#pragma unroll
        for (int a = 0; a < 2; ++a)
#pragma unroll
            for (int b = 0; b < 2; ++b)
#pragma unroll
                for (int m = 0; m < 4; ++m)
#pragma unroll
                    for (int n = 0; n < 2; ++n) acc[a][b][m][n] = (f32x4){0.f, 0.f, 0.f, 0.f};
        cur = nxt; cA = nA; cB = nB; ++ui;
    }
    PG8_WAIT_V(0);
    if (wr == 0) PG8_BAR;
    PG8_BAR;
#undef PG8_SA
#undef PG8_SB
#undef PG8_STAGE
#undef PG8_LDA
#undef PG8_LDB
#undef PG8_MMA
#undef PG8_WAIT_V
#undef PG8_WAIT_L
#undef PG8_BAR
#undef PG8_SCHED
}
}

namespace att {
constexpr int D = 128, NW = 8, QBLK = 32, KVBLK = 64;
constexpr float SCALE = 0.088388347648318440f;
constexpr float THR = 8.f;
#ifndef ATT_SDEPTH
#define ATT_SDEPTH 1
#endif
constexpr int LDQ = INW, LDK = INW, LDO = INW / 2;
constexpr int SHM_V = KVBLK * D * 2, SHM_K = KVBLK * D * 2;
constexpr int OFF_WS = 2 * SHM_V + 2 * SHM_K, OFF_TAB = OFF_WS + NW * 64 * 4, SHM_ATTN = OFF_TAB + 768 * 4;
#define KSWZ(row, colB) ((row) * 256 + ((colB) ^ (((row) & 7) << 4)))
#define SBAR() __builtin_amdgcn_sched_barrier(0)
__device__ __forceinline__ int crow(int r, int hi) { return (r & 3) + 8 * (r >> 2) + 4 * hi; }

__device__ __forceinline__ void partialSM(f32x16& p0, f32x16& p1, float& m_reg, float& mn, float& alpha) {
  constexpr float C = SCALE * 1.4426950408889634f;
  float pmax = p0[0];
#pragma unroll
  for (int r = 1; r < 16; ++r) pmax = fmaxf(pmax, p0[r]);
#pragma unroll
  for (int r = 0; r < 16; ++r) pmax = fmaxf(pmax, p1[r]);
  { auto rr = __builtin_amdgcn_permlane32_swap(__float_as_uint(pmax), __float_as_uint(pmax), false, false);
    pmax = fmaxf(__uint_as_float(rr[0]), __uint_as_float(rr[1])); }
  if (__builtin_expect(__all(pmax - m_reg <= THR / SCALE), 1)) { mn = m_reg; alpha = 1.f; }
  else { mn = fmaxf(m_reg, pmax); alpha = __builtin_amdgcn_exp2f((m_reg - mn) * C); m_reg = mn; }
  float mnC = -mn * C;
#pragma unroll
  for (int r = 0; r < 16; ++r) p0[r] = fmaf(p0[r], C, mnC);
#pragma unroll
  for (int r = 0; r < 16; ++r) p1[r] = fmaf(p1[r], C, mnC);
#pragma unroll
  for (int r = 0; r < 16; ++r) p0[r] = __builtin_amdgcn_exp2f(p0[r]);
}
__device__ __forceinline__ void finishSM(f32x16& p0, f32x16& p1, float alpha, float& l_reg, bf16x8& pa0, bf16x8& pa1, bf16x8& pa2, bf16x8& pa3) {
#pragma unroll
  for (int r = 0; r < 16; ++r) p1[r] = __builtin_amdgcn_exp2f(p1[r]);
  float ps = 0;
#pragma unroll
  for (int r = 0; r < 16; ++r) ps += p0[r];
#pragma unroll
  for (int r = 0; r < 16; ++r) ps += p1[r];
  { auto rr = __builtin_amdgcn_permlane32_swap(__float_as_uint(ps), __float_as_uint(ps), false, false);
    ps = __uint_as_float(rr[0]) + __uint_as_float(rr[1]); }
  l_reg = l_reg * alpha + ps;
#define PK4(P, BASE, OUT) do { unsigned a0 = cvt_pk_bf16(P[BASE + 0], P[BASE + 1]), a1 = cvt_pk_bf16(P[BASE + 2], P[BASE + 3]);   \
    unsigned b0 = cvt_pk_bf16(P[BASE + 4], P[BASE + 5]), b1 = cvt_pk_bf16(P[BASE + 6], P[BASE + 7]);                              \
    auto r0 = __builtin_amdgcn_permlane32_swap(a0, b0, false, false); auto r1 = __builtin_amdgcn_permlane32_swap(a1, b1, false, false); \
    u32x4 w = {r0[0], r1[0], r0[1], r1[1]}; OUT = *reinterpret_cast<bf16x8*>(&w); } while (0)
  PK4(p0, 0, pa0); PK4(p0, 8, pa1); PK4(p1, 0, pa2); PK4(p1, 8, pa3);
#undef PK4
}
template <bool NEAR>
__device__ __forceinline__ void qkt(f32x16& p0, f32x16& p1, const bf16_t* Ks, const bf16x8 (&qr)[8], int r32, int hi, float cfar, const float* tabp) {
  if (!NEAR) {
#pragma unroll
    for (int r = 0; r < 16; ++r) { p0[r] = cfar; p1[r] = cfar; }
  } else {
#pragma unroll
    for (int r = 0; r < 16; ++r) { p0[r] = tabp[(r & 3) + 8 * (r >> 2)]; p1[r] = tabp[32 + (r & 3) + 8 * (r >> 2)]; }
  }
#pragma unroll
  for (int d0 = 0; d0 < 8; ++d0) { int cb = (d0 * 16 + hi * 8) * 2;
    bf16x8 b0 = *reinterpret_cast<const bf16x8*>((const char*)Ks + KSWZ(r32, cb));
    bf16x8 b1 = *reinterpret_cast<const bf16x8*>((const char*)Ks + KSWZ(32 + r32, cb));
    p0 = __builtin_amdgcn_mfma_f32_32x32x16_bf16(b0, qr[d0], p0, 0, 0, 0);
    p1 = __builtin_amdgcn_mfma_f32_32x32x16_bf16(b1, qr[d0], p1, 0, 0, 0); }
}
__device__ __forceinline__ int v_st(int k, int c) { const int kk = (k & ~0xC) | ((k & 4) << 1) | ((k & 8) >> 1); return ((kk >> 3) * 4 + (c >> 5)) * 512 + ((kk & 7) * 32 + (c & 31)) * 2; }
__device__ __forceinline__ int v_rd_base(int lane) { return ((lane & 3) << 3) | (((lane >> 2) & 3) << 6) | (((lane >> 4) & 1) << 5) | (((lane >> 5) & 1) << 8); }
constexpr int v_rd_off(int d0, int ks, int half) { return d0 * 512 + ks * 4096 + half * 2048; }
template <int OFF> __device__ __forceinline__ s16x4 tr_read(int vb) {
  s16x4 r; asm volatile("ds_read_b64_tr_b16 %0, %1 offset:%2" : "=&v"(r) : "v"(vb), "i"(OFF) : "memory"); return r;
}
template <int D0> __device__ __forceinline__ void pv_one(f32x16& od, int vb, bf16x8 pa0, bf16x8 pa1, bf16x8 pa2, bf16x8 pa3) {
  const s16x4 l0 = tr_read<v_rd_off(D0, 0, 0)>(vb), h0 = tr_read<v_rd_off(D0, 0, 1)>(vb), l1 = tr_read<v_rd_off(D0, 1, 0)>(vb), h1 = tr_read<v_rd_off(D0, 1, 1)>(vb);
  const s16x4 l2 = tr_read<v_rd_off(D0, 2, 0)>(vb), h2 = tr_read<v_rd_off(D0, 2, 1)>(vb), l3 = tr_read<v_rd_off(D0, 3, 0)>(vb), h3 = tr_read<v_rd_off(D0, 3, 1)>(vb);
  asm volatile("s_waitcnt lgkmcnt(0)" ::: "memory"); SBAR();
#define PK(L, H) (bf16x8){L[0], L[1], L[2], L[3], H[0], H[1], H[2], H[3]}
  od = __builtin_amdgcn_mfma_f32_32x32x16_bf16(pa0, PK(l0, h0), od, 0, 0, 0);
  od = __builtin_amdgcn_mfma_f32_32x32x16_bf16(pa1, PK(l1, h1), od, 0, 0, 0);
  od = __builtin_amdgcn_mfma_f32_32x32x16_bf16(pa2, PK(l2, h2), od, 0, 0, 0);
  od = __builtin_amdgcn_mfma_f32_32x32x16_bf16(pa3, PK(l3, h3), od, 0, 0, 0);
#undef PK
}
__device__ __forceinline__ void pv_d0(f32x16* o, int vb, bf16x8 pa0, bf16x8 pa1, bf16x8 pa2, bf16x8 pa3) {
  pv_one<0>(o[0], vb, pa0, pa1, pa2, pa3); pv_one<1>(o[1], vb, pa0, pa1, pa2, pa3); pv_one<2>(o[2], vb, pa0, pa1, pa2, pa3); pv_one<3>(o[3], vb, pa0, pa1, pa2, pa3);
}

template <int SDEPTH>
__device__ __forceinline__ void attn_range(const bf16_t* __restrict__ Kh, const bf16_t* __restrict__ Vh, int NT, float cfar, const bf16x8 (&qr)[8],
                                           float& m_reg, float& l_reg, f32x16 (&o)[4], char* lds, int tid, int wid, int r32, int hi) {
  bf16_t* V_lds = (bf16_t*)lds; bf16_t* K_lds = (bf16_t*)(lds + 2 * SHM_V);
  float* al_l = (float*)(lds + OFF_WS) + wid * 64 + 32;
  const int sr = tid >> 4, sc = (tid & 15) * 8, vst0 = v_st(sr, sc), vst1 = v_st(32 + sr, sc);
  const int vb0 = (int)(uintptr_t)V_lds + v_rd_base(tid & 63);
  struct { bf16x8 vs0, vs1, ks0, ks1; } sr_[SDEPTH];
#define SLOAD(i, k0) do { sr_[i].vs0 = *reinterpret_cast<const bf16x8*>(&Vh[(long)((k0) + sr) * LDK + sc]); sr_[i].vs1 = *reinterpret_cast<const bf16x8*>(&Vh[(long)((k0) + 32 + sr) * LDK + sc]); \
    sr_[i].ks0 = *reinterpret_cast<const bf16x8*>(&Kh[(long)((k0) + sr) * LDK + sc]); sr_[i].ks1 = *reinterpret_cast<const bf16x8*>(&Kh[(long)((k0) + 32 + sr) * LDK + sc]); } while (0)
#define SWRITE(b, i) do { *(bf16x8*)((char*)V_lds + (b) * SHM_V + vst0) = sr_[i].vs0;          \
    *(bf16x8*)((char*)V_lds + (b) * SHM_V + vst1) = sr_[i].vs1; int kc = sc * 2;               \
    *(bf16x8*)((char*)K_lds + (b) * SHM_K + KSWZ(sr, kc)) = sr_[i].ks0;                       \
    *(bf16x8*)((char*)K_lds + (b) * SHM_K + KSWZ(32 + sr, kc)) = sr_[i].ks1; } while (0)
#define SWAIT() do { if constexpr (SDEPTH == 2) asm volatile("s_waitcnt vmcnt(4)" ::: "memory"); else asm volatile("s_waitcnt vmcnt(0)" ::: "memory"); } while (0)
#define RESC(a) do { if (__any((a) < 1.f)) { if (hi == 0) al_l[r32] = (a); asm volatile("s_waitcnt lgkmcnt(0)" ::: "memory"); \
    _Pragma("unroll") for (int d = 0; d < 4; ++d) _Pragma("unroll") for (int r = 0; r < 16; ++r) o[d][r] *= al_l[crow(r, hi)]; } } while (0)
#define QKT(P0, P1, KB, jj) qkt<false>(P0, P1, KB, qr, r32, hi, cfar, nullptr)
  f32x16 pA0, pA1, pB0, pB1; float mnA, mnB, alA, alB; bf16x8 pa0, pa1, pa2, pa3;
  constexpr int SE = 0, SO = SDEPTH - 1;
  SLOAD(SE, 0); asm volatile("s_waitcnt vmcnt(0)" ::: "memory"); SWRITE(0, SE); __syncthreads();
  QKT(pA0, pA1, K_lds, 0); partialSM(pA0, pA1, m_reg, mnA, alA);
  SLOAD(SO, KVBLK); if constexpr (SDEPTH == 2) { if (2 < NT) SLOAD(SE, 2 * KVBLK); }
  SWAIT(); SWRITE(1, SO); __syncthreads();
  RESC(alA);
  for (int j = 1; j + 1 < NT; j += 2) {
    SBAR(); QKT(pB0, pB1, (bf16_t*)((char*)K_lds + SHM_K), j);
    finishSM(pA0, pA1, alA, l_reg, pa0, pa1, pa2, pa3); SBAR();
    SLOAD(SO, (j + SDEPTH) * KVBLK); SBAR();
    pv_d0(o, vb0, pa0, pa1, pa2, pa3); partialSM(pB0, pB1, m_reg, mnB, alB);
    __syncthreads(); SWAIT(); SWRITE(0, SE);
    RESC(alB); __syncthreads();
    SBAR(); QKT(pA0, pA1, K_lds, j + 1);
    finishSM(pB0, pB1, alB, l_reg, pa0, pa1, pa2, pa3); SBAR();
    if (SDEPTH == 1 || j + 3 < NT) SLOAD(SE, (j + 1 + SDEPTH) * KVBLK); SBAR();
    pv_d0(o, vb0 + (int)SHM_V, pa0, pa1, pa2, pa3); partialSM(pA0, pA1, m_reg, mnA, alA);
    __syncthreads(); SWAIT(); SWRITE(1, SO);
    RESC(alA); __syncthreads();
  }
  SBAR(); QKT(pB0, pB1, (bf16_t*)((char*)K_lds + SHM_K), NT - 1);
  finishSM(pA0, pA1, alA, l_reg, pa0, pa1, pa2, pa3); SBAR();
  pv_d0(o, vb0, pa0, pa1, pa2, pa3); partialSM(pB0, pB1, m_reg, mnB, alB);
  __syncthreads(); RESC(alB);
  finishSM(pB0, pB1, alB, l_reg, pa0, pa1, pa2, pa3); SBAR();
  pv_d0(o, vb0 + (int)SHM_V, pa0, pa1, pa2, pa3);
#undef SLOAD
#undef SWRITE
#undef SWAIT
#undef RESC
#undef QKT
}

__device__ __forceinline__ void attn_near(const bf16_t* __restrict__ Kh, const bf16_t* __restrict__ Vh, int NT, const float* tabl, const bf16x8 (&qr)[8],
                                          float& m_reg, float& l_reg, f32x16 (&o)[4], char* lds, int tid, int wid, int r32, int hi) {
  bf16_t* V_lds = (bf16_t*)lds; bf16_t* K_lds = (bf16_t*)(lds + 2 * SHM_V);
  float* al_l = (float*)(lds + OFF_WS) + wid * 64 + 32;
  const int sr = tid >> 4, sc = (tid & 15) * 8, vst0 = v_st(sr, sc), vst1 = v_st(32 + sr, sc);
  const int vb0 = (int)(uintptr_t)V_lds + v_rd_base(tid & 63);
#pragma unroll 1
  for (int j = 0; j < NT; ++j) {
    const long k0 = (long)j * KVBLK;
    const bf16x8 vs0 = *reinterpret_cast<const bf16x8*>(&Vh[(k0 + sr) * LDK + sc]), vs1 = *reinterpret_cast<const bf16x8*>(&Vh[(k0 + 32 + sr) * LDK + sc]);
    const bf16x8 ks0 = *reinterpret_cast<const bf16x8*>(&Kh[(k0 + sr) * LDK + sc]), ks1 = *reinterpret_cast<const bf16x8*>(&Kh[(k0 + 32 + sr) * LDK + sc]);
    __syncthreads();
    *(bf16x8*)((char*)V_lds + vst0) = vs0; *(bf16x8*)((char*)V_lds + vst1) = vs1;
    *(bf16x8*)((char*)K_lds + KSWZ(sr, sc * 2)) = ks0; *(bf16x8*)((char*)K_lds + KSWZ(32 + sr, sc * 2)) = ks1;
    __syncthreads();
    f32x16 p0, p1; float mn, al; bf16x8 pa0, pa1, pa2, pa3;
    qkt<true>(p0, p1, K_lds, qr, r32, hi, 0.f, tabl + j * KVBLK);
    partialSM(p0, p1, m_reg, mn, al);
    if (__any(al < 1.f)) { if (hi == 0) al_l[r32] = al; asm volatile("s_waitcnt lgkmcnt(0)" ::: "memory");
#pragma unroll
      for (int d = 0; d < 4; ++d)
#pragma unroll
        for (int r = 0; r < 16; ++r) o[d][r] *= al_l[crow(r, hi)]; }
    finishSM(p0, p1, al, l_reg, pa0, pa1, pa2, pa3); SBAR();
    pv_d0(o, vb0, pa0, pa1, pa2, pa3);
  }
  __syncthreads();
}

__device__ __forceinline__ void attn_body(const bf16_t* __restrict__ Qb, const bf16_t* __restrict__ Kh, const bf16_t* __restrict__ Vh, float* Ob, int seq, int q0, float lam, bool SUBTRACT, char* lds) {
  int tid = threadIdx.x; asm volatile("" : "+v"(tid));
  const int wid = __builtin_amdgcn_readfirstlane(tid >> 6), lane = tid & 63, r32 = lane & 31, hi = lane >> 5;
  float* li_l = (float*)(lds + OFF_WS) + wid * 64;
  const float* tab = (const float*)(lds + OFF_TAB);
  const int NT = seq / KVBLK;
  int jn0 = q0 / KVBLK - 2, jn1 = q0 / KVBLK + 6; jn0 = jn0 < 0 ? 0 : jn0; jn1 = jn1 > NT ? NT : jn1;
  float m_reg = -1e30f, l_reg = 0; f32x16 o[4] = {}; bf16x8 qr[8];
  const bf16_t* Qw = Qb + (long)(wid * QBLK + r32) * LDQ + hi * 8;
#pragma unroll
  for (int d0 = 0; d0 < 8; ++d0) qr[d0] = *reinterpret_cast<const bf16x8*>(Qw + d0 * 16);
  { const float* tabl = tab + (384 + 4 * hi - (q0 + wid * QBLK + r32 - jn0 * KVBLK));
    attn_near(Kh + (long)jn0 * KVBLK * LDK, Vh + (long)jn0 * KVBLK * LDK, jn1 - jn0, tabl, qr, m_reg, l_reg, o, lds, tid, wid, r32, hi); }
#pragma unroll 1
  for (int rg = 0; rg < 2; ++rg) {
    int rr = rg; asm volatile("" : "+s"(rr));
    const int ja = rr ? jn1 : 0, nt = rr ? NT - jn1 : jn0;
    const float cfar = __uint_as_float(__builtin_amdgcn_readfirstlane(__float_as_uint(tab[rr ? 767 : 0])));
    if (nt > 0) attn_range<ATT_SDEPTH>(Kh + (long)ja * KVBLK * LDK, Vh + (long)ja * KVBLK * LDK, nt, cfar, qr, m_reg, l_reg, o, lds, tid, wid, r32, hi);
  }
  if (hi == 0) li_l[r32] = l_reg; asm volatile("s_waitcnt lgkmcnt(0)" ::: "memory");
  float rli[16];
#pragma unroll
  for (int r = 0; r < 16; ++r) rli[r] = __builtin_amdgcn_rcpf(li_l[crow(r, hi)]);
  int r32e = r32, hie = hi; asm volatile("" : "+v"(r32e), "+v"(hie));
  float* Ow = Ob + (long)(wid * QBLK) * LDO + (4 * hie) * LDO + r32e;
  if (SUBTRACT) {
#pragma unroll
    for (int r = 0; r < 16; ++r) {
#pragma unroll
      for (int d0 = 0; d0 < 4; ++d0) { float* op = Ow + ((r & 3) + 8 * (r >> 2)) * LDO + d0 * 32; *op = *op - lam * (o[d0][r] * rli[r]); }
      asm volatile("" ::: "memory"); }
  } else {
#pragma unroll
    for (int r = 0; r < 16; ++r) {
#pragma unroll
      for (int d0 = 0; d0 < 4; ++d0) Ow[((r & 3) + 8 * (r >> 2)) * LDO + d0 * 32] = o[d0][r] * rli[r]; }
  }
  asm volatile("s_waitcnt vmcnt(0)" ::: "memory");
  __syncthreads();
}
}

namespace att2 {
using att::crow; using att::partialSM; using att::finishSM; using att::KVBLK; using att::QBLK; using att::LDQ; using att::LDK; using att::LDO;
constexpr int KBUF = 16384, VBUF = 32768, OFF_K = 0, OFF_V = 2 * KBUF, OFF_WS = OFF_V + 3 * VBUF, OFF_TAB = OFF_WS + 2048, SHM = OFF_TAB + 768 * 4;
#define A2_WAIT_V(n) asm volatile("s_waitcnt vmcnt(" #n ")" ::: "memory")
#define A2_BAR() do { asm volatile("" ::: "memory"); __builtin_amdgcn_s_barrier(); asm volatile("" ::: "memory"); } while (0)
template <int OFF> __device__ __forceinline__ s16x4 tr_read(int vb) {
  s16x4 r; asm volatile("ds_read_b64_tr_b16 %0, %1 offset:%2" : "=&v"(r) : "v"(vb), "i"(OFF) : "memory"); return r;
}
constexpr int v_off(int d0, int ks, int half) { return (d0 >> 2) * 16384 + (d0 & 3) * 512 + ks * 4096 + half * 2048; }
struct VFrag { s16x4 l0, h0, l1, h1; };
template <int D0, int SUB> __device__ __forceinline__ void v_read(VFrag& f, int vb) {
  f.l0 = tr_read<v_off(D0, 2 * SUB, 0)>(vb); f.h0 = tr_read<v_off(D0, 2 * SUB, 1)>(vb); f.l1 = tr_read<v_off(D0, 2 * SUB + 1, 0)>(vb); f.h1 = tr_read<v_off(D0, 2 * SUB + 1, 1)>(vb);
}
__device__ __forceinline__ void v_mma(f32x16& od, const VFrag& f, bf16x8 pa0, bf16x8 pa1) {
#define PK(L, H) (bf16x8){L[0], L[1], L[2], L[3], H[0], H[1], H[2], H[3]}
  od = __builtin_amdgcn_mfma_f32_32x32x16_bf16(pa0, PK(f.l0, f.h0), od, 0, 0, 0);
  od = __builtin_amdgcn_mfma_f32_32x32x16_bf16(pa1, PK(f.l1, f.h1), od, 0, 0, 0);
#undef PK
}
#define A2_LWAIT(n) do { asm volatile("s_waitcnt lgkmcnt(" #n ")" ::: "memory"); __builtin_amdgcn_sched_barrier(0); } while (0)
template <int SUB> __device__ __forceinline__ void pv_all(f32x16 (&o)[8], int vb, bf16x8 pa0, bf16x8 pa1, VFrag& fa) {
  VFrag fb;
  __builtin_amdgcn_s_setprio(1);
  v_read<1, SUB>(fb, vb); A2_LWAIT(4); v_mma(o[0], fa, pa0, pa1); __builtin_amdgcn_sched_barrier(0);
  v_read<2, SUB>(fa, vb); A2_LWAIT(4); v_mma(o[1], fb, pa0, pa1); __builtin_amdgcn_sched_barrier(0);
  v_read<3, SUB>(fb, vb); A2_LWAIT(4); v_mma(o[2], fa, pa0, pa1); __builtin_amdgcn_sched_barrier(0);
  v_read<4, SUB>(fa, vb); A2_LWAIT(4); v_mma(o[3], fb, pa0, pa1); __builtin_amdgcn_sched_barrier(0);
  v_read<5, SUB>(fb, vb); A2_LWAIT(4); v_mma(o[4], fa, pa0, pa1); __builtin_amdgcn_sched_barrier(0);
  v_read<6, SUB>(fa, vb); A2_LWAIT(4); v_mma(o[5], fb, pa0, pa1); __builtin_amdgcn_sched_barrier(0);
  v_read<7, SUB>(fb, vb); A2_LWAIT(4); v_mma(o[6], fa, pa0, pa1); __builtin_amdgcn_sched_barrier(0);
  A2_LWAIT(0); v_mma(o[7], fb, pa0, pa1);
  __builtin_amdgcn_s_setprio(0);
}
struct Ctx { LAS unsigned char* lds; unsigned voffK, voffV; int wid, r32, hi, vb0; LAS float* al_l; };
__device__ __forceinline__ void issueK(const Ctx& c, int buf, const char* g) {
#pragma unroll
  for (int i = 0; i < 2; ++i) __builtin_amdgcn_global_load_lds((const unsigned*)(g + (size_t)i * (32 * LDK * 2) + c.voffK), (LAS unsigned*)(c.lds + OFF_K + buf * KBUF + c.wid * 1024 + i * 8192), 16, 0, 0);
}
__device__ __forceinline__ void issueV(const Ctx& c, int buf, const char* g) {
#pragma unroll
  for (int i = 0; i < 4; ++i) __builtin_amdgcn_global_load_lds((const unsigned*)(g + (size_t)(i & 1) * (32 * LDK * 2) + (i >> 1) * 256 + c.voffV), (LAS unsigned*)(c.lds + OFF_V + buf * VBUF + c.wid * 1024 + i * 8192), 16, 0, 0);
}
template <bool NEAR, int SUB, int DMA = 0>
__device__ __forceinline__ void qk_sm(const Ctx& c, const LAS unsigned char* Ks, const bf16x8 (&qr)[8], float cfar, const LAS float* tabp, float& m_reg, float& l_reg, f32x16 (&o)[8], bf16x8& pa0, bf16x8& pa1,
                                      VFrag& fa, int vbp, int dbuf = 0, const char* dsrc = nullptr, int dbuf2 = 0, const char* dsrc2 = nullptr) {
  constexpr float C = att::SCALE * 1.4426950408889634f;
  f32x16 p;
  if (!NEAR) {
#pragma unroll
    for (int r = 0; r < 16; ++r) p[r] = 0.f;
  } else {
#pragma unroll
    for (int r = 0; r < 16; ++r) p[r] = tabp[32 * SUB + (r & 3) + 8 * (r >> 2)];
  }
  { const int kb = (int)(unsigned)(uintptr_t)Ks + c.r32 * 256 + ((c.hi << 4) ^ ((c.r32 & 7) << 4));
    bf16x8 ka, kbf, kc;
#define K_RD(dst, d0) asm volatile("ds_read_b128 %0, %1 offset:%2" : "=&v"(dst) : "v"(kb ^ ((d0) << 5)), "i"(SUB * 8192) : "memory")
    __builtin_amdgcn_s_setprio(1);
    K_RD(ka, 0); K_RD(kbf, 1); K_RD(kc, 2);
    A2_LWAIT(2); p = __builtin_amdgcn_mfma_f32_32x32x16_bf16(ka, qr[0], p, 0, 0, 0); __builtin_amdgcn_sched_barrier(0); K_RD(ka, 3);
    A2_LWAIT(2); p = __builtin_amdgcn_mfma_f32_32x32x16_bf16(kbf, qr[1], p, 0, 0, 0); __builtin_amdgcn_sched_barrier(0); K_RD(kbf, 4);
    A2_LWAIT(2); p = __builtin_amdgcn_mfma_f32_32x32x16_bf16(kc, qr[2], p, 0, 0, 0); __builtin_amdgcn_sched_barrier(0); K_RD(kc, 5);
    A2_LWAIT(2); p = __builtin_amdgcn_mfma_f32_32x32x16_bf16(ka, qr[3], p, 0, 0, 0); __builtin_amdgcn_sched_barrier(0); K_RD(ka, 6);
    A2_LWAIT(2); p = __builtin_amdgcn_mfma_f32_32x32x16_bf16(kbf, qr[4], p, 0, 0, 0); __builtin_amdgcn_sched_barrier(0); K_RD(kbf, 7);
    A2_LWAIT(2); p = __builtin_amdgcn_mfma_f32_32x32x16_bf16(kc, qr[5], p, 0, 0, 0); __builtin_amdgcn_sched_barrier(0);
    A2_LWAIT(1); p = __builtin_amdgcn_mfma_f32_32x32x16_bf16(ka, qr[6], p, 0, 0, 0); __builtin_amdgcn_sched_barrier(0);
    A2_LWAIT(0); p = __builtin_amdgcn_mfma_f32_32x32x16_bf16(kbf, qr[7], p, 0, 0, 0);
    __builtin_amdgcn_s_setprio(0);
#undef K_RD
  }
  if (DMA == 1) { __builtin_amdgcn_sched_barrier(0); issueK(c, dbuf, dsrc); __builtin_amdgcn_sched_barrier(0); }
  if (DMA == 3) { __builtin_amdgcn_sched_barrier(0); issueK(c, dbuf, dsrc); issueV(c, dbuf2, dsrc2); __builtin_amdgcn_sched_barrier(0); }
  if (DMA == 2) { __builtin_amdgcn_sched_barrier(0); issueV(c, dbuf, dsrc); __builtin_amdgcn_sched_barrier(0); }
  v_read<0, SUB>(fa, vbp);
  float pmax = p[0];
#pragma unroll
  for (int r = 1; r < 16; ++r) pmax = fmaxf(pmax, p[r]);
  { auto rr = __builtin_amdgcn_permlane32_swap(__float_as_uint(pmax), __float_as_uint(pmax), false, false);
    pmax = fmaxf(__uint_as_float(rr[0]), __uint_as_float(rr[1])); }
  if (!NEAR) pmax += cfar;
  float mn, alpha;
  if (__builtin_expect(__all(pmax - m_reg <= att::THR / att::SCALE), 1)) { mn = m_reg; alpha = 1.f; }
  else { mn = fmaxf(m_reg, pmax); alpha = __builtin_amdgcn_exp2f((m_reg - mn) * C); m_reg = mn;
    if (__any(alpha < 1.f)) { if (c.hi == 0) c.al_l[c.r32] = alpha; asm volatile("s_waitcnt lgkmcnt(0)" ::: "memory");
#pragma unroll
      for (int d = 0; d < 8; ++d)
#pragma unroll
        for (int r = 0; r < 16; ++r) o[d][r] *= c.al_l[crow(r, c.hi)]; } }
  const float mnC = NEAR ? -mn * C : (cfar - mn) * C;
  float ps = 0.f;
#pragma unroll
  for (int r = 0; r < 16; ++r) { p[r] = __builtin_amdgcn_exp2f(fmaf(p[r], C, mnC)); ps += p[r]; }
  { auto rr = __builtin_amdgcn_permlane32_swap(__float_as_uint(ps), __float_as_uint(ps), false, false);
    ps = __uint_as_float(rr[0]) + __uint_as_float(rr[1]); }
  l_reg = l_reg * alpha + ps;
#define PK4(P, BASE, OUT) do { unsigned a0 = cvt_pk_bf16(P[BASE + 0], P[BASE + 1]), a1 = cvt_pk_bf16(P[BASE + 2], P[BASE + 3]);   \
    unsigned b0 = cvt_pk_bf16(P[BASE + 4], P[BASE + 5]), b1 = cvt_pk_bf16(P[BASE + 6], P[BASE + 7]);                              \
    auto r0 = __builtin_amdgcn_permlane32_swap(a0, b0, false, false); auto r1 = __builtin_amdgcn_permlane32_swap(a1, b1, false, false); \
    u32x4 w = {r0[0], r1[0], r0[1], r1[1]}; OUT = *reinterpret_cast<bf16x8*>(&w); } while (0)
  PK4(p, 0, pa0); PK4(p, 8, pa1);
#undef PK4
}
template <bool NEAR, int SUB>
__device__ __forceinline__ void sub_tile(const Ctx& c, const LAS unsigned char* Ks, int vb, const bf16x8 (&qr)[8], float cfar, const LAS float* tabp, float& m_reg, float& l_reg, f32x16 (&o)[8]) {
  bf16x8 pa0, pa1; VFrag fa;
  qk_sm<NEAR, SUB>(c, Ks, qr, cfar, tabp, m_reg, l_reg, o, pa0, pa1, fa, vb);
  __builtin_amdgcn_sched_barrier(0);
  pv_all<SUB>(o, vb, pa0, pa1, fa);
}
__device__ __forceinline__ void far_run(const Ctx& c, const char* gK, const char* gV, int NT, float cfar, const bf16x8 (&qr)[8], float& m_reg, float& l_reg, f32x16 (&o)[8]) {
  constexpr size_t TSTEP = (size_t)KVBLK * LDK * 2;
  const bool roleB = c.wid >= 4;
  issueV(c, 0, gV); issueK(c, 0, gK);
  bf16x8 pa0, pa1; VFrag fa;
  int vcur = 0, vprev = 0;
#pragma unroll 1
  for (int t = 0; t < NT; ++t) {
    const int t1 = (t + 1 < NT) ? t + 1 : NT - 1;
    const int vnext = vcur == 2 ? 0 : vcur + 1;
    const LAS unsigned char* Ks = c.lds + OFF_K + (t & 1) * KBUF;
    const int vbc = c.vb0 + vcur * VBUF;
    A2_WAIT_V(0); A2_BAR();
    if (roleB && t > 0) pv_all<1>(o, c.vb0 + vprev * VBUF, pa0, pa1, fa);
    qk_sm<false, 0, 3>(c, Ks, qr, cfar, nullptr, m_reg, l_reg, o, pa0, pa1, fa, vbc, (t + 1) & 1, gK + (size_t)t1 * TSTEP, vnext, gV + (size_t)t1 * TSTEP);
    __builtin_amdgcn_sched_barrier(0);
    pv_all<0>(o, vbc, pa0, pa1, fa);
    qk_sm<false, 1, 0>(c, Ks, qr, cfar, nullptr, m_reg, l_reg, o, pa0, pa1, fa, vbc);
    __builtin_amdgcn_sched_barrier(0);
    if (!roleB) pv_all<1>(o, vbc, pa0, pa1, fa);
    vprev = vcur; vcur = vnext;
  }
  if (roleB) pv_all<1>(o, c.vb0 + vprev * VBUF, pa0, pa1, fa);
  A2_WAIT_V(0); A2_BAR();
}
__device__ __forceinline__ void near_run(const Ctx& c, const char* gK, const char* gV, int NT, const LAS float* tabl, const bf16x8 (&qr)[8], float& m_reg, float& l_reg, f32x16 (&o)[8]) {
  constexpr size_t TSTEP = (size_t)KVBLK * LDK * 2;
  issueK(c, 0, gK); issueV(c, 0, gV);
#pragma unroll 1
  for (int j = 0; j < NT; ++j) {
    const int jn = (j + 1 < NT) ? j + 1 : NT - 1, b = j & 1;
    A2_WAIT_V(0); A2_BAR();
    issueK(c, b ^ 1, gK + (size_t)jn * TSTEP); issueV(c, b ^ 1, gV + (size_t)jn * TSTEP);
    sub_tile<true, 0>(c, c.lds + OFF_K + b * KBUF, c.vb0 + b * VBUF, qr, 0.f, tabl + j * KVBLK, m_reg, l_reg, o);
    sub_tile<true, 1>(c, c.lds + OFF_K + b * KBUF, c.vb0 + b * VBUF, qr, 0.f, tabl + j * KVBLK, m_reg, l_reg, o);
  }
  A2_WAIT_V(0); A2_BAR();
}
__device__ __forceinline__ void attn_body(const bf16_t* __restrict__ Qb, const bf16_t* __restrict__ Kh, const bf16_t* __restrict__ Vh, float* Ob, int seq, int q0, float lam, bool SUBTRACT, LAS unsigned char* lds,
                                          bf16_t* Dst, const float* __restrict__ sub_norm, const float* __restrict__ q_gain) {
  int tid = threadIdx.x; asm volatile("" : "+v"(tid));
  const int wid = __builtin_amdgcn_readfirstlane(tid >> 6), lane = tid & 63, r32 = lane & 31, hi = lane >> 5;
  Ctx c; c.lds = lds; c.wid = wid; c.r32 = r32; c.hi = hi;
  c.vb0 = (int)(unsigned)(uintptr_t)(lds + OFF_V) + att::v_rd_base(lane);
  c.al_l = (LAS float*)(lds + OFF_WS) + wid * 64 + 32;
  LAS float* li_l = (LAS float*)(lds + OFF_WS) + wid * 64;
  const LAS float* tab = (const LAS float*)(lds + OFF_TAB);
  { const int P = wid * 1024 + lane * 16, row = P >> 8, cb = (P & 255) ^ ((row & 7) << 4); c.voffK = (unsigned)(row * LDK * 2 + cb); }
  { const int P = wid * 1024 + lane * 16, sub = P >> 9, w = P & 511;
    const int kk = (sub >> 2) * 8 + (w >> 6), k = (kk & ~0xC) | ((kk & 4) << 1) | ((kk & 8) >> 1), col = (sub & 3) * 32 + ((w & 63) >> 1);
    c.voffV = (unsigned)(k * LDK * 2 + col * 2); }
  const int NT = seq / KVBLK;
  int jn0 = q0 / KVBLK - 2, jn1 = q0 / KVBLK + 6; jn0 = jn0 < 0 ? 0 : jn0; jn1 = jn1 > NT ? NT : jn1;
  float m_reg = -1e30f, l_reg = 0; f32x16 o[8] = {}; bf16x8 qr[8];
  const bf16_t* Qw = Qb + (long)(wid * QBLK + r32) * LDQ + hi * 8;
#pragma unroll
  for (int d0 = 0; d0 < 8; ++d0) qr[d0] = *reinterpret_cast<const bf16x8*>(Qw + d0 * 16);
  {
    float f[8][8]; float ss = 0.f;
#pragma unroll
    for (int d0 = 0; d0 < 8; ++d0) { unpack8(*reinterpret_cast<const u32x4*>(&qr[d0]), f[d0]);
#pragma unroll
      for (int e = 0; e < 8; ++e) ss += f[d0][e] * f[d0][e]; }
    { auto rr = __builtin_amdgcn_permlane32_swap(__float_as_uint(ss), __float_as_uint(ss), false, false); ss = __uint_as_float(rr[0]) + __uint_as_float(rr[1]); }
    const float rstd = rsqrtf(ss * (1.0f / 128.0f) + EPS);
#pragma unroll
    for (int d0 = 0; d0 < 8; ++d0) { const f32x4 g0 = *(const f32x4*)(q_gain + d0 * 16 + hi * 8), g1 = *(const f32x4*)(q_gain + d0 * 16 + hi * 8 + 4);
      u32x4 w; w.x = cvt_pk_bf16(f[d0][0] * rstd * g0[0], f[d0][1] * rstd * g0[1]); w.y = cvt_pk_bf16(f[d0][2] * rstd * g0[2], f[d0][3] * rstd * g0[3]);
      w.z = cvt_pk_bf16(f[d0][4] * rstd * g1[0], f[d0][5] * rstd * g1[1]); w.w = cvt_pk_bf16(f[d0][6] * rstd * g1[2], f[d0][7] * rstd * g1[3]);
      qr[d0] = *reinterpret_cast<bf16x8*>(&w); }
  }
  constexpr size_t TSTEP = (size_t)KVBLK * LDK * 2;
  { const LAS float* tabl = tab + (384 + 4 * hi - (q0 + wid * QBLK + r32 - jn0 * KVBLK));
    near_run(c, (const char*)Kh + (size_t)jn0 * TSTEP, (const char*)Vh + (size_t)jn0 * TSTEP, jn1 - jn0, tabl, qr, m_reg, l_reg, o); }
#pragma unroll 1
  for (int rg = 0; rg < 2; ++rg) {
    int rr = rg; asm volatile("" : "+s"(rr));
    const int ja = rr ? jn1 : 0, nt = rr ? NT - jn1 : jn0;
    const float cfar = __uint_as_float(__builtin_amdgcn_readfirstlane(__float_as_uint(tab[rr ? 767 : 0])));
    if (nt > 0) far_run(c, (const char*)Kh + (size_t)ja * TSTEP, (const char*)Vh + (size_t)ja * TSTEP, nt, cfar, qr, m_reg, l_reg, o);
  }
  if (hi == 0) li_l[r32] = l_reg; asm volatile("s_waitcnt lgkmcnt(0)" ::: "memory");
  float rli[16];
#pragma unroll
  for (int r = 0; r < 16; ++r) rli[r] = __builtin_amdgcn_rcpf(li_l[crow(r, hi)]);
  int r32e = r32, hie = hi; asm volatile("" : "+v"(r32e), "+v"(hie));
  float* Ow = Ob + (long)(wid * QBLK) * LDO + (4 * hie) * LDO + r32e;
  if (SUBTRACT) {
    float g[8];
#pragma unroll
    for (int d0 = 0; d0 < 8; ++d0) g[d0] = sub_norm[d0 * 32 + r32e] * 0.8f;
    bf16_t* Dw = Dst + (long)(wid * QBLK + 4 * hie) * LDQ + r32e;
#pragma unroll
    for (int r = 0; r < 16; ++r) { float v[8]; float ss = 0.f;
#pragma unroll
      for (int d0 = 0; d0 < 8; ++d0) { v[d0] = Ow[((r & 3) + 8 * (r >> 2)) * LDO + d0 * 32] - lam * (o[d0][r] * rli[r]); ss += v[d0] * v[d0]; }
      ss += __shfl_xor(ss, 1); ss += __shfl_xor(ss, 2); ss += __shfl_xor(ss, 4); ss += __shfl_xor(ss, 8); ss += __shfl_xor(ss, 16);
      const float rs = rsqrtf(ss * (1.0f / 256.0f) + EPS);
#pragma unroll
      for (int d0 = 0; d0 < 8; ++d0) { const float w = v[d0] * rs * g[d0]; Dw[((r & 3) + 8 * (r >> 2)) * LDQ + d0 * 32] = (bf16_t)(cvt_pk_bf16(w, w) & 0xffffu); }
      asm volatile("" ::: "memory"); }
  } else {
#pragma unroll
    for (int r = 0; r < 16; ++r) {
#pragma unroll
      for (int d0 = 0; d0 < 8; ++d0) Ow[((r & 3) + 8 * (r >> 2)) * LDO + d0 * 32] = o[d0][r] * rli[r]; }
  }
  asm volatile("s_waitcnt vmcnt(0)" ::: "memory");
  __syncthreads();
}
}

__device__ void transpose_cvt(unsigned char* lds, const float* __restrict__ src, bf16_t* __restrict__ dst, int K, int N, int mode, int which, const float* __restrict__ gain = nullptr, int srcld = 0) {
    bf16_t* tile = (bf16_t*)lds;
    const int t = threadIdx.x, ntn = N / 64, ntiles = (K / 64) * ntn; if (srcld == 0) srcld = N;
    for (int tl = blockIdx.x; tl < ntiles; tl += gridDim.x) {
        const int tk = tl / ntn, tn = tl % ntn;
        const int kk = t >> 4, n4 = (t & 15) * 4;
#pragma unroll
        for (int i = 0; i < 2; ++i) { const int k = kk + 32 * i;
            f32x4 v = *(const f32x4*)(src + (size_t)(tk * 64 + k) * srcld + tn * 64 + n4);
            if (gain) v = v * gain[tk * 64 + k];
            const unsigned w0 = cvt_pk_bf16(v[0], v[1]), w1 = cvt_pk_bf16(v[2], v[3]);
            tile[(n4 + 0) * 72 + k] = (bf16_t)(w0 & 0xffff); tile[(n4 + 1) * 72 + k] = (bf16_t)(w0 >> 16);
            tile[(n4 + 2) * 72 + k] = (bf16_t)(w1 & 0xffff); tile[(n4 + 3) * 72 + k] = (bf16_t)(w1 >> 16); }
        __syncthreads();
        { const int n = t >> 3, k8 = (t & 7) * 8; const u32x4 v = *(const u32x4*)(tile + n * 72 + k8);
          const int gn = tn * 64 + n; const int drow = mode ? (gn >> 7) * 256 + which * 128 + (gn & 127) : gn;
          *(u32x4*)(dst + (size_t)drow * K + tk * 64 + k8) = v; }
        __syncthreads();
    }
}
__device__ void rmsnorm_rows(const float* __restrict__ src, const float* __restrict__ gain, bf16_t* __restrict__ dst) {
    const int lane = threadIdx.x & 63, gw = blockIdx.x * 8 + (threadIdx.x >> 6), nw = gridDim.x * 8;
    for (int row = gw; row < T; row += nw) {
        const f32x4* p = (const f32x4*)(src + (size_t)row * DM);
        f32x4 v[8]; float ss = 0.f;
#pragma unroll
        for (int j = 0; j < 8; ++j) { v[j] = p[lane + 64 * j]; ss += v[j][0] * v[j][0] + v[j][1] * v[j][1] + v[j][2] * v[j][2] + v[j][3] * v[j][3]; }
        ss = wave_sum(ss);
        const float rstd = rsqrtf(ss * (1.0f / DM) + EPS);
#pragma unroll
        for (int j = 0; j < 8; ++j) { const f32x4 g = ((const f32x4*)gain)[lane + 64 * j];
            u32x2 w; w.x = cvt_pk_bf16(v[j][0] * rstd * g[0], v[j][1] * rstd * g[1]); w.y = cvt_pk_bf16(v[j][2] * rstd * g[2], v[j][3] * rstd * g[3]);
            *(u32x2*)(dst + (size_t)row * DM + (lane + 64 * j) * 4) = w; }
    }
}
__device__ void cvt_rows(const float* __restrict__ src, bf16_t* __restrict__ dst, size_t n8) {
    for (size_t i = (size_t)blockIdx.x * 512 + threadIdx.x; i < n8; i += (size_t)gridDim.x * 512) {
        const f32x4 a = *(const f32x4*)(src + i * 8), b = *(const f32x4*)(src + i * 8 + 4);
        u32x4 w; w.x = cvt_pk_bf16(a[0], a[1]); w.y = cvt_pk_bf16(a[2], a[3]); w.z = cvt_pk_bf16(b[0], b[1]); w.w = cvt_pk_bf16(b[2], b[3]);
        *(u32x4*)(dst + i * 8) = w; }
}
__device__ void conv_qknorm(bf16_t* proj, const float* __restrict__ conv_w, const float* __restrict__ qg, const float* __restrict__ kg) {
    const int lane = threadIdx.x & 63, gw = blockIdx.x * 8 + (threadIdx.x >> 6), nw = gridDim.x * 8;
    for (int it = gw; it < (T / 16) * 2; it += nw) {
        const int t0 = (it >> 1) * 16, ch = (it & 1) * 512 + lane * 8;
        float w0[8], w1[8], w2[8];
#pragma unroll
        for (int e = 0; e < 8; ++e) { w0[e] = conv_w[ch + e]; w1[e] = conv_w[CW + ch + e]; w2[e] = conv_w[2 * CW + ch + e]; }
        float zp[8], zc[8], zn[8], fa[8], fc[8];
        if ((t0 % SEQ) == 0) {
#pragma unroll
            for (int e = 0; e < 8; ++e) zp[e] = 0.f;
        } else { const bf16_t* r = proj + (size_t)(t0 - 1) * INW + ch; unpack8(*(const u32x4*)r, fa);
#pragma unroll
            for (int e = 0; e < 8; ++e) zp[e] = fa[e]; }
        { const bf16_t* r = proj + (size_t)t0 * INW + ch; unpack8(*(const u32x4*)r, fa);
#pragma unroll
          for (int e = 0; e < 8; ++e) zc[e] = fa[e]; }
        for (int i = 0; i < 16; ++i) { const int t = t0 + i;
            if (((t + 1) % SEQ) == 0) {
#pragma unroll
                for (int e = 0; e < 8; ++e) zn[e] = 0.f;
            } else { const bf16_t* r = proj + (size_t)(t + 1) * INW + ch; unpack8(*(const u32x4*)r, fa);
#pragma unroll
                for (int e = 0; e < 8; ++e) zn[e] = fa[e]; }
            bf16_t* bp = proj + (size_t)t * INW + 2 * CW + ch; float fb[8]; unpack8(*(const u32x4*)bp, fb);
            float y[8];
#pragma unroll
            for (int e = 0; e < 8; ++e) y[e] = fb[e] * (w0[e] * zp[e] + w1[e] * zc[e] + w2[e] * zn[e]);
            u32x4 w; w.x = cvt_pk_bf16(y[0], y[1]); w.y = cvt_pk_bf16(y[2], y[3]); w.z = cvt_pk_bf16(y[4], y[5]); w.w = cvt_pk_bf16(y[6], y[7]);
            *(u32x4*)bp = w;
#pragma unroll
            for (int e = 0; e < 8; ++e) { zp[e] = zc[e]; zc[e] = zn[e]; }
        }
    }
    for (int t = gw; t < T; t += nw) {
        bf16_t* p = proj + (size_t)t * INW + 3 * CW;
#pragma unroll
        for (int j = 2; j < 4; ++j) { const int idx = (j * 64 + lane) * 8; float f[8]; unpack8(*(const u32x4*)(p + idx), f);
            float ss = 0.f;
#pragma unroll
            for (int e = 0; e < 8; ++e) ss += f[e] * f[e];
            ss += __shfl_xor(ss, 8); ss += __shfl_xor(ss, 4); ss += __shfl_xor(ss, 2); ss += __shfl_xor(ss, 1);
            const float rstd = rsqrtf(ss * (1.0f / 128.0f) + EPS);
            const float* g = (j < 2 ? qg : kg) + (idx & 127);
#pragma unroll
            for (int e = 0; e < 8; ++e) f[e] = f[e] * rstd * g[e];
            u32x4 w; w.x = cvt_pk_bf16(f[0], f[1]); w.y = cvt_pk_bf16(f[2], f[3]); w.z = cvt_pk_bf16(f[4], f[5]); w.w = cvt_pk_bf16(f[6], f[7]);
            *(u32x4*)(p + idx) = w; }
    }
}
__device__ void attn_post(bf16_t* proj, const float* __restrict__ sub_norm) {
    const int lane = threadIdx.x & 63, gw = blockIdx.x * 8 + (threadIdx.x >> 6), nw = gridDim.x * 8;
    const f32x4 g = ((const f32x4*)sub_norm)[lane];
    for (int t = gw; t < T; t += nw) {
        const f32x4* O = (const f32x4*)((const float*)proj + (size_t)t * (INW / 2));
        bf16_t* dst = proj + (size_t)t * INW + 3 * CW;
#pragma unroll
        for (int h = 0; h < NH; ++h) { const f32x4 v = O[h * 64 + lane];
            const float ss = wave_sum(v[0] * v[0] + v[1] * v[1] + v[2] * v[2] + v[3] * v[3]);
            const float rstd = rsqrtf(ss * (1.0f / 256.0f) + EPS) * 0.8f;
            u32x2 w; w.x = cvt_pk_bf16(v[0] * rstd * g[0], v[1] * rstd * g[1]); w.y = cvt_pk_bf16(v[2] * rstd * g[2], v[3] * rstd * g[3]);
            *(u32x2*)(dst + h * 256 + lane * 4) = w; }
    }
}
__device__ __forceinline__ int t5_bucket(int rel) {
    const int ret = rel > 0 ? 16 : 0; const int n = rel < 0 ? -rel : rel;
    if (n < 8) return ret + n;
    int large = 8 + (int)(logf((float)n * 0.125f) / 2.7725887f * 8.0f);
    large = large < 15 ? large : 15;
    return ret + large;
}

#define XB_TMO      128
#define XB_XCNT(j)  (256  + 64 * (j))
#define XB_XSUB(j)  (1280 + 64 * (j))
#define XB_XGEN(j)  (2304 + 64 * (j))
#define XB_TOP      3328
#define XB_TOPGEN   3392
#define XCD_BAR_WORDS 3456
#define XB_SPIN_CAP (1u << 18)

__device__ __forceinline__ unsigned xb_ld(unsigned* p)              { return __hip_atomic_load(p, __ATOMIC_RELAXED, __HIP_MEMORY_SCOPE_AGENT); }
__device__ __forceinline__ unsigned xb_add(unsigned* p, unsigned v) { return __hip_atomic_fetch_add(p, v, __ATOMIC_RELAXED, __HIP_MEMORY_SCOPE_AGENT); }
__device__ __forceinline__ unsigned xb_xcc_id() { return (unsigned)__builtin_amdgcn_s_getreg((3 << 11) | 20) & 0xFu; }
#define XB_SPIN(cond, bar) do { unsigned _sp = 0; while (cond) { __builtin_amdgcn_s_sleep(1); \
    if ((++_sp & 255u) == 0u) { if (xb_ld(&(bar)[XB_TMO])) break; if (_sp > XB_SPIN_CAP) { atomicAdd(&(bar)[XB_TMO], 1u); break; } } } } while (0)

struct XcdBarrier {
    unsigned* bar; unsigned x;
    volatile LAS unsigned* st;
};

__device__ __forceinline__ XcdBarrier xcd_barrier_post(unsigned* bar, volatile LAS unsigned* st) {
    XcdBarrier b; b.bar = bar; b.x = xb_xcc_id(); b.st = st;
    if (threadIdx.x == 0) (void)xb_add(&bar[XB_XCNT(b.x)], 1u);
    return b;
}
__device__ __forceinline__ void xcd_barrier_complete(unsigned* bar, unsigned x, unsigned& nloc, unsigned& nx) {
    const unsigned G = gridDim.x * gridDim.y * gridDim.z;
    unsigned sum, cnt, mine, sp = 0u;
    for (;;) {
        sum = 0u; cnt = 0u; mine = 0u;
#pragma unroll
        for (unsigned j = 0; j < 16; ++j) { const unsigned c = xb_ld(&bar[XB_XCNT(j)]); sum += c; cnt += (c > 0u) ? 1u : 0u; mine = (j == x) ? c : mine; }
        if (sum == G) break;
        __builtin_amdgcn_s_sleep(1);
        if ((++sp & 255u) == 0u) { if (xb_ld(&bar[XB_TMO])) break; if (sp > XB_SPIN_CAP) { atomicAdd(&bar[XB_TMO], 1u); break; } }
    }
    nloc = mine > 0u ? mine : 1u; nx = cnt > 0u ? cnt : 1u;
}

__device__ __forceinline__ void xcd_barrier(const XcdBarrier& b) {
    asm volatile("s_waitcnt vmcnt(0)" ::: "memory");
    __syncthreads();
    if (threadIdx.x == 0) {
        unsigned* bar = b.bar;
        __builtin_amdgcn_s_waitcnt(0);
        unsigned nloc = b.st[0], nx = b.st[1];
        if (nloc == 0u) { xcd_barrier_complete(bar, b.x, nloc, nx); b.st[0] = nloc; b.st[1] = nx; }
        const unsigned old = xb_add(&bar[XB_XSUB(b.x)], 1u);
        const unsigned gen = old / nloc;
        if (old + 1u == (gen + 1u) * nloc) {
            __builtin_amdgcn_fence(__ATOMIC_RELEASE, "agent");
            asm volatile("s_waitcnt vmcnt(0)" ::: "memory");
            const unsigned og = xb_add(&bar[XB_TOP], 1u);
            const unsigned tg = og / nx;
            if (og + 1u == (tg + 1u) * nx) xb_add(&bar[XB_TOPGEN], 1u);
            else XB_SPIN(xb_ld(&bar[XB_TOPGEN]) == tg, bar);
            __builtin_amdgcn_fence(__ATOMIC_ACQUIRE, "agent");
            xb_add(&bar[XB_XGEN(b.x)], 1u);
            asm volatile("s_waitcnt vmcnt(0)" ::: "memory");
        } else {
            XB_SPIN(xb_ld(&bar[XB_XGEN(b.x)]) == gen, bar);
            __builtin_amdgcn_fence(__ATOMIC_ACQUIRE, "agent");
            asm volatile("s_waitcnt vmcnt(0)" ::: "memory");
        }
    }
    __syncthreads();
}

__global__ void __launch_bounds__(512, 2) mega(Params P) {
    extern __shared__ __attribute__((aligned(16))) unsigned char lds[];
    cg::grid_group grid = cg::this_grid();
    LAS unsigned char* ldsl = (LAS unsigned char*)lds;
    const int G = gridDim.x, lo = P.ph_lo, hi = P.ph_hi;
    volatile LAS unsigned* xbst = (volatile LAS unsigned*)(ldsl + LDS_XB);
    if (threadIdx.x < 4) xbst[threadIdx.x] = 0u;
    __syncthreads();
    unsigned char* ws = P.ws;
    const float* x = P.in[0]; const float* pin = P.in[1];
    bf16_t* W13_1 = (bf16_t*)(ws + WS_W13_1); bf16_t* W2_1 = (bf16_t*)(ws + WS_W2_1); bf16_t* W13_2 = (bf16_t*)(ws + WS_W13_2); bf16_t* W2_2 = (bf16_t*)(ws + WS_W2_2);
    bf16_t* WIG = (bf16_t*)(ws + WS_WIG); bf16_t* WA = (bf16_t*)(ws + WS_WA); bf16_t* WB = (bf16_t*)(ws + WS_WB); bf16_t* WO = (bf16_t*)(ws + WS_WO);
    bf16_t* WPG = (bf16_t*)(ws + WS_WPG); bf16_t* WPP = (bf16_t*)(ws + WS_WPP);
    bf16_t* RA = (bf16_t*)(ws + WS_A); bf16_t* PROJ = (bf16_t*)(ws + WS_PROJ); bf16_t* GATES = (bf16_t*)(ws + WS_GATES); bf16_t* GB = (bf16_t*)(ws + WS_G);
    bf16_t* PP = (bf16_t*)(ws + WS_PP); bf16_t* P16 = (bf16_t*)(ws + WS_P16); bf16_t* RB = (bf16_t*)(ws + WS_RB);
    float* RSS1 = (float*)(ws + WS_RSS); float* RSS2 = RSS1 + T; float* RSS3 = RSS2 + T;
    float* out = P.out;
#ifndef PHASE_MASK
#define PHASE_MASK 0x1FFFF
#endif
#define IN(k) (((PHASE_MASK >> (k)) & 1) && lo <= (k) && (k) < hi)
#define SYNC(k) do { if (lo <= (k) && (k) + 1 < hi) xcd_barrier(xbar); } while (0)

    if (IN(0)) {
        for (int i = blockIdx.x * 512 + threadIdx.x; i < 3 * T; i += G * 512) RSS1[i] = 0.f;
        if (blockIdx.x == 0) for (int i = threadIdx.x; i < XCD_BAR_WORDS; i += 512) ((unsigned*)(ws + WS_XBAR))[i] = 0u;
        cvt_rows(pin, P16, (size_t)T * PLE / 8);
        transpose_cvt(lds, P.in[3], W13_1, DM, FF, 1, 0); transpose_cvt(lds, P.in[4], W13_1, DM, FF, 1, 1); transpose_cvt(lds, P.in[5], W2_1, FF, DM, 0, 0);
        transpose_cvt(lds, P.in[22], W13_2, DM, FF, 1, 0, P.in[21]); transpose_cvt(lds, P.in[23], W13_2, DM, FF, 1, 1, P.in[21]); transpose_cvt(lds, P.in[24], W2_2, FF, DM, 0, 0);
        transpose_cvt(lds, P.in[7], WIG, DM, CW, 1, 0, P.in[6], INW); transpose_cvt(lds, P.in[7] + CW, WIG, DM, CW, 1, 1, P.in[6], INW);
        transpose_cvt(lds, P.in[7] + 2 * CW, WIG + (size_t)2 * CW * DM, DM, INW - 2 * CW, 0, 0, P.in[6], INW); transpose_cvt(lds, P.in[19], WIG + (size_t)INW * DM, DM, 2 * DM, 0, 0, P.in[6]);
        transpose_cvt(lds, P.in[17], WA, CW, DM, 0, 0); transpose_cvt(lds, P.in[18], WB, AW, DM, 0, 0);
        transpose_cvt(lds, P.in[20], WO, DM, DM, 0, 0); transpose_cvt(lds, P.in[26], WPG, DM, DM, 0, 0, P.in[25]); transpose_cvt(lds, P.in[27], WPP, PLE, DM, 0, 0);
        rmsnorm_rows(x, P.in[2], RA);
    }
    if (lo <= 0 && 1 < hi) grid.sync();
    XcdBarrier xbar = xcd_barrier_post((unsigned*)(ws + WS_XBAR), xbst);
    if (IN(1)) { pg8::Gemm g{RA, W13_1, T, 2 * FF, DM, DM}; pg8::StaticOrder S; S.init(T, 2 * FF, G, (int)blockIdx.x); pg8::EpiSwiGLU E{GB, FF, nullptr}; pg8::gemm_phase(ldsl, g, S, E); }
    SYNC(1);
    if (IN(2)) { pg8::Gemm g{GB, W2_1, T, DM, FF, FF}; pg8::StaticOrder S; S.init(T, DM, G, (int)blockIdx.x); pg8::EpiRes<false> E{x, DM, 0.5f, RA, RSS1}; pg8::gemm_phase(ldsl, g, S, E); }
    SYNC(2);
    if (IN(4)) { pg8::Gemm g{RA, WIG, T, INW + 2 * DM, DM, DM}; pg8::StaticOrder S; S.init(T, INW + 2 * DM, G, (int)blockIdx.x); pg8::EpiProjGate E{PROJ, INW, GATES, 2 * DM, INW / 256, RSS1}; pg8::gemm_phase(ldsl, g, S, E); }
    SYNC(4);
    if (IN(5)) conv_qknorm(PROJ, P.in[8], P.in[9], P.in[10]);
    SYNC(5);
    if (IN(6)) {
        LAS float* tab = (LAS float*)(ldsl + att2::OFF_TAB);
        float s1 = 0.f, s2 = 0.f;
        { const int l = threadIdx.x & 63; s1 = P.in[11][l] * P.in[12][l] + P.in[11][l + 64] * P.in[12][l + 64]; s2 = P.in[13][l] * P.in[14][l] + P.in[13][l + 64] * P.in[14][l + 64]; s1 = wave_sum(s1); s2 = wave_sum(s2); }
        const float lam = __uint_as_float(__builtin_amdgcn_readfirstlane(__float_as_uint(__expf(s1) - __expf(s2) + 0.2f)));
        for (int it = blockIdx.x; it < NB * NH * (SEQ / 256); it += G) {
            const int bh = it & 7, qb = it >> 3, b = bh >> 2, h = bh & 3, q0 = qb * 256;
            __syncthreads();
            for (int i = threadIdx.x; i < 768; i += 512) tab[i] = P.in[16][t5_bucket(i - 384) * NH + h] * (1.0f / att::SCALE);
            __syncthreads();
            const bf16_t* rowq = PROJ + (size_t)(b * SEQ + q0) * INW; const bf16_t* rowk = PROJ + (size_t)(b * SEQ) * INW;
            float* Ob = (float*)PROJ + (size_t)(b * SEQ + q0) * (INW / 2) + h * 256;
#pragma unroll 1
            for (int sub = 0; sub < 2; ++sub) {
                int sb = sub; asm volatile("" : "+s"(sb));
                int seqv = SEQ; asm volatile("" : "+s"(seqv));
                att2::attn_body(rowq + 3 * CW + h * 256 + sb * 128, rowk + 4 * CW + h * 256 + sb * 128, rowk + 5 * CW + h * 256, Ob, seqv, q0, lam, sb != 0, ldsl, (bf16_t*)rowq + 3 * CW + h * 256, P.in[15], P.in[9]);
            }
        }
    }
    SYNC(6);
    if (IN(8)) { pg8::Gemm g{PROJ + 2 * CW, WA, T, DM, CW, INW}; pg8::StaticOrder S; S.init(T, DM, G, (int)blockIdx.x); pg8::EpiGated<false> E{PROJ + 4 * CW, INW, (const unsigned char*)GATES, 2 * DM, 0}; pg8::gemm_phase(ldsl, g, S, E); }
    if (IN(9)) { pg8::Gemm g{PROJ + 3 * CW, WB, T, DM, AW, INW}; pg8::StaticOrder S; S.init(T, DM, G, (int)blockIdx.x); pg8::EpiGated<true> E{PROJ + 4 * CW, INW, (const unsigned char*)GATES, 2 * DM, DM}; pg8::gemm_phase(ldsl, g, S, E); }
    SYNC(9);
    if (IN(10)) { pg8::Gemm g{PROJ + 4 * CW, WO, T, DM, DM, INW}; pg8::StaticOrder S; S.init(T, DM, G, (int)blockIdx.x); pg8::EpiRes<true> E{RA, DM, 1.0f, RB, RSS2}; pg8::gemm_phase(ldsl, g, S, E); }
    SYNC(10);
    if (IN(12)) { pg8::Gemm g{RB, W13_2, T, 2 * FF, DM, DM}; pg8::StaticOrder S; S.init(T, 2 * FF, G, (int)blockIdx.x); pg8::EpiSwiGLU E{GB, FF, RSS2}; pg8::gemm_phase(ldsl, g, S, E); }
    SYNC(12);
    if (IN(13)) { pg8::Gemm g{GB, W2_2, T, DM, FF, FF}; pg8::StaticOrder S; S.init(T, DM, G, (int)blockIdx.x); pg8::EpiRes<true> E{RB, DM, 0.5f, RA, RSS3}; pg8::gemm_phase(ldsl, g, S, E); }
    if (IN(15)) { pg8::Gemm g{P16, WPP, T, DM, PLE, PLE}; pg8::StaticOrder S; S.init(T, DM, G, (int)blockIdx.x); pg8::EpiBf16NP E{PP, DM}; pg8::gemm_phase(ldsl, g, S, E); }
    SYNC(13);
    if (IN(16)) { pg8::Gemm g{RA, WPG, T, DM, DM, DM}; pg8::StaticOrder S; S.init(T, DM, G, (int)blockIdx.x); pg8::EpiFinal E{RA, out, DM, PP, RSS3}; pg8::gemm_phase(ldsl, g, S, E); }
#undef IN
#undef SYNC
}

extern "C" void kernel_launch(void* const* d_in, const int* in_sizes, int n_in, void* d_out, int out_size, void* d_ws, size_t ws_size, hipStream_t stream) {
    static int grid_blocks = 0;
    if (grid_blocks == 0) {
        if (n_in != 28 || in_sizes[0] != T * DM || out_size != T * DM || ws_size < WS_END) {
            fprintf(stderr, "kernel_launch: shape/workspace mismatch: n_in %d in0 %d out %d ws %zu (need %zu)\n", n_in, n_in > 0 ? in_sizes[0] : -1, out_size, ws_size, (size_t)WS_END); grid_blocks = -1; return; }
        int dev = 0, cus = 0, per_cu = 0;
        hipGetDevice(&dev); hipDeviceGetAttribute(&cus, hipDeviceAttributeMultiprocessorCount, dev);
        if (hipFuncSetAttribute((const void*)mega, hipFuncAttributeMaxDynamicSharedMemorySize, LDS_BYTES) != hipSuccess) { fprintf(stderr, "kernel_launch: hipFuncSetAttribute failed\n"); grid_blocks = -1; return; }
        if (hipOccupancyMaxActiveBlocksPerMultiprocessor(&per_cu, (const void*)mega, 512, LDS_BYTES) != hipSuccess || per_cu < 1) { fprintf(stderr, "kernel_launch: occupancy query says %d\n", per_cu); per_cu = 1; }
        (void)hipGetLastError();
        grid_blocks = cus * 1;
        if (grid_blocks % 8 != 0) grid_blocks -= grid_blocks % 8;
    }
    if (grid_blocks < 0) return;
    Params p{};
    for (int i = 0; i < 28; ++i) p.in[i] = (const float*)d_in[i];
    p.out = (float*)d_out; p.ws = (unsigned char*)d_ws; p.ph_lo = 0; p.ph_hi = 17;
    void* args[] = {&p};
    hipError_t e = hipLaunchCooperativeKernel((const void*)mega, dim3(grid_blocks), dim3(512), args, LDS_BYTES, stream);
    if (e != hipSuccess) fprintf(stderr, "cooperative launch failed: %s (grid %d)\n", hipGetErrorString(e), grid_blocks);
}
```

```cpp
#include <hip/hip_runtime.h>
#include <hip/hip_cooperative_groups.h>
#include <cstdio>
#include <cstdint>
namespace cg = cooperative_groups;

#define LAS __attribute__((address_space(3)))
typedef unsigned short bf16_t;
typedef short bf16x8 __attribute__((ext_vector_type(8)));
typedef short s16x4 __attribute__((ext_vector_type(4)));
typedef float f32x2 __attribute__((ext_vector_type(2)));
typedef float f32x4 __attribute__((ext_vector_type(4)));
typedef float f32x16 __attribute__((ext_vector_type(16)));
typedef unsigned u32x2 __attribute__((ext_vector_type(2)));
typedef unsigned u32x4 __attribute__((ext_vector_type(4)));

constexpr int DM = 2048, NB = 2, SEQ = 16384, T = NB * SEQ, FF = 5632, CW = 1024, AW = 1024, INW = 6144, PLE = 256, NH = 4;
constexpr float EPS = 1e-6f;
constexpr int LDS_XB = 2 * 16384 + 3 * 32768 + 2048 + 768 * 4;
constexpr int LDS_BYTES = LDS_XB + 16;

constexpr size_t SZ_W13 = (size_t)2 * FF * DM * 2, SZ_W2 = (size_t)DM * FF * 2;
constexpr size_t WS_W13_1 = 0, WS_W2_1 = WS_W13_1 + SZ_W13, WS_W13_2 = WS_W2_1 + SZ_W2, WS_W2_2 = WS_W13_2 + SZ_W13;
constexpr size_t WS_WIG = WS_W2_2 + SZ_W2;
constexpr size_t WS_WA = WS_WIG + (size_t)(INW + 2 * DM) * DM * 2;
constexpr size_t WS_WB = WS_WA + (size_t)DM * CW * 2;
constexpr size_t WS_WO = WS_WB + (size_t)DM * AW * 2;
constexpr size_t WS_WPG = WS_WO + (size_t)DM * DM * 2;
constexpr size_t WS_WPP = WS_WPG + (size_t)DM * DM * 2;
constexpr size_t WS_A = WS_WPP + (size_t)DM * PLE * 2;
constexpr size_t WS_BIG = WS_A + (size_t)T * DM * 2;
constexpr size_t WS_PROJ = WS_BIG;
constexpr size_t WS_GATES = WS_PROJ + (size_t)T * INW * 2;
constexpr size_t WS_G = WS_BIG;
constexpr size_t WS_PP = WS_GATES + (size_t)T * DM * 2;
constexpr size_t WS_RB = WS_GATES;
constexpr size_t WS_P16 = WS_GATES + (size_t)T * 2 * DM * 2;
constexpr size_t WS_RSS = WS_P16 + (size_t)T * PLE * 2;
constexpr size_t WS_XBAR = WS_RSS + (size_t)3 * T * 4;
constexpr size_t WS_END = WS_XBAR + 16384;

struct Params { const float* in[28]; float* out; unsigned char* ws; int ph_lo, ph_hi; };

__device__ __forceinline__ unsigned cvt_pk_bf16(float lo, float hi) { unsigned r; asm volatile("v_cvt_pk_bf16_f32 %0, %1, %2" : "=v"(r) : "v"(lo), "v"(hi)); return r; }
__device__ __forceinline__ float bf_lo(unsigned w) { return __uint_as_float(w << 16); }
__device__ __forceinline__ float bf_hi(unsigned w) { return __uint_as_float(w & 0xffff0000u); }
__device__ __forceinline__ float sigmoidf_(float x) { return __builtin_amdgcn_rcpf(1.0f + __expf(-x)); }
__device__ __forceinline__ void unpack8(const u32x4 w, float* f) { f[0] = bf_lo(w.x); f[1] = bf_hi(w.x); f[2] = bf_lo(w.y); f[3] = bf_hi(w.y); f[4] = bf_lo(w.z); f[5] = bf_hi(w.z); f[6] = bf_lo(w.w); f[7] = bf_hi(w.w); }
__device__ __forceinline__ float wave_sum(float s) {
    s += __shfl_xor(s, 32); s += __shfl_xor(s, 16); s += __shfl_xor(s, 8); s += __shfl_xor(s, 4); s += __shfl_xor(s, 2); s += __shfl_xor(s, 1); return s; }

namespace pg8 {
constexpr int BM = 256, BK = 64, HALF = 128, HTB = HALF * BK * 2, STAGE_BYTES = 8 * HTB, NXCD = 8, WGM = 8;
__device__ __forceinline__ int lds_byte(int r, int c) { const int st = (r >> 4) * 2 + (c >> 5), rr = r & 15, cc = c & 31, ob = rr * 64 + cc * 2; return st * 1024 + (ob ^ (((ob >> 9) & 1) << 5)); }
__device__ __forceinline__ void stage_rc(int b, int& R, int& C) { const int st = b / 1024, sb = b % 1024, swz = sb ^ (((sb >> 9) & 1) << 5); R = (st >> 1) * 16 + swz / 64; C = (st & 1) * 32 + (swz % 64) / 2; }
__device__ __forceinline__ int perm32(int rho) { const int n = rho >> 4, i = rho & 15; return 8 * (i >> 2) + 4 * n + (i & 3); }

struct Unit { int pm, pn; };
struct Gemm { const bf16_t* A; const bf16_t* Bt; int M, N, K, lda; };

struct StaticOrder {
    int nM, nN, nwg, G, c, wgm;
    __device__ void init(int M, int N, int G_, int c_) { nM = M / BM; nN = N / BM; nwg = nM * nN; G = G_; c = c_; wgm = nN <= 8 ? 4 : WGM; }
    __device__ bool next(int i, Unit& u) const {
        const long L = (long)i * G + c; if (L >= nwg) return false;
        int wgid = (int)L; { const int q = nwg / NXCD, r = nwg % NXCD, xcd = wgid % NXCD, off = wgid / NXCD; wgid = (xcd < r ? xcd * (q + 1) : r * (q + 1) + (xcd - r) * q) + off; }
        const int nig = wgm * nN, gid = wgid / nig, fm = gid * wgm, gsz = (nM - fm) < wgm ? (nM - fm) : wgm;
        u.pm = fm + ((wgid % nig) % gsz); u.pn = (wgid % nig) / gsz; return true;
    }
};

typedef f32x4 Acc[2][2][4][2];

template <bool USE> struct EpiSwiGLU {
    static constexpr bool PERM = true;
    bf16_t* O; int ldc; const float* rss;
    __device__ __forceinline__ void operator()(const Acc& acc, const Unit& u, int wr, int wc, int fr, int fq) const {
        const int row0 = u.pm * BM + wr * 64 + fr, col0 = u.pn * HALF + wc * 32 + 8 * fq;
        float rsv[2][4];
        if (USE) {
#pragma unroll
            for (int ai = 0; ai < 2; ++ai)
#pragma unroll
                for (int m = 0; m < 4; ++m) rsv[ai][m] = rss[row0 + ai * HALF + m * 16];
        }
#pragma unroll
        for (int ai = 0; ai < 2; ++ai)
#pragma unroll
            for (int m = 0; m < 4; ++m) {
                const int row = row0 + ai * HALF + m * 16;
                const float rs = USE ? rsqrtf(rsv[ai][m] * (1.0f / DM) + EPS) : 1.0f;
                const float ce = -1.4426950408889634f * rs, c2 = rs * rs;
                bf16_t* rowp = O + (size_t)row * ldc + col0;
                float v[8];
#pragma unroll
                for (int n = 0; n < 2; ++n)
#pragma unroll
                    for (int j = 0; j < 4; ++j) { const float g = acc[ai][0][m][n][j], up = acc[ai][1][m][n][j];
                        const float r = __builtin_amdgcn_rcpf(1.0f + __builtin_amdgcn_exp2f(g * ce));
                        v[n * 4 + j] = USE ? (g * up) * (c2 * r) : (g * up) * r; }
                u32x4 w; w.x = cvt_pk_bf16(v[0], v[1]); w.y = cvt_pk_bf16(v[2], v[3]); w.z = cvt_pk_bf16(v[4], v[5]); w.w = cvt_pk_bf16(v[6], v[7]);
                *(u32x4*)rowp = w;
            }
    }
};
template <bool BASE_BF16> struct EpiRes {
    static constexpr bool PERM = true;
    const void* base; int ldc; float alpha; bf16_t* obf; float* rss;
    __device__ __forceinline__ void operator()(const Acc& acc, const Unit& u, int wr, int wc, int fr, int fq) const {
        const int row0 = u.pm * BM + wr * 64 + fr, col0 = u.pn * BM + wc * 32 + 8 * fq;
#pragma unroll
        for (int ai = 0; ai < 2; ++ai) {
            u32x4 wb[4][2]; f32x4 fb0[4][2], fb1[4][2];
#pragma unroll
            for (int m = 0; m < 4; ++m) { const size_t off = (size_t)(row0 + ai * HALF + m * 16) * ldc + col0;
#pragma unroll
                for (int bj = 0; bj < 2; ++bj) {
                    if (BASE_BF16) wb[m][bj] = *(const u32x4*)((const bf16_t*)base + off + bj * HALF);
                    else { fb0[m][bj] = *(const f32x4*)((const float*)base + off + bj * HALF); fb1[m][bj] = *(const f32x4*)((const float*)base + off + bj * HALF + 4); } } }
#pragma unroll
            for (int m = 0; m < 4; ++m) { const int row = row0 + ai * HALF + m * 16; const size_t off = (size_t)row * ldc + col0; float ss = 0.f;
#pragma unroll
                for (int bj = 0; bj < 2; ++bj) {
                    f32x4 b0, b1;
                    if (BASE_BF16) { const u32x4 w = wb[m][bj]; b0 = (f32x4){bf_lo(w.x), bf_hi(w.x), bf_lo(w.y), bf_hi(w.y)}; b1 = (f32x4){bf_lo(w.z), bf_hi(w.z), bf_lo(w.w), bf_hi(w.w)}; }
                    else { b0 = fb0[m][bj]; b1 = fb1[m][bj]; }
                    const f32x4 r0 = b0 + alpha * acc[ai][bj][m][0], r1 = b1 + alpha * acc[ai][bj][m][1];
                    ss += ((r0[0] * r0[0] + r0[1] * r0[1]) + (r0[2] * r0[2] + r0[3] * r0[3])) + ((r1[0] * r1[0] + r1[1] * r1[1]) + (r1[2] * r1[2] + r1[3] * r1[3]));
                    u32x4 w; w.x = cvt_pk_bf16(r0[0], r0[1]); w.y = cvt_pk_bf16(r0[2], r0[3]); w.z = cvt_pk_bf16(r1[0], r1[1]); w.w = cvt_pk_bf16(r1[2], r1[3]);
                    *(u32x4*)(obf + off + bj * HALF) = w; }
                ss += __shfl_xor(ss, 16); ss += __shfl_xor(ss, 32);
                if (fq == 0) atomicAdd(rss + row, ss); }
            asm volatile("" ::: "memory"); }
    }
};
struct EpiProjGate {
    static constexpr bool PERM = true;
    bf16_t* O0; int ld0; bf16_t* O1; int ld1; int nsplit; const float* rss;
    __device__ __forceinline__ void operator()(const Acc& acc, const Unit& u, int wr, int wc, int fr, int fq) const {
        const bool gate = u.pn >= nsplit;
        bf16_t* base = gate ? O1 : O0; const int ldc = gate ? ld1 : ld0;
        const int row0 = u.pm * BM + wr * 64 + fr, col0 = (gate ? u.pn - nsplit : u.pn) * BM + wc * 32 + 8 * fq;
        float rsv[2][4];
#pragma unroll
        for (int ai = 0; ai < 2; ++ai)
#pragma unroll
            for (int m = 0; m < 4; ++m) rsv[ai][m] = rss[row0 + ai * HALF + m * 16];
#pragma unroll
        for (int ai = 0; ai < 2; ++ai)
#pragma unroll
            for (int m = 0; m < 4; ++m) { const int row = row0 + ai * HALF + m * 16; bf16_t* rowp = base + (size_t)row * ldc + col0;
                const float rs = rsqrtf(rsv[ai][m] * (1.0f / DM) + EPS);
                if (u.pn < 8) {
                    const float rs2 = rs * rs; const f32x4 z0 = acc[ai][0][m][0] * acc[ai][1][m][0] * rs2, z1 = acc[ai][0][m][1] * acc[ai][1][m][1] * rs2;
                    u32x4 w; w.x = cvt_pk_bf16(z0[0], z0[1]); w.y = cvt_pk_bf16(z0[2], z0[3]); w.z = cvt_pk_bf16(z1[0], z1[1]); w.w = cvt_pk_bf16(z1[2], z1[3]);
                    *(u32x4*)(O0 + (size_t)row * ld0 + u.pn * HALF + wc * 32 + 8 * fq) = w;
                    continue; }
#pragma unroll
                for (int bj = 0; bj < 2; ++bj) { f32x4 v0 = acc[ai][bj][m][0] * rs, v1 = acc[ai][bj][m][1] * rs;
                    if (gate) {
#pragma unroll
                        for (int j = 0; j < 4; ++j) { v0[j] = sigmoidf_(v0[j]); v1[j] = sigmoidf_(v1[j]); } }
                    u32x4 w; w.x = cvt_pk_bf16(v0[0], v0[1]); w.y = cvt_pk_bf16(v0[2], v0[3]); w.z = cvt_pk_bf16(v1[0], v1[1]); w.w = cvt_pk_bf16(v1[2], v1[3]);
                    *(u32x4*)(rowp + bj * HALF) = w; } }
    }
};
template <bool ADD> struct EpiGated {
    static constexpr bool PERM = true;
    bf16_t* O; int ldc; const bf16_t* gate; int ldg; int goff;
    __device__ __forceinline__ void operator()(const Acc& acc, const Unit& u, int wr, int wc, int fr, int fq) const {
        const int row0 = u.pm * BM + wr * 64 + fr, col0 = u.pn * BM + wc * 32 + 8 * fq;
#pragma unroll
        for (int ai = 0; ai < 2; ++ai) {
            u32x4 g[4][2], pv[4][2];
#pragma unroll
            for (int m = 0; m < 4; ++m) { const size_t r = (size_t)(row0 + ai * HALF + m * 16);
#pragma unroll
                for (int bj = 0; bj < 2; ++bj) { g[m][bj] = *(const u32x4*)(gate + r * ldg + goff + col0 + bj * HALF); if (ADD) pv[m][bj] = *(const u32x4*)(O + r * ldc + col0 + bj * HALF); } }
#pragma unroll
            for (int m = 0; m < 4; ++m) { const size_t r = (size_t)(row0 + ai * HALF + m * 16);
#pragma unroll
                for (int bj = 0; bj < 2; ++bj) { const f32x4 v0 = acc[ai][bj][m][0], v1 = acc[ai][bj][m][1]; const u32x4 gg = g[m][bj];
                    float o[8] = {bf_lo(gg.x) * v0[0], bf_hi(gg.x) * v0[1], bf_lo(gg.y) * v0[2], bf_hi(gg.y) * v0[3], bf_lo(gg.z) * v1[0], bf_hi(gg.z) * v1[1], bf_lo(gg.w) * v1[2], bf_hi(gg.w) * v1[3]};
                    if (ADD) { const u32x4 p = pv[m][bj];
                        o[0] += bf_lo(p.x); o[1] += bf_hi(p.x); o[2] += bf_lo(p.y); o[3] += bf_hi(p.y); o[4] += bf_lo(p.z); o[5] += bf_hi(p.z); o[6] += bf_lo(p.w); o[7] += bf_hi(p.w); }
                    u32x4 w; w.x = cvt_pk_bf16(o[0], o[1]); w.y = cvt_pk_bf16(o[2], o[3]); w.z = cvt_pk_bf16(o[4], o[5]); w.w = cvt_pk_bf16(o[6], o[7]);
                    *(u32x4*)(O + r * ldc + col0 + bj * HALF) = w; } }
            asm volatile("" ::: "memory"); }
    }
};
struct EpiBf16NP {
    static constexpr bool PERM = true;
    bf16_t* O; int ldc;
    __device__ __forceinline__ void operator()(const Acc& acc, const Unit& u, int wr, int wc, int fr, int fq) const {
        const int row0 = u.pm * BM + wr * 64 + fr, col0 = u.pn * BM + wc * 32 + 8 * fq;
#pragma unroll
        for (int ai = 0; ai < 2; ++ai)
#pragma unroll
            for (int m = 0; m < 4; ++m) { const size_t off = (size_t)(row0 + ai * HALF + m * 16) * ldc + col0;
#pragma unroll
                for (int bj = 0; bj < 2; ++bj) { const f32x4 v0 = acc[ai][bj][m][0], v1 = acc[ai][bj][m][1];
                    u32x4 w; w.x = cvt_pk_bf16(v0[0], v0[1]); w.y = cvt_pk_bf16(v0[2], v0[3]); w.z = cvt_pk_bf16(v1[0], v1[1]); w.w = cvt_pk_bf16(v1[2], v1[3]);
                    *(u32x4*)(O + off + bj * HALF) = w; } }
    }
};
struct EpiFinal {
    static constexpr bool PERM = true;
    const bf16_t* base; float* out; int ldc; const bf16_t* pp; const float* rss;
    __device__ __forceinline__ void operator()(const Acc& acc, const Unit& u, int wr, int wc, int fr, int fq) const {
        const int row0 = u.pm * BM + wr * 64 + fr, col0 = u.pn * BM + wc * 32 + 8 * fq;
        float rsv[2][4];
#pragma unroll
        for (int ai = 0; ai < 2; ++ai)
#pragma unroll
            for (int m = 0; m < 4; ++m) rsv[ai][m] = rss[row0 + ai * HALF + m * 16];
#pragma unroll
        for (int ai = 0; ai < 2; ++ai) {
            u32x4 bs[4][2], pw[4][2];
#pragma unroll
            for (int m = 0; m < 4; ++m) { const size_t off = (size_t)(row0 + ai * HALF + m * 16) * ldc + col0;
#pragma unroll
                for (int bj = 0; bj < 2; ++bj) { bs[m][bj] = *(const u32x4*)(base + off + bj * HALF); pw[m][bj] = *(const u32x4*)(pp + off + bj * HALF); } }
#pragma unroll
            for (int m = 0; m < 4; ++m) { const int row = row0 + ai * HALF + m * 16; const size_t off = (size_t)row * ldc + col0; const float rs = rsqrtf(rsv[ai][m] * (1.0f / DM) + EPS);
#pragma unroll
                for (int bj = 0; bj < 2; ++bj) { const u32x4 bw = bs[m][bj], q = pw[m][bj]; const f32x4 a0 = acc[ai][bj][m][0] * rs, a1 = acc[ai][bj][m][1] * rs;
                    f32x4 r0, r1;
                    r0[0] = bf_lo(bw.x) + sigmoidf_(a0[0]) * bf_lo(q.x); r0[1] = bf_hi(bw.x) + sigmoidf_(a0[1]) * bf_hi(q.x); r0[2] = bf_lo(bw.y) + sigmoidf_(a0[2]) * bf_lo(q.y); r0[3] = bf_hi(bw.y) + sigmoidf_(a0[3]) * bf_hi(q.y);
                    r1[0] = bf_lo(bw.z) + sigmoidf_(a1[0]) * bf_lo(q.z); r1[1] = bf_hi(bw.z) + sigmoidf_(a1[1]) * bf_hi(q.z); r1[2] = bf_lo(bw.w) + sigmoidf_(a1[2]) * bf_lo(q.w); r1[3] = bf_hi(bw.w) + sigmoidf_(a1[3]) * bf_hi(q.w);
                    *(f32x4*)(out + off + bj * HALF) = r0; *(f32x4*)(out + off + bj * HALF + 4) = r1; } }
            asm volatile("" ::: "memory"); }
    }
};

template <class Epi>
__device__ __forceinline__ void gemm_phase(LAS unsigned char* lds, const Gemm g, const StaticOrder& S, const Epi& E) {
    const int tid = threadIdx.x, wid = __builtin_amdgcn_readfirstlane(tid >> 6), lane = tid & 63, wr = wid >> 2, wc = wid & 3, fr = lane & 15, fq = lane >> 4;
    const int K = g.K, nt = K / BK, lda = g.lda;
    unsigned voffA[2], voffB[2];
#pragma unroll
    for (int i = 0; i < 2; ++i) { int R, C; stage_rc(tid * 16 + i * 8192, R, C); const int Rb = Epi::PERM ? ((R & ~31) + perm32(R & 31)) : R;
        voffA[i] = (unsigned)(R * lda + C) * 2u; voffB[i] = (unsigned)(Rb * K + C) * 2u; }
    const size_t kstep = (size_t)(BK * 2);
    const size_t hstepA = (size_t)HALF * lda * 2, hstepB = (size_t)HALF * K * 2;
    const size_t tstepA = 2 * hstepA, tstepB = 2 * hstepB;
    const unsigned ldsw = (unsigned)wid * 1024u;
    const int aoff = lds_byte(wr * 64 + fr, fq * 8), boff = lds_byte(wc * 32 + fr, fq * 8);
#define PG8_SA(b, h) (((b) * 2 + (h)) * HTB)
#define PG8_SB(b, h) ((4 + (b) * 2 + (h)) * HTB)
#define PG8_STAGE(bufoff, gbase, voff) do { _Pragma("unroll") for (int _i = 0; _i < 2; ++_i) \
        __builtin_amdgcn_global_load_lds((const unsigned*)((const char*)(gbase) + (voff)[_i]), (LAS unsigned*)(lds + (bufoff) + ldsw + _i * 8192), 16, 0, 0); } while (0)
#define PG8_LDA(dst, b, h) do { _Pragma("unroll") for (int m = 0; m < 4; ++m) _Pragma("unroll") for (int k = 0; k < 2; ++k) dst[m][k] = *(const LAS bf16x8*)(lds + PG8_SA(b, h) + aoff + m * 2048 + k * 1024); } while (0)
#define PG8_LDB(dst, b, h) do { _Pragma("unroll") for (int n = 0; n < 2; ++n) _Pragma("unroll") for (int k = 0; k < 2; ++k) dst[n][k] = *(const LAS bf16x8*)(lds + PG8_SB(b, h) + boff + n * 2048 + k * 1024); } while (0)
#define PG8_MMA(ai, bj, At, Bt) do { __builtin_amdgcn_s_setprio(1); _Pragma("unroll") for (int m = 0; m < 4; ++m) _Pragma("unroll") for (int n = 0; n < 2; ++n) _Pragma("unroll") for (int k = 0; k < 2; ++k) \
        acc[ai][bj][m][n] = __builtin_amdgcn_mfma_f32_16x16x32_bf16(Bt[n][k], At[m][k], acc[ai][bj][m][n], 0, 0, 0); __builtin_amdgcn_s_setprio(0); } while (0)
#define PG8_WAIT_V(n) asm volatile("s_waitcnt vmcnt(" #n ")" ::: "memory")
#define PG8_WAIT_L(n) asm volatile("s_waitcnt lgkmcnt(" #n ")" ::: "memory")
#define PG8_BAR __builtin_amdgcn_s_barrier()
#define PG8_SCHED __builtin_amdgcn_sched_barrier(0)
    Unit cur, nxt; int ui = 0;
    if (!S.next(0, cur)) return;
    f32x4 acc[2][2][4][2];
#pragma unroll
    for (int a = 0; a < 2; ++a)
#pragma unroll
        for (int b = 0; b < 2; ++b)
#pragma unroll
            for (int m = 0; m < 4; ++m)
#pragma unroll
                for (int n = 0; n < 2; ++n) acc[a][b][m][n] = (f32x4){0.f, 0.f, 0.f, 0.f};
    bf16x8 At[4][2], B0[2][2], B1[2][2];
    const char* cA = (const char*)g.A + (size_t)cur.pm * tstepA; const char* cB = (const char*)g.Bt + (size_t)cur.pn * tstepB;
    PG8_STAGE(PG8_SB(0, 0), cB, voffB); PG8_STAGE(PG8_SA(0, 0), cA, voffA); PG8_STAGE(PG8_SB(0, 1), cB + hstepB, voffB); PG8_STAGE(PG8_SA(0, 1), cA + hstepA, voffA);
    if (wr == 1) PG8_BAR;
    PG8_WAIT_V(4); PG8_BAR;
    PG8_STAGE(PG8_SB(1, 0), cB + kstep, voffB); PG8_STAGE(PG8_SA(1, 0), cA + kstep, voffA); PG8_STAGE(PG8_SB(1, 1), cB + hstepB + kstep, voffB);
    PG8_WAIT_V(6); PG8_BAR;
    for (;;) {
        const bool has_next = S.next(ui + 1, nxt);
        const char* nA = has_next ? (const char*)g.A + (size_t)nxt.pm * tstepA : cA; const char* nB = has_next ? (const char*)g.Bt + (size_t)nxt.pn * tstepB : cB;
        for (int t = 0; t < nt; t += 2) {
            const bool last = (t == nt - 2);
            const char* a1 = cA + (size_t)(t + 1) * kstep;
            const char* a2 = last ? nA : cA + (size_t)(t + 2) * kstep; const char* b2 = last ? nB : cB + (size_t)(t + 2) * kstep;
            const char* a3 = a2 + kstep; const char* b3 = b2 + kstep;
            PG8_LDB(B0, 0, 0); PG8_SCHED; PG8_LDA(At, 0, 0); PG8_STAGE(PG8_SA(1, 1), a1 + hstepA, voffA);
            PG8_WAIT_L(8); PG8_BAR; PG8_WAIT_L(0); PG8_MMA(0, 0, At, B0); PG8_BAR; PG8_SCHED;
            PG8_LDB(B1, 0, 1); PG8_STAGE(PG8_SB(0, 0), b2, voffB);
            PG8_BAR; PG8_WAIT_L(0); PG8_MMA(0, 1, At, B1); PG8_BAR;
            PG8_LDA(At, 0, 1); PG8_STAGE(PG8_SA(0, 0), a2, voffA);
            PG8_BAR; PG8_WAIT_L(0); PG8_MMA(1, 0, At, B0); PG8_BAR; PG8_SCHED;
            PG8_STAGE(PG8_SB(0, 1), b2 + hstepB, voffB);
            PG8_WAIT_V(6); PG8_BAR; PG8_MMA(1, 1, At, B1); PG8_BAR;
            PG8_LDB(B0, 1, 0); PG8_SCHED; PG8_LDA(At, 1, 0); PG8_STAGE(PG8_SA(0, 1), a2 + hstepA, voffA);
            PG8_WAIT_L(8); PG8_BAR; PG8_WAIT_L(0); PG8_MMA(0, 0, At, B0); PG8_BAR; PG8_SCHED;
            PG8_LDB(B1, 1, 1); PG8_STAGE(PG8_SB(1, 0), b3, voffB);
            PG8_BAR; PG8_WAIT_L(0); PG8_MMA(0, 1, At, B1); PG8_BAR;
            PG8_LDA(At, 1, 1); PG8_STAGE(PG8_SA(1, 0), a3, voffA);
            PG8_BAR; PG8_WAIT_L(0); PG8_MMA(1, 0, At, B0); PG8_BAR; PG8_SCHED;
            PG8_STAGE(PG8_SB(1, 1), b3 + hstepB, voffB);
            PG8_WAIT_V(6); PG8_BAR; PG8_MMA(1, 1, At, B1); PG8_BAR;
        }
        E(acc, cur, wr, wc, fr, fq);
        if (!has_next) break;
#pragma unroll
        for (int a = 0; a < 2; ++a)
#pragma unroll
            for (int b = 0; b < 2; ++b)
#pragma unroll
                for (int m = 0; m < 4; ++m)
#pragma unroll
                    for (int n = 0; n < 2; ++n) acc[a][b][m][n] = (f32x4){0.f, 0.f, 0.f, 0.f};
        cur = nxt; cA = nA; cB = nB; ++ui;
    }
    PG8_WAIT_V(0);
    if (wr == 0) PG8_BAR;
    PG8_BAR;
#undef PG8_SA
#undef PG8_SB
#undef PG8_STAGE
#undef PG8_LDA
#undef PG8_LDB
#undef PG8_MMA
#undef PG8_WAIT_V
#undef PG8_WAIT_L
#undef PG8_BAR
#undef PG8_SCHED
}
}

namespace att {
constexpr int D = 128, NW = 8, QBLK = 32, KVBLK = 64;
constexpr float SCALE = 0.088388347648318440f;
constexpr float THR = 8.f;
#ifndef ATT_SDEPTH
#define ATT_SDEPTH 1
#endif
constexpr int LDQ = INW, LDK = INW, LDO = INW / 2;
constexpr int SHM_V = KVBLK * D * 2, SHM_K = KVBLK * D * 2;
constexpr int OFF_WS = 2 * SHM_V + 2 * SHM_K, OFF_TAB = OFF_WS + NW * 64 * 4, SHM_ATTN = OFF_TAB + 768 * 4;
#define KSWZ(row, colB) ((row) * 256 + ((colB) ^ (((row) & 7) << 4)))
#define SBAR() __builtin_amdgcn_sched_barrier(0)
__device__ __forceinline__ int crow(int r, int hi) { return (r & 3) + 8 * (r >> 2) + 4 * hi; }

__device__ __forceinline__ void partialSM(f32x16& p0, f32x16& p1, float& m_reg, float& mn, float& alpha) {
  constexpr float C = SCALE * 1.4426950408889634f;
  float pmax = p0[0];
#pragma unroll
  for (int r = 1; r < 16; ++r) pmax = fmaxf(pmax, p0[r]);
#pragma unroll
  for (int r = 0; r < 16; ++r) pmax = fmaxf(pmax, p1[r]);
  { auto rr = __builtin_amdgcn_permlane32_swap(__float_as_uint(pmax), __float_as_uint(pmax), false, false);
    pmax = fmaxf(__uint_as_float(rr[0]), __uint_as_float(rr[1])); }
  if (__builtin_expect(__all(pmax - m_reg <= THR / SCALE), 1)) { mn = m_reg; alpha = 1.f; }
  else { mn = fmaxf(m_reg, pmax); alpha = __builtin_amdgcn_exp2f((m_reg - mn) * C); m_reg = mn; }
  float mnC = -mn * C;
#pragma unroll
  for (int r = 0; r < 16; ++r) p0[r] = fmaf(p0[r], C, mnC);
#pragma unroll
  for (int r = 0; r < 16; ++r) p1[r] = fmaf(p1[r], C, mnC);
#pragma unroll
  for (int r = 0; r < 16; ++r) p0[r] = __builtin_amdgcn_exp2f(p0[r]);
}
__device__ __forceinline__ void finishSM(f32x16& p0, f32x16& p1, float alpha, float& l_reg, bf16x8& pa0, bf16x8& pa1, bf16x8& pa2, bf16x8& pa3) {
#pragma unroll
  for (int r = 0; r < 16; ++r) p1[r] = __builtin_amdgcn_exp2f(p1[r]);
  float ps = 0;
#pragma unroll
  for (int r = 0; r < 16; ++r) ps += p0[r];
#pragma unroll
  for (int r = 0; r < 16; ++r) ps += p1[r];
  { auto rr = __builtin_amdgcn_permlane32_swap(__float_as_uint(ps), __float_as_uint(ps), false, false);
    ps = __uint_as_float(rr[0]) + __uint_as_float(rr[1]); }
  l_reg = l_reg * alpha + ps;
#define PK4(P, BASE, OUT) do { unsigned a0 = cvt_pk_bf16(P[BASE + 0], P[BASE + 1]), a1 = cvt_pk_bf16(P[BASE + 2], P[BASE + 3]);   \
    unsigned b0 = cvt_pk_bf16(P[BASE + 4], P[BASE + 5]), b1 = cvt_pk_bf16(P[BASE + 6], P[BASE + 7]);                              \
    auto r0 = __builtin_amdgcn_permlane32_swap(a0, b0, false, false); auto r1 = __builtin_amdgcn_permlane32_swap(a1, b1, false, false); \
    u32x4 w = {r0[0], r1[0], r0[1], r1[1]}; OUT = *reinterpret_cast<bf16x8*>(&w); } while (0)
  PK4(p0, 0, pa0); PK4(p0, 8, pa1); PK4(p1, 0, pa2); PK4(p1, 8, pa3);
#undef PK4
}
template <bool NEAR>
__device__ __forceinline__ void qkt(f32x16& p0, f32x16& p1, const bf16_t* Ks, const bf16x8 (&qr)[8], int r32, int hi, float cfar, const float* tabp) {
  if (!NEAR) {
#pragma unroll
    for (int r = 0; r < 16; ++r) { p0[r] = cfar; p1[r] = cfar; }
  } else {
#pragma unroll
    for (int r = 0; r < 16; ++r) { p0[r] = tabp[(r & 3) + 8 * (r >> 2)]; p1[r] = tabp[32 + (r & 3) + 8 * (r >> 2)]; }
  }
#pragma unroll
  for (int d0 = 0; d0 < 8; ++d0) { int cb = (d0 * 16 + hi * 8) * 2;
    bf16x8 b0 = *reinterpret_cast<const bf16x8*>((const char*)Ks + KSWZ(r32, cb));
    bf16x8 b1 = *reinterpret_cast<const bf16x8*>((const char*)Ks + KSWZ(32 + r32, cb));
    p0 = __builtin_amdgcn_mfma_f32_32x32x16_bf16(b0, qr[d0], p0, 0, 0, 0);
    p1 = __builtin_amdgcn_mfma_f32_32x32x16_bf16(b1, qr[d0], p1, 0, 0, 0); }
}
__device__ __forceinline__ int v_st(int k, int c) { const int kk = (k & ~0xC) | ((k & 4) << 1) | ((k & 8) >> 1); return ((kk >> 3) * 4 + (c >> 5)) * 512 + ((kk & 7) * 32 + (c & 31)) * 2; }
__device__ __forceinline__ int v_rd_base(int lane) { return ((lane & 3) << 3) | (((lane >> 2) & 3) << 6) | (((lane >> 4) & 1) << 5) | (((lane >> 5) & 1) << 8); }
constexpr int v_rd_off(int d0, int ks, int half) { return d0 * 512 + ks * 4096 + half * 2048; }
template <int OFF> __device__ __forceinline__ s16x4 tr_read(int vb) {
  s16x4 r; asm volatile("ds_read_b64_tr_b16 %0, %1 offset:%2" : "=&v"(r) : "v"(vb), "i"(OFF) : "memory"); return r;
}
template <int D0> __device__ __forceinline__ void pv_one(f32x16& od, int vb, bf16x8 pa0, bf16x8 pa1, bf16x8 pa2, bf16x8 pa3) {
  const s16x4 l0 = tr_read<v_rd_off(D0, 0, 0)>(vb), h0 = tr_read<v_rd_off(D0, 0, 1)>(vb), l1 = tr_read<v_rd_off(D0, 1, 0)>(vb), h1 = tr_read<v_rd_off(D0, 1, 1)>(vb);
  const s16x4 l2 = tr_read<v_rd_off(D0, 2, 0)>(vb), h2 = tr_read<v_rd_off(D0, 2, 1)>(vb), l3 = tr_read<v_rd_off(D0, 3, 0)>(vb), h3 = tr_read<v_rd_off(D0, 3, 1)>(vb);
  asm volatile("s_waitcnt lgkmcnt(0)" ::: "memory"); SBAR();
#define PK(L, H) (bf16x8){L[0], L[1], L[2], L[3], H[0], H[1], H[2], H[3]}
  od = __builtin_amdgcn_mfma_f32_32x32x16_bf16(pa0, PK(l0, h0), od, 0, 0, 0);
  od = __builtin_amdgcn_mfma_f32_32x32x16_bf16(pa1, PK(l1, h1), od, 0, 0, 0);
  od = __builtin_amdgcn_mfma_f32_32x32x16_bf16(pa2, PK(l2, h2), od, 0, 0, 0);
  od = __builtin_amdgcn_mfma_f32_32x32x16_bf16(pa3, PK(l3, h3), od, 0, 0, 0);
#undef PK
}
__device__ __forceinline__ void pv_d0(f32x16* o, int vb, bf16x8 pa0, bf16x8 pa1, bf16x8 pa2, bf16x8 pa3) {
  pv_one<0>(o[0], vb, pa0, pa1, pa2, pa3); pv_one<1>(o[1], vb, pa0, pa1, pa2, pa3); pv_one<2>(o[2], vb, pa0, pa1, pa2, pa3); pv_one<3>(o[3], vb, pa0, pa1, pa2, pa3);
}

template <int SDEPTH>
__device__ __forceinline__ void attn_range(const bf16_t* __restrict__ Kh, const bf16_t* __restrict__ Vh, int NT, float cfar, const bf16x8 (&qr)[8],
                                           float& m_reg, float& l_reg, f32x16 (&o)[4], char* lds, int tid, int wid, int r32, int hi) {
  bf16_t* V_lds = (bf16_t*)lds; bf16_t* K_lds = (bf16_t*)(lds + 2 * SHM_V);
  float* al_l = (float*)(lds + OFF_WS) + wid * 64 + 32;
  const int sr = tid >> 4, sc = (tid & 15) * 8, vst0 = v_st(sr, sc), vst1 = v_st(32 + sr, sc);
  const int vb0 = (int)(uintptr_t)V_lds + v_rd_base(tid & 63);
  struct { bf16x8 vs0, vs1, ks0, ks1; } sr_[SDEPTH];
#define SLOAD(i, k0) do { sr_[i].vs0 = *reinterpret_cast<const bf16x8*>(&Vh[(long)((k0) + sr) * LDK + sc]); sr_[i].vs1 = *reinterpret_cast<const bf16x8*>(&Vh[(long)((k0) + 32 + sr) * LDK + sc]); \
    sr_[i].ks0 = *reinterpret_cast<const bf16x8*>(&Kh[(long)((k0) + sr) * LDK + sc]); sr_[i].ks1 = *reinterpret_cast<const bf16x8*>(&Kh[(long)((k0) + 32 + sr) * LDK + sc]); } while (0)
#define SWRITE(b, i) do { *(bf16x8*)((char*)V_lds + (b) * SHM_V + vst0) = sr_[i].vs0;          \
    *(bf16x8*)((char*)V_lds + (b) * SHM_V + vst1) = sr_[i].vs1; int kc = sc * 2;               \
    *(bf16x8*)((char*)K_lds + (b) * SHM_K + KSWZ(sr, kc)) = sr_[i].ks0;                       \
    *(bf16x8*)((char*)K_lds + (b) * SHM_K + KSWZ(32 + sr, kc)) = sr_[i].ks1; } while (0)
#define SWAIT() do { if constexpr (SDEPTH == 2) asm volatile("s_waitcnt vmcnt(4)" ::: "memory"); else asm volatile("s_waitcnt vmcnt(0)" ::: "memory"); } while (0)
#define RESC(a) do { if (__any((a) < 1.f)) { if (hi == 0) al_l[r32] = (a); asm volatile("s_waitcnt lgkmcnt(0)" ::: "memory"); \
    _Pragma("unroll") for (int d = 0; d < 4; ++d) _Pragma("unroll") for (int r = 0; r < 16; ++r) o[d][r] *= al_l[crow(r, hi)]; } } while (0)
#define QKT(P0, P1, KB, jj) qkt<false>(P0, P1, KB, qr, r32, hi, cfar, nullptr)
  f32x16 pA0, pA1, pB0, pB1; float mnA, mnB, alA, alB; bf16x8 pa0, pa1, pa2, pa3;
  constexpr int SE = 0, SO = SDEPTH - 1;
  SLOAD(SE, 0); asm volatile("s_waitcnt vmcnt(0)" ::: "memory"); SWRITE(0, SE); __syncthreads();
  QKT(pA0, pA1, K_lds, 0); partialSM(pA0, pA1, m_reg, mnA, alA);
  SLOAD(SO, KVBLK); if constexpr (SDEPTH == 2) { if (2 < NT) SLOAD(SE, 2 * KVBLK); }
  SWAIT(); SWRITE(1, SO); __syncthreads();
  RESC(alA);
  for (int j = 1; j + 1 < NT; j += 2) {
    SBAR(); QKT(pB0, pB1, (bf16_t*)((char*)K_lds + SHM_K), j);
    finishSM(pA0, pA1, alA, l_reg, pa0, pa1, pa2, pa3); SBAR();
    SLOAD(SO, (j + SDEPTH) * KVBLK); SBAR();
    pv_d0(o, vb0, pa0, pa1, pa2, pa3); partialSM(pB0, pB1, m_reg, mnB, alB);
    __syncthreads(); SWAIT(); SWRITE(0, SE);
    RESC(alB); __syncthreads();
    SBAR(); QKT(pA0, pA1, K_lds, j + 1);
    finishSM(pB0, pB1, alB, l_reg, pa0, pa1, pa2, pa3); SBAR();
    if (SDEPTH == 1 || j + 3 < NT) SLOAD(SE, (j + 1 + SDEPTH) * KVBLK); SBAR();
    pv_d0(o, vb0 + (int)SHM_V, pa0, pa1, pa2, pa3); partialSM(pA0, pA1, m_reg, mnA, alA);
    __syncthreads(); SWAIT(); SWRITE(1, SO);
    RESC(alA); __syncthreads();
  }
  SBAR(); QKT(pB0, pB1, (bf16_t*)((char*)K_lds + SHM_K), NT - 1);
  finishSM(pA0, pA1, alA, l_reg, pa0, pa1, pa2, pa3); SBAR();
  pv_d0(o, vb0, pa0, pa1, pa2, pa3); partialSM(pB0, pB1, m_reg, mnB, alB);
  __syncthreads(); RESC(alB);
  finishSM(pB0, pB1, alB, l_reg, pa0, pa1, pa2, pa3); SBAR();
  pv_d0(o, vb0 + (int)SHM_V, pa0, pa1, pa2, pa3);
#undef SLOAD
#undef SWRITE
#undef SWAIT
#undef RESC
#undef QKT
}

__device__ __forceinline__ void attn_near(const bf16_t* __restrict__ Kh, const bf16_t* __restrict__ Vh, int NT, const float* tabl, const bf16x8 (&qr)[8],
                                          float& m_reg, float& l_reg, f32x16 (&o)[4], char* lds, int tid, int wid, int r32, int hi) {
  bf16_t* V_lds = (bf16_t*)lds; bf16_t* K_lds = (bf16_t*)(lds + 2 * SHM_V);
  float* al_l = (float*)(lds + OFF_WS) + wid * 64 + 32;
  const int sr = tid >> 4, sc = (tid & 15) * 8, vst0 = v_st(sr, sc), vst1 = v_st(32 + sr, sc);
  const int vb0 = (int)(uintptr_t)V_lds + v_rd_base(tid & 63);
#pragma unroll 1
  for (int j = 0; j < NT; ++j) {
    const long k0 = (long)j * KVBLK;
    const bf16x8 vs0 = *reinterpret_cast<const bf16x8*>(&Vh[(k0 + sr) * LDK + sc]), vs1 = *reinterpret_cast<const bf16x8*>(&Vh[(k0 + 32 + sr) * LDK + sc]);
    const bf16x8 ks0 = *reinterpret_cast<const bf16x8*>(&Kh[(k0 + sr) * LDK + sc]), ks1 = *reinterpret_cast<const bf16x8*>(&Kh[(k0 + 32 + sr) * LDK + sc]);
    __syncthreads();
    *(bf16x8*)((char*)V_lds + vst0) = vs0; *(bf16x8*)((char*)V_lds + vst1) = vs1;
    *(bf16x8*)((char*)K_lds + KSWZ(sr, sc * 2)) = ks0; *(bf16x8*)((char*)K_lds + KSWZ(32 + sr, sc * 2)) = ks1;
    __syncthreads();
    f32x16 p0, p1; float mn, al; bf16x8 pa0, pa1, pa2, pa3;
    qkt<true>(p0, p1, K_lds, qr, r32, hi, 0.f, tabl + j * KVBLK);
    partialSM(p0, p1, m_reg, mn, al);
    if (__any(al < 1.f)) { if (hi == 0) al_l[r32] = al; asm volatile("s_waitcnt lgkmcnt(0)" ::: "memory");
#pragma unroll
      for (int d = 0; d < 4; ++d)
#pragma unroll
        for (int r = 0; r < 16; ++r) o[d][r] *= al_l[crow(r, hi)]; }
    finishSM(p0, p1, al, l_reg, pa0, pa1, pa2, pa3); SBAR();
    pv_d0(o, vb0, pa0, pa1, pa2, pa3);
  }
  __syncthreads();
}

__device__ __forceinline__ void attn_body(const bf16_t* __restrict__ Qb, const bf16_t* __restrict__ Kh, const bf16_t* __restrict__ Vh, float* Ob, int seq, int q0, float lam, bool SUBTRACT, char* lds) {
  int tid = threadIdx.x; asm volatile("" : "+v"(tid));
  const int wid = __builtin_amdgcn_readfirstlane(tid >> 6), lane = tid & 63, r32 = lane & 31, hi = lane >> 5;
  float* li_l = (float*)(lds + OFF_WS) + wid * 64;
  const float* tab = (const float*)(lds + OFF_TAB);
  const int NT = seq / KVBLK;
  int jn0 = q0 / KVBLK - 2, jn1 = q0 / KVBLK + 6; jn0 = jn0 < 0 ? 0 : jn0; jn1 = jn1 > NT ? NT : jn1;
  float m_reg = -1e30f, l_reg = 0; f32x16 o[4] = {}; bf16x8 qr[8];
  const bf16_t* Qw = Qb + (long)(wid * QBLK + r32) * LDQ + hi * 8;
#pragma unroll
  for (int d0 = 0; d0 < 8; ++d0) qr[d0] = *reinterpret_cast<const bf16x8*>(Qw + d0 * 16);
  { const float* tabl = tab + (384 + 4 * hi - (q0 + wid * QBLK + r32 - jn0 * KVBLK));
    attn_near(Kh + (long)jn0 * KVBLK * LDK, Vh + (long)jn0 * KVBLK * LDK, jn1 - jn0, tabl, qr, m_reg, l_reg, o, lds, tid, wid, r32, hi); }
#pragma unroll 1
  for (int rg = 0; rg < 2; ++rg) {
    int rr = rg; asm volatile("" : "+s"(rr));
    const int ja = rr ? jn1 : 0, nt = rr ? NT - jn1 : jn0;
    const float cfar = __uint_as_float(__builtin_amdgcn_readfirstlane(__float_as_uint(tab[rr ? 767 : 0])));
    if (nt > 0) attn_range<ATT_SDEPTH>(Kh + (long)ja * KVBLK * LDK, Vh + (long)ja * KVBLK * LDK, nt, cfar, qr, m_reg, l_reg, o, lds, tid, wid, r32, hi);
  }
  if (hi == 0) li_l[r32] = l_reg; asm volatile("s_waitcnt lgkmcnt(0)" ::: "memory");
  float rli[16];
#pragma unroll
  for (int r = 0; r < 16; ++r) rli[r] = __builtin_amdgcn_rcpf(li_l[crow(r, hi)]);
  int r32e = r32, hie = hi; asm volatile("" : "+v"(r32e), "+v"(hie));
  float* Ow = Ob + (long)(wid * QBLK) * LDO + (4 * hie) * LDO + r32e;
  if (SUBTRACT) {
#pragma unroll
    for (int r = 0; r < 16; ++r) {
#pragma unroll
      for (int d0 = 0; d0 < 4; ++d0) { float* op = Ow + ((r & 3) + 8 * (r >> 2)) * LDO + d0 * 32; *op = *op - lam * (o[d0][r] * rli[r]); }
      asm volatile("" ::: "memory"); }
  } else {
#pragma unroll
    for (int r = 0; r < 16; ++r) {
#pragma unroll
      for (int d0 = 0; d0 < 4; ++d0) Ow[((r & 3) + 8 * (r >> 2)) * LDO + d0 * 32] = o[d0][r] * rli[r]; }
  }
  asm volatile("s_waitcnt vmcnt(0)" ::: "memory");
  __syncthreads();
}
}

namespace att2 {
using att::crow; using att::partialSM; using att::finishSM; using att::KVBLK; using att::QBLK; using att::LDQ; using att::LDK; using att::LDO;
constexpr int KBUF = 16384, VBUF = 32768, OFF_K = 0, OFF_V = 2 * KBUF, OFF_WS = OFF_V + 3 * VBUF, OFF_TAB = OFF_WS + 2048, SHM = OFF_TAB + 768 * 4;
#define A2_WAIT_V(n) asm volatile("s_waitcnt vmcnt(" #n ")" ::: "memory")
#define A2_BAR() do { asm volatile("" ::: "memory"); __builtin_amdgcn_s_barrier(); asm volatile("" ::: "memory"); } while (0)
template <int OFF> __device__ __forceinline__ s16x4 tr_read(int vb) {
  s16x4 r; asm volatile("ds_read_b64_tr_b16 %0, %1 offset:%2" : "=&v"(r) : "v"(vb), "i"(OFF) : "memory"); return r;
}
constexpr int v_off(int d0, int ks, int half) { return (d0 >> 2) * 16384 + (d0 & 3) * 512 + ks * 4096 + half * 2048; }
struct VFrag { s16x4 l0, h0, l1, h1; };
template <int D0, int SUB> __device__ __forceinline__ void v_read(VFrag& f, int vb) {
  f.l0 = tr_read<v_off(D0, 2 * SUB, 0)>(vb); f.h0 = tr_read<v_off(D0, 2 * SUB, 1)>(vb); f.l1 = tr_read<v_off(D0, 2 * SUB + 1, 0)>(vb); f.h1 = tr_read<v_off(D0, 2 * SUB + 1, 1)>(vb);
}
__device__ __forceinline__ void v_mma(f32x16& od, const VFrag& f, bf16x8 pa0, bf16x8 pa1) {
#define PK(L, H) (bf16x8){L[0], L[1], L[2], L[3], H[0], H[1], H[2], H[3]}
  od = __builtin_amdgcn_mfma_f32_32x32x16_bf16(pa0, PK(f.l0, f.h0), od, 0, 0, 0);
  od = __builtin_amdgcn_mfma_f32_32x32x16_bf16(pa1, PK(f.l1, f.h1), od, 0, 0, 0);
#undef PK
}
#define A2_LWAIT(n) do { asm volatile("s_waitcnt lgkmcnt(" #n ")" ::: "memory"); __builtin_amdgcn_sched_barrier(0); } while (0)
template <int SUB> __device__ __forceinline__ void pv_all(f32x16 (&o)[8], int vb, bf16x8 pa0, bf16x8 pa1, VFrag& fa) {
  VFrag fb;
  __builtin_amdgcn_s_setprio(1);
  v_read<1, SUB>(fb, vb); A2_LWAIT(4); v_mma(o[0], fa, pa0, pa1); __builtin_amdgcn_sched_barrier(0);
  v_read<2, SUB>(fa, vb); A2_LWAIT(4); v_mma(o[1], fb, pa0, pa1); __builtin_amdgcn_sched_barrier(0);
  v_read<3, SUB>(fb, vb); A2_LWAIT(4); v_mma(o[2], fa, pa0, pa1); __builtin_amdgcn_sched_barrier(0);
  v_read<4, SUB>(fa, vb); A2_LWAIT(4); v_mma(o[3], fb, pa0, pa1); __builtin_amdgcn_sched_barrier(0);
  v_read<5, SUB>(fb, vb); A2_LWAIT(4); v_mma(o[4], fa, pa0, pa1); __builtin_amdgcn_sched_barrier(0);
  v_read<6, SUB>(fa, vb); A2_LWAIT(4); v_mma(o[5], fb, pa0, pa1); __builtin_amdgcn_sched_barrier(0);
  v_read<7, SUB>(fb, vb); A2_LWAIT(4); v_mma(o[6], fa, pa0, pa1); __builtin_amdgcn_sched_barrier(0);
  A2_LWAIT(0); v_mma(o[7], fb, pa0, pa1);
  __builtin_amdgcn_s_setprio(0);
}
struct Ctx { LAS unsigned char* lds; unsigned voffK, voffV; int wid, r32, hi, vb0; LAS float* al_l; };
__device__ __forceinline__ void issueK(const Ctx& c, int buf, const char* g) {
#pragma unroll
  for (int i = 0; i < 2; ++i) __builtin_amdgcn_global_load_lds((const unsigned*)(g + (size_t)i * (32 * LDK * 2) + c.voffK), (LAS unsigned*)(c.lds + OFF_K + buf * KBUF + c.wid * 1024 + i * 8192), 16, 0, 0);
}
__device__ __forceinline__ void issueV(const Ctx& c, int buf, const char* g) {
#pragma unroll
  for (int i = 0; i < 4; ++i) __builtin_amdgcn_global_load_lds((const unsigned*)(g + (size_t)(i & 1) * (32 * LDK * 2) + (i >> 1) * 256 + c.voffV), (LAS unsigned*)(c.lds + OFF_V + buf * VBUF + c.wid * 1024 + i * 8192), 16, 0, 0);
}
template <bool NEAR, int SUB, int DMA = 0>
__device__ __forceinline__ void qk_sm(const Ctx& c, const LAS unsigned char* Ks, const bf16x8 (&qr)[8], float cfar, const LAS float* tabp, float& m_reg, float& l_reg, f32x16 (&o)[8], bf16x8& pa0, bf16x8& pa1,
                                      VFrag& fa, int vbp, int dbuf = 0, const char* dsrc = nullptr, int dbuf2 = 0, const char* dsrc2 = nullptr) {
  constexpr float C = att::SCALE * 1.4426950408889634f;
  f32x16 p;
  if (!NEAR) {
#pragma unroll
    for (int r = 0; r < 16; ++r) p[r] = 0.f;
  } else {
#pragma unroll
    for (int r = 0; r < 16; ++r) p[r] = tabp[32 * SUB + (r & 3) + 8 * (r >> 2)];
  }
  { const int kb = (int)(unsigned)(uintptr_t)Ks + c.r32 * 256 + ((c.hi << 4) ^ ((c.r32 & 7) << 4));
    bf16x8 ka, kbf, kc;
#define K_RD(dst, d0) asm volatile("ds_read_b128 %0, %1 offset:%2" : "=&v"(dst) : "v"(kb ^ ((d0) << 5)), "i"(SUB * 8192) : "memory")
    __builtin_amdgcn_s_setprio(1);
    K_RD(ka, 0); K_RD(kbf, 1); K_RD(kc, 2);
    A2_LWAIT(2); p = __builtin_amdgcn_mfma_f32_32x32x16_bf16(ka, qr[0], p, 0, 0, 0); __builtin_amdgcn_sched_barrier(0); K_RD(ka, 3);
    A2_LWAIT(2); p = __builtin_amdgcn_mfma_f32_32x32x16_bf16(kbf, qr[1], p, 0, 0, 0); __builtin_amdgcn_sched_barrier(0); K_RD(kbf, 4);
    A2_LWAIT(2); p = __builtin_amdgcn_mfma_f32_32x32x16_bf16(kc, qr[2], p, 0, 0, 0); __builtin_amdgcn_sched_barrier(0); K_RD(kc, 5);
    A2_LWAIT(2); p = __builtin_amdgcn_mfma_f32_32x32x16_bf16(ka, qr[3], p, 0, 0, 0); __builtin_amdgcn_sched_barrier(0); K_RD(ka, 6);
    A2_LWAIT(2); p = __builtin_amdgcn_mfma_f32_32x32x16_bf16(kbf, qr[4], p, 0, 0, 0); __builtin_amdgcn_sched_barrier(0); K_RD(kbf, 7);
    A2_LWAIT(2); p = __builtin_amdgcn_mfma_f32_32x32x16_bf16(kc, qr[5], p, 0, 0, 0); __builtin_amdgcn_sched_barrier(0);
    A2_LWAIT(1); p = __builtin_amdgcn_mfma_f32_32x32x16_bf16(ka, qr[6], p, 0, 0, 0); __builtin_amdgcn_sched_barrier(0);
    A2_LWAIT(0); p = __builtin_amdgcn_mfma_f32_32x32x16_bf16(kbf, qr[7], p, 0, 0, 0);
    __builtin_amdgcn_s_setprio(0);
#undef K_RD
  }
  if (DMA == 1) { __builtin_amdgcn_sched_barrier(0); issueK(c, dbuf, dsrc); __builtin_amdgcn_sched_barrier(0); }
  if (DMA == 3) { __builtin_amdgcn_sched_barrier(0); issueK(c, dbuf, dsrc); issueV(c, dbuf2, dsrc2); __builtin_amdgcn_sched_barrier(0); }
  if (DMA == 2) { __builtin_amdgcn_sched_barrier(0); issueV(c, dbuf, dsrc); __builtin_amdgcn_sched_barrier(0); }
  v_read<0, SUB>(fa, vbp);
  float pmax = p[0];
#pragma unroll
  for (int r = 1; r < 16; ++r) pmax = fmaxf(pmax, p[r]);
  { auto rr = __builtin_amdgcn_permlane32_swap(__float_as_uint(pmax), __float_as_uint(pmax), false, false);
    pmax = fmaxf(__uint_as_float(rr[0]), __uint_as_float(rr[1])); }
  if (!NEAR) pmax += cfar;
  float mn, alpha;
  if (__builtin_expect(__all(pmax - m_reg <= att::THR / att::SCALE), 1)) { mn = m_reg; alpha = 1.f; }
  else { mn = fmaxf(m_reg, pmax); alpha = __builtin_amdgcn_exp2f((m_reg - mn) * C); m_reg = mn;
    if (__any(alpha < 1.f)) { if (c.hi == 0) c.al_l[c.r32] = alpha; asm volatile("s_waitcnt lgkmcnt(0)" ::: "memory");
#pragma unroll
      for (int d = 0; d < 8; ++d)
#pragma unroll
        for (int r = 0; r < 16; ++r) o[d][r] *= c.al_l[crow(r, c.hi)]; } }
  const float mnC = NEAR ? -mn * C : (cfar - mn) * C;
  float ps = 0.f;
#pragma unroll
  for (int r = 0; r < 16; ++r) { p[r] = __builtin_amdgcn_exp2f(fmaf(p[r], C, mnC)); ps += p[r]; }
  { auto rr = __builtin_amdgcn_permlane32_swap(__float_as_uint(ps), __float_as_uint(ps), false, false);
    ps = __uint_as_float(rr[0]) + __uint_as_float(rr[1]); }
  l_reg = l_reg * alpha + ps;
#define PK4(P, BASE, OUT) do { unsigned a0 = cvt_pk_bf16(P[BASE + 0], P[BASE + 1]), a1 = cvt_pk_bf16(P[BASE + 2], P[BASE + 3]);   \
    unsigned b0 = cvt_pk_bf16(P[BASE + 4], P[BASE + 5]), b1 = cvt_pk_bf16(P[BASE + 6], P[BASE + 7]);                              \
    auto r0 = __builtin_amdgcn_permlane32_swap(a0, b0, false, false); auto r1 = __builtin_amdgcn_permlane32_swap(a1, b1, false, false); \
    u32x4 w = {r0[0], r1[0], r0[1], r1[1]}; OUT = *reinterpret_cast<bf16x8*>(&w); } while (0)
  PK4(p, 0, pa0); PK4(p, 8, pa1);
#undef PK4
}
template <bool NEAR, int SUB>
__device__ __forceinline__ void sub_tile(const Ctx& c, const LAS unsigned char* Ks, int vb, const bf16x8 (&qr)[8], float cfar, const LAS float* tabp, float& m_reg, float& l_reg, f32x16 (&o)[8]) {
  bf16x8 pa0, pa1; VFrag fa;
  qk_sm<NEAR, SUB>(c, Ks, qr, cfar, tabp, m_reg, l_reg, o, pa0, pa1, fa, vb);
  __builtin_amdgcn_sched_barrier(0);
  pv_all<SUB>(o, vb, pa0, pa1, fa);
}
__device__ __forceinline__ void far_run(const Ctx& c, const char* gK, const char* gV, int NT, float cfar, const bf16x8 (&qr)[8], float& m_reg, float& l_reg, f32x16 (&o)[8]) {
  constexpr size_t TSTEP = (size_t)KVBLK * LDK * 2;
  const bool roleB = c.wid >= 4;
  issueV(c, 0, gV); issueK(c, 0, gK);
  bf16x8 pa0, pa1; VFrag fa;
  int vcur = 0, vprev = 0;
#pragma unroll 1
  for (int t = 0; t < NT; ++t) {
    const int t1 = (t + 1 < NT) ? t + 1 : NT - 1;
    const int vnext = vcur == 2 ? 0 : vcur + 1;
    const LAS unsigned char* Ks = c.lds + OFF_K + (t & 1) * KBUF;
    const int vbc = c.vb0 + vcur * VBUF;
    A2_WAIT_V(0); A2_BAR();
    if (roleB && t > 0) pv_all<1>(o, c.vb0 + vprev * VBUF, pa0, pa1, fa);
    qk_sm<false, 0, 3>(c, Ks, qr, cfar, nullptr, m_reg, l_reg, o, pa0, pa1, fa, vbc, (t + 1) & 1, gK + (size_t)t1 * TSTEP, vnext, gV + (size_t)t1 * TSTEP);
    __builtin_amdgcn_sched_barrier(0);
    pv_all<0>(o, vbc, pa0, pa1, fa);
    qk_sm<false, 1, 0>(c, Ks, qr, cfar, nullptr, m_reg, l_reg, o, pa0, pa1, fa, vbc);
    __builtin_amdgcn_sched_barrier(0);
    if (!roleB) pv_all<1>(o, vbc, pa0, pa1, fa);
    vprev = vcur; vcur = vnext;
  }
  if (roleB) pv_all<1>(o, c.vb0 + vprev * VBUF, pa0, pa1, fa);
  A2_WAIT_V(0); A2_BAR();
}
__device__ __forceinline__ void near_run(const Ctx& c, const char* gK, const char* gV, int NT, const LAS float* tabl, const bf16x8 (&qr)[8], float& m_reg, float& l_reg, f32x16 (&o)[8]) {
  constexpr size_t TSTEP = (size_t)KVBLK * LDK * 2;
  issueK(c, 0, gK); issueV(c, 0, gV);
#pragma unroll 1
  for (int j = 0; j < NT; ++j) {
    const int jn = (j + 1 < NT) ? j + 1 : NT - 1, b = j & 1;
    A2_WAIT_V(0); A2_BAR();
    issueK(c, b ^ 1, gK + (size_t)jn * TSTEP); issueV(c, b ^ 1, gV + (size_t)jn * TSTEP);
    sub_tile<true, 0>(c, c.lds + OFF_K + b * KBUF, c.vb0 + b * VBUF, qr, 0.f, tabl + j * KVBLK, m_reg, l_reg, o);
    sub_tile<true, 1>(c, c.lds + OFF_K + b * KBUF, c.vb0 + b * VBUF, qr, 0.f, tabl + j * KVBLK, m_reg, l_reg, o);
  }
  A2_WAIT_V(0); A2_BAR();
}
__device__ __forceinline__ void attn_body(const bf16_t* __restrict__ Qb, const bf16_t* __restrict__ Kh, const bf16_t* __restrict__ Vh, float* Ob, int seq, int q0, float lam, bool SUBTRACT, LAS unsigned char* lds,
                                          bf16_t* Dst, const float* __restrict__ sub_norm, const float* __restrict__ q_gain) {
  int tid = threadIdx.x; asm volatile("" : "+v"(tid));
  const int wid = __builtin_amdgcn_readfirstlane(tid >> 6), lane = tid & 63, r32 = lane & 31, hi = lane >> 5;
  Ctx c; c.lds = lds; c.wid = wid; c.r32 = r32; c.hi = hi;
  c.vb0 = (int)(unsigned)(uintptr_t)(lds + OFF_V) + att::v_rd_base(lane);
  c.al_l = (LAS float*)(lds + OFF_WS) + wid * 64 + 32;
  LAS float* li_l = (LAS float*)(lds + OFF_WS) + wid * 64;
  const LAS float* tab = (const LAS float*)(lds + OFF_TAB);
  { const int P = wid * 1024 + lane * 16, row = P >> 8, cb = (P & 255) ^ ((row & 7) << 4); c.voffK = (unsigned)(row * LDK * 2 + cb); }
  { const int P = wid * 1024 + lane * 16, sub = P >> 9, w = P & 511;
    const int kk = (sub >> 2) * 8 + (w >> 6), k = (kk & ~0xC) | ((kk & 4) << 1) | ((kk & 8) >> 1), col = (sub & 3) * 32 + ((w & 63) >> 1);
    c.voffV = (unsigned)(k * LDK * 2 + col * 2); }
  const int NT = seq / KVBLK;
  int jn0 = q0 / KVBLK - 2, jn1 = q0 / KVBLK + 6; jn0 = jn0 < 0 ? 0 : jn0; jn1 = jn1 > NT ? NT : jn1;
  float m_reg = -1e30f, l_reg = 0; f32x16 o[8] = {}; bf16x8 qr[8];
  const bf16_t* Qw = Qb + (long)(wid * QBLK + r32) * LDQ + hi * 8;
#pragma unroll
  for (int d0 = 0; d0 < 8; ++d0) qr[d0] = *reinterpret_cast<const bf16x8*>(Qw + d0 * 16);
  {
    float f[8][8]; float ss = 0.f;
#pragma unroll
    for (int d0 = 0; d0 < 8; ++d0) { unpack8(*reinterpret_cast<const u32x4*>(&qr[d0]), f[d0]);
#pragma unroll
      for (int e = 0; e < 8; ++e) ss += f[d0][e] * f[d0][e]; }
    { auto rr = __builtin_amdgcn_permlane32_swap(__float_as_uint(ss), __float_as_uint(ss), false, false); ss = __uint_as_float(rr[0]) + __uint_as_float(rr[1]); }
    const float rstd = rsqrtf(ss * (1.0f / 128.0f) + EPS);
#pragma unroll
    for (int d0 = 0; d0 < 8; ++d0) { const f32x4 g0 = *(const f32x4*)(q_gain + d0 * 16 + hi * 8), g1 = *(const f32x4*)(q_gain + d0 * 16 + hi * 8 + 4);
      u32x4 w; w.x = cvt_pk_bf16(f[d0][0] * rstd * g0[0], f[d0][1] * rstd * g0[1]); w.y = cvt_pk_bf16(f[d0][2] * rstd * g0[2], f[d0][3] * rstd * g0[3]);
      w.z = cvt_pk_bf16(f[d0][4] * rstd * g1[0], f[d0][5] * rstd * g1[1]); w.w = cvt_pk_bf16(f[d0][6] * rstd * g1[2], f[d0][7] * rstd * g1[3]);
      qr[d0] = *reinterpret_cast<bf16x8*>(&w); }
  }
  constexpr size_t TSTEP = (size_t)KVBLK * LDK * 2;
  { const LAS float* tabl = tab + (384 + 4 * hi - (q0 + wid * QBLK + r32 - jn0 * KVBLK));
    near_run(c, (const char*)Kh + (size_t)jn0 * TSTEP, (const char*)Vh + (size_t)jn0 * TSTEP, jn1 - jn0, tabl, qr, m_reg, l_reg, o); }
#pragma unroll 1
  for (int rg = 0; rg < 2; ++rg) {
    int rr = rg; asm volatile("" : "+s"(rr));
    const int ja = rr ? jn1 : 0, nt = rr ? NT - jn1 : jn0;
    const float cfar = __uint_as_float(__builtin_amdgcn_readfirstlane(__float_as_uint(tab[rr ? 767 : 0])));
    if (nt > 0) far_run(c, (const char*)Kh + (size_t)ja * TSTEP, (const char*)Vh + (size_t)ja * TSTEP, nt, cfar, qr, m_reg, l_reg, o);
  }
  if (hi == 0) li_l[r32] = l_reg; asm volatile("s_waitcnt lgkmcnt(0)" ::: "memory");
  float rli[16];
#pragma unroll
  for (int r = 0; r < 16; ++r) rli[r] = __builtin_amdgcn_rcpf(li_l[crow(r, hi)]);
  int r32e = r32, hie = hi; asm volatile("" : "+v"(r32e), "+v"(hie));
  float* Ow = Ob + (long)(wid * QBLK) * LDO + (4 * hie) * LDO + r32e;
  if (SUBTRACT) {
    float g[8];
#pragma unroll
    for (int d0 = 0; d0 < 8; ++d0) g[d0] = sub_norm[d0 * 32 + r32e] * 0.8f;
    bf16_t* Dw = Dst + (long)(wid * QBLK + 4 * hie) * LDQ + r32e;
#pragma unroll
    for (int r = 0; r < 16; ++r) { float v[8]; float ss = 0.f;
#pragma unroll
      for (int d0 = 0; d0 < 8; ++d0) { v[d0] = Ow[((r & 3) + 8 * (r >> 2)) * LDO + d0 * 32] - lam * (o[d0][r] * rli[r]); ss += v[d0] * v[d0]; }
      ss += __shfl_xor(ss, 1); ss += __shfl_xor(ss, 2); ss += __shfl_xor(ss, 4); ss += __shfl_xor(ss, 8); ss += __shfl_xor(ss, 16);
      const float rs = rsqrtf(ss * (1.0f / 256.0f) + EPS);
#pragma unroll
      for (int d0 = 0; d0 < 8; ++d0) { const float w = v[d0] * rs * g[d0]; Dw[((r & 3) + 8 * (r >> 2)) * LDQ + d0 * 32] = (bf16_t)(cvt_pk_bf16(w, w) & 0xffffu); }
      asm volatile("" ::: "memory"); }
  } else {
#pragma unroll
    for (int r = 0; r < 16; ++r) {
#pragma unroll
      for (int d0 = 0; d0 < 8; ++d0) Ow[((r & 3) + 8 * (r >> 2)) * LDO + d0 * 32] = o[d0][r] * rli[r]; }
  }
  asm volatile("s_waitcnt vmcnt(0)" ::: "memory");
  __syncthreads();
}
}

__device__ void transpose_cvt(unsigned char* lds, const float* __restrict__ src, bf16_t* __restrict__ dst, int K, int N, int mode, int which, const float* __restrict__ gain = nullptr, int srcld = 0) {
    bf16_t* tile = (bf16_t*)lds;
    const int t = threadIdx.x, ntn = N / 64, ntiles = (K / 64) * ntn; if (srcld == 0) srcld = N;
    for (int tl = blockIdx.x; tl < ntiles; tl += gridDim.x) {
        const int tk = tl / ntn, tn = tl % ntn;
        const int kk = t >> 4, n4 = (t & 15) * 4;
#pragma unroll
        for (int i = 0; i < 2; ++i) { const int k = kk + 32 * i;
            f32x4 v = *(const f32x4*)(src + (size_t)(tk * 64 + k) * srcld + tn * 64 + n4);
            if (gain) v = v * gain[tk * 64 + k];
            const unsigned w0 = cvt_pk_bf16(v[0], v[1]), w1 = cvt_pk_bf16(v[2], v[3]);
            tile[(n4 + 0) * 72 + k] = (bf16_t)(w0 & 0xffff); tile[(n4 + 1) * 72 + k] = (bf16_t)(w0 >> 16);
            tile[(n4 + 2) * 72 + k] = (bf16_t)(w1 & 0xffff); tile[(n4 + 3) * 72 + k] = (bf16_t)(w1 >> 16); }
        __syncthreads();
        { const int n = t >> 3, k8 = (t & 7) * 8; const u32x4 v = *(const u32x4*)(tile + n * 72 + k8);
          const int gn = tn * 64 + n; const int drow = mode ? (gn >> 7) * 256 + which * 128 + (gn & 127) : gn;
          *(u32x4*)(dst + (size_t)drow * K + tk * 64 + k8) = v; }
        __syncthreads();
    }
}
__device__ void rmsnorm_rows(const float* __restrict__ src, const float* __restrict__ gain, bf16_t* __restrict__ dst) {
    const int lane = threadIdx.x & 63, gw = blockIdx.x * 8 + (threadIdx.x >> 6), nw = gridDim.x * 8;
    for (int row = gw; row < T; row += nw) {
        const f32x4* p = (const f32x4*)(src + (size_t)row * DM);
        f32x4 v[8]; float ss = 0.f;
#pragma unroll
        for (int j = 0; j < 8; ++j) { v[j] = p[lane + 64 * j]; ss += v[j][0] * v[j][0] + v[j][1] * v[j][1] + v[j][2] * v[j][2] + v[j][3] * v[j][3]; }
        ss = wave_sum(ss);
        const float rstd = rsqrtf(ss * (1.0f / DM) + EPS);
#pragma unroll
        for (int j = 0; j < 8; ++j) { const f32x4 g = ((const f32x4*)gain)[lane + 64 * j];
            u32x2 w; w.x = cvt_pk_bf16(v[j][0] * rstd * g[0], v[j][1] * rstd * g[1]); w.y = cvt_pk_bf16(v[j][2] * rstd * g[2], v[j][3] * rstd * g[3]);
            *(u32x2*)(dst + (size_t)row * DM + (lane + 64 * j) * 4) = w; }
    }
}
__device__ void cvt_rows(const float* __restrict__ src, bf16_t* __restrict__ dst, size_t n8) {
    for (size_t i = (size_t)blockIdx.x * 512 + threadIdx.x; i < n8; i += (size_t)gridDim.x * 512) {
        const f32x4 a = *(const f32x4*)(src + i * 8), b = *(const f32x4*)(src + i * 8 + 4);
        u32x4 w; w.x = cvt_pk_bf16(a[0], a[1]); w.y = cvt_pk_bf16(a[2], a[3]); w.z = cvt_pk_bf16(b[0], b[1]); w.w = cvt_pk_bf16(b[2], b[3]);
        *(u32x4*)(dst + i * 8) = w; }
}
__device__ void conv_qknorm(bf16_t* proj, const float* __restrict__ conv_w, const float* __restrict__ qg, const float* __restrict__ kg) {
    const int lane = threadIdx.x & 63, gw = blockIdx.x * 8 + (threadIdx.x >> 6), nw = gridDim.x * 8;
    for (int it = gw; it < (T / 16) * 2; it += nw) {
        const int t0 = (it >> 1) * 16, ch = (it & 1) * 512 + lane * 8;
        float w0[8], w1[8], w2[8];
#pragma unroll
        for (int e = 0; e < 8; ++e) { w0[e] = conv_w[ch + e]; w1[e] = conv_w[CW + ch + e]; w2[e] = conv_w[2 * CW + ch + e]; }
        float zp[8], zc[8], zn[8], fa[8], fc[8];
        if ((t0 % SEQ) == 0) {
#pragma unroll
            for (int e = 0; e < 8; ++e) zp[e] = 0.f;
        } else { const bf16_t* r = proj + (size_t)(t0 - 1) * INW + ch; unpack8(*(const u32x4*)r, fa);
#pragma unroll
            for (int e = 0; e < 8; ++e) zp[e] = fa[e]; }
        { const bf16_t* r = proj + (size_t)t0 * INW + ch; unpack8(*(const u32x4*)r, fa);
#pragma unroll
          for (int e = 0; e < 8; ++e) zc[e] = fa[e]; }
        for (int i = 0; i < 16; ++i) { const int t = t0 + i;
            if (((t + 1) % SEQ) == 0) {
#pragma unroll
                for (int e = 0; e < 8; ++e) zn[e] = 0.f;
            } else { const bf16_t* r = proj + (size_t)(t + 1) * INW + ch; unpack8(*(const u32x4*)r, fa);
#pragma unroll
                for (int e = 0; e < 8; ++e) zn[e] = fa[e]; }
            bf16_t* bp = proj + (size_t)t * INW + 2 * CW + ch; float fb[8]; unpack8(*(const u32x4*)bp, fb);
            float y[8];
#pragma unroll
            for (int e = 0; e < 8; ++e) y[e] = fb[e] * (w0[e] * zp[e] + w1[e] * zc[e] + w2[e] * zn[e]);
            u32x4 w; w.x = cvt_pk_bf16(y[0], y[1]); w.y = cvt_pk_bf16(y[2], y[3]); w.z = cvt_pk_bf16(y[4], y[5]); w.w = cvt_pk_bf16(y[6], y[7]);
            *(u32x4*)bp = w;
#pragma unroll
            for (int e = 0; e < 8; ++e) { zp[e] = zc[e]; zc[e] = zn[e]; }
        }
    }
    for (int t = gw; t < T; t += nw) {
        bf16_t* p = proj + (size_t)t * INW + 3 * CW;
#pragma unroll
        for (int j = 2; j < 4; ++j) { const int idx = (j * 64 + lane) * 8; float f[8]; unpack8(*(const u32x4*)(p + idx), f);
            float ss = 0.f;
#pragma unroll
            for (int e = 0; e < 8; ++e) ss += f[e] * f[e];
            ss += __shfl_xor(ss, 8); ss += __shfl_xor(ss, 4); ss += __shfl_xor(ss, 2); ss += __shfl_xor(ss, 1);
            const float rstd = rsqrtf(ss * (1.0f / 128.0f) + EPS);
            const float* g = (j < 2 ? qg : kg) + (idx & 127);
#pragma unroll
            for (int e = 0; e < 8; ++e) f[e] = f[e] * rstd * g[e];
            u32x4 w; w.x = cvt_pk_bf16(f[0], f[1]); w.y = cvt_pk_bf16(f[2], f[3]); w.z = cvt_pk_bf16(f[4], f[5]); w.w = cvt_pk_bf16(f[6], f[7]);
            *(u32x4*)(p + idx) = w; }
    }
}
__device__ void attn_post(bf16_t* proj, const float* __restrict__ sub_norm) {
    const int lane = threadIdx.x & 63, gw = blockIdx.x * 8 + (threadIdx.x >> 6), nw = gridDim.x * 8;
    const f32x4 g = ((const f32x4*)sub_norm)[lane];
    for (int t = gw; t < T; t += nw) {
        const f32x4* O = (const f32x4*)((const float*)proj + (size_t)t * (INW / 2));
        bf16_t* dst = proj + (size_t)t * INW + 3 * CW;
#pragma unroll
        for (int h = 0; h < NH; ++h) { const f32x4 v = O[h * 64 + lane];
            const float ss = wave_sum(v[0] * v[0] + v[1] * v[1] + v[2] * v[2] + v[3] * v[3]);
            const float rstd = rsqrtf(ss * (1.0f / 256.0f) + EPS) * 0.8f;
            u32x2 w; w.x = cvt_pk_bf16(v[0] * rstd * g[0], v[1] * rstd * g[1]); w.y = cvt_pk_bf16(v[2] * rstd * g[2], v[3] * rstd * g[3]);
            *(u32x2*)(dst + h * 256 + lane * 4) = w; }
    }
}
__device__ __forceinline__ int t5_bucket(int rel) {
    const int ret = rel > 0 ? 16 : 0; const int n = rel < 0 ? -rel : rel;
    if (n < 8) return ret + n;
    int large = 8 + (int)(logf((float)n * 0.125f) / 2.7725887f * 8.0f);
    large = large < 15 ? large : 15;
    return ret + large;
}

#define XB_TMO      128
#define XB_XCNT(j)  (256  + 64 * (j))
#define XB_XSUB(j)  (1280 + 64 * (j))
#define XB_XGEN(j)  (2304 + 64 * (j))
#define XB_TOP      3328
#define XB_TOPGEN   3392
#define XCD_BAR_WORDS 3456
#define XB_SPIN_CAP (1u << 18)

__device__ __forceinline__ unsigned xb_ld(unsigned* p)              { return __hip_atomic_load(p, __ATOMIC_RELAXED, __HIP_MEMORY_SCOPE_AGENT); }
__device__ __forceinline__ unsigned xb_add(unsigned* p, unsigned v) { return __hip_atomic_fetch_add(p, v, __ATOMIC_RELAXED, __HIP_MEMORY_SCOPE_AGENT); }
__device__ __forceinline__ unsigned xb_xcc_id() { return (unsigned)__builtin_amdgcn_s_getreg((3 << 11) | 20) & 0xFu; }
#define XB_SPIN(cond, bar) do { unsigned _sp = 0; while (cond) { __builtin_amdgcn_s_sleep(1); \
    if ((++_sp & 255u) == 0u) { if (xb_ld(&(bar)[XB_TMO])) break; if (_sp > XB_SPIN_CAP) { atomicAdd(&(bar)[XB_TMO], 1u); break; } } } } while (0)

struct XcdBarrier {
    unsigned* bar; unsigned x;
    volatile LAS unsigned* st;
};

__device__ __forceinline__ XcdBarrier xcd_barrier_post(unsigned* bar, volatile LAS unsigned* st) {
    XcdBarrier b; b.bar = bar; b.x = xb_xcc_id(); b.st = st;
    if (threadIdx.x == 0) (void)xb_add(&bar[XB_XCNT(b.x)], 1u);
    return b;
}
__device__ __forceinline__ void xcd_barrier_complete(unsigned* bar, unsigned x, unsigned& nloc, unsigned& nx) {
    const unsigned G = gridDim.x * gridDim.y * gridDim.z;
    unsigned sum, cnt, mine, sp = 0u;
    for (;;) {
        sum = 0u; cnt = 0u; mine = 0u;
#pragma unroll
        for (unsigned j = 0; j < 16; ++j) { const unsigned c = xb_ld(&bar[XB_XCNT(j)]); sum += c; cnt += (c > 0u) ? 1u : 0u; mine = (j == x) ? c : mine; }
        if (sum == G) break;
        __builtin_amdgcn_s_sleep(1);
        if ((++sp & 255u) == 0u) { if (xb_ld(&bar[XB_TMO])) break; if (sp > XB_SPIN_CAP) { atomicAdd(&bar[XB_TMO], 1u); break; } }
    }
    nloc = mine > 0u ? mine : 1u; nx = cnt > 0u ? cnt : 1u;
}

__device__ __forceinline__ void xcd_barrier(const XcdBarrier& b) {
    asm volatile("s_waitcnt vmcnt(0)" ::: "memory");
    __syncthreads();
    if (threadIdx.x == 0) {
        unsigned* bar = b.bar;
        __builtin_amdgcn_s_waitcnt(0);
        unsigned nloc = b.st[0], nx = b.st[1];
        if (nloc == 0u) { xcd_barrier_complete(bar, b.x, nloc, nx); b.st[0] = nloc; b.st[1] = nx; }
        const unsigned old = xb_add(&bar[XB_XSUB(b.x)], 1u);
        const unsigned gen = old / nloc;
        if (old + 1u == (gen + 1u) * nloc) {
            __builtin_amdgcn_fence(__ATOMIC_RELEASE, "agent");
            asm volatile("s_waitcnt vmcnt(0)" ::: "memory");
            const unsigned og = xb_add(&bar[XB_TOP], 1u);
            const unsigned tg = og / nx;
            if (og + 1u == (tg + 1u) * nx) xb_add(&bar[XB_TOPGEN], 1u);
            else XB_SPIN(xb_ld(&bar[XB_TOPGEN]) == tg, bar);
            __builtin_amdgcn_fence(__ATOMIC_ACQUIRE, "agent");
            xb_add(&bar[XB_XGEN(b.x)], 1u);
            asm volatile("s_waitcnt vmcnt(0)" ::: "memory");
        } else {
            XB_SPIN(xb_ld(&bar[XB_XGEN(b.x)]) == gen, bar);
            __builtin_amdgcn_fence(__ATOMIC_ACQUIRE, "agent");
            asm volatile("s_waitcnt vmcnt(0)" ::: "memory");
        }
    }
    __syncthreads();
}

__global__ void __launch_bounds__(512, 2) mega(Params P) {
    extern __shared__ __attribute__((aligned(16))) unsigned char lds[];
    cg::grid_group grid = cg::this_grid();
    LAS unsigned char* ldsl = (LAS unsigned char*)lds;
    const int G = gridDim.x, lo = P.ph_lo, hi = P.ph_hi;
    volatile LAS unsigned* xbst = (volatile LAS unsigned*)(ldsl + LDS_XB);
    if (threadIdx.x < 4) xbst[threadIdx.x] = 0u;
    __syncthreads();
    unsigned char* ws = P.ws;
    const float* x = P.in[0]; const float* pin = P.in[1];
    bf16_t* W13_1 = (bf16_t*)(ws + WS_W13_1); bf16_t* W2_1 = (bf16_t*)(ws + WS_W2_1); bf16_t* W13_2 = (bf16_t*)(ws + WS_W13_2); bf16_t* W2_2 = (bf16_t*)(ws + WS_W2_2);
    bf16_t* WIG = (bf16_t*)(ws + WS_WIG); bf16_t* WA = (bf16_t*)(ws + WS_WA); bf16_t* WB = (bf16_t*)(ws + WS_WB); bf16_t* WO = (bf16_t*)(ws + WS_WO);
    bf16_t* WPG = (bf16_t*)(ws + WS_WPG); bf16_t* WPP = (bf16_t*)(ws + WS_WPP);
    bf16_t* RA = (bf16_t*)(ws + WS_A); bf16_t* PROJ = (bf16_t*)(ws + WS_PROJ); bf16_t* GATES = (bf16_t*)(ws + WS_GATES); bf16_t* GB = (bf16_t*)(ws + WS_G);
    bf16_t* PP = (bf16_t*)(ws + WS_PP); bf16_t* P16 = (bf16_t*)(ws + WS_P16); bf16_t* RB = (bf16_t*)(ws + WS_RB);
    float* RSS1 = (float*)(ws + WS_RSS); float* RSS2 = RSS1 + T; float* RSS3 = RSS2 + T;
    float* out = P.out;
#ifndef PHASE_MASK
#define PHASE_MASK 0x1FFFF
#endif
#define IN(k) (((PHASE_MASK >> (k)) & 1) && lo <= (k) && (k) < hi)
#define SYNC(k) do { if (lo <= (k) && (k) + 1 < hi) xcd_barrier(xbar); } while (0)

    if (IN(0)) {
        for (int i = blockIdx.x * 512 + threadIdx.x; i < 3 * T; i += G * 512) RSS1[i] = 0.f;
        if (blockIdx.x == 0) for (int i = threadIdx.x; i < XCD_BAR_WORDS; i += 512) ((unsigned*)(ws + WS_XBAR))[i] = 0u;
        cvt_rows(pin, P16, (size_t)T * PLE / 8);
        transpose_cvt(lds, P.in[22], W13_2, DM, FF, 1, 0, P.in[21]); transpose_cvt(lds, P.in[23], W13_2, DM, FF, 1, 1, P.in[21]); transpose_cvt(lds, P.in[24], W2_2, FF, DM, 0, 0);
        transpose_cvt(lds, P.in[7], WIG, DM, CW, 1, 0, P.in[6], INW); transpose_cvt(lds, P.in[7] + CW, WIG, DM, CW, 1, 1, P.in[6], INW);
        transpose_cvt(lds, P.in[7] + 2 * CW, WIG + (size_t)2 * CW * DM, DM, INW - 2 * CW, 0, 0, P.in[6], INW); transpose_cvt(lds, P.in[19], WIG + (size_t)INW * DM, DM, 2 * DM, 0, 0, P.in[6]);
        transpose_cvt(lds, P.in[17], WA, CW, DM, 0, 0); transpose_cvt(lds, P.in[18], WB, AW, DM, 0, 0);
        transpose_cvt(lds, P.in[20], WO, DM, DM, 0, 0); transpose_cvt(lds, P.in[26], WPG, DM, DM, 0, 0, P.in[25]); transpose_cvt(lds, P.in[27], WPP, PLE, DM, 0, 0);
        transpose_cvt(lds, P.in[5], W2_1, FF, DM, 0, 0);
        transpose_cvt(lds, P.in[3], W13_1, DM, FF, 1, 0); transpose_cvt(lds, P.in[4], W13_1, DM, FF, 1, 1);
        rmsnorm_rows(x, P.in[2], RA);
    }
    if (lo <= 0 && 1 < hi) grid.sync();
    XcdBarrier xbar = xcd_barrier_post((unsigned*)(ws + WS_XBAR), xbst);
    if (IN(1)) { pg8::Gemm g{RA, W13_1, T, 2 * FF, DM, DM}; pg8::StaticOrder S; S.init(T, 2 * FF, G, (int)blockIdx.x); pg8::EpiSwiGLU<false> E{GB, FF, nullptr}; pg8::gemm_phase(ldsl, g, S, E); }
    SYNC(1);
    if (IN(2)) { pg8::Gemm g{GB, W2_1, T, DM, FF, FF}; pg8::StaticOrder S; S.init(T, DM, G, (int)blockIdx.x); pg8::EpiRes<false> E{x, DM, 0.5f, RA, RSS1}; pg8::gemm_phase(ldsl, g, S, E); }
    SYNC(2);
    if (IN(4)) { pg8::Gemm g{RA, WIG, T, INW + 2 * DM, DM, DM}; pg8::StaticOrder S; S.init(T, INW + 2 * DM, G, (int)blockIdx.x); pg8::EpiProjGate E{PROJ, INW, GATES, 2 * DM, INW / 256, RSS1}; pg8::gemm_phase(ldsl, g, S, E); }
    SYNC(4);
    if (IN(5)) conv_qknorm(PROJ, P.in[8], P.in[9], P.in[10]);
    SYNC(5);
    if (IN(6)) {
        LAS float* tab = (LAS float*)(ldsl + att2::OFF_TAB);
        float s1 = 0.f, s2 = 0.f;
        { const int l = threadIdx.x & 63; s1 = P.in[11][l] * P.in[12][l] + P.in[11][l + 64] * P.in[12][l + 64]; s2 = P.in[13][l] * P.in[14][l] + P.in[13][l + 64] * P.in[14][l + 64]; s1 = wave_sum(s1); s2 = wave_sum(s2); }
        const float lam = __uint_as_float(__builtin_amdgcn_readfirstlane(__float_as_uint(__expf(s1) - __expf(s2) + 0.2f)));
        for (int it = blockIdx.x; it < NB * NH * (SEQ / 256); it += G) {
            const int bh = it & 7, qb = it >> 3, b = bh >> 2, h = bh & 3, q0 = qb * 256;
            __syncthreads();
            for (int i = threadIdx.x; i < 768; i += 512) tab[i] = P.in[16][t5_bucket(i - 384) * NH + h] * (1.0f / att::SCALE);
            __syncthreads();
            const bf16_t* rowq = PROJ + (size_t)(b * SEQ + q0) * INW; const bf16_t* rowk = PROJ + (size_t)(b * SEQ) * INW;
            float* Ob = (float*)PROJ + (size_t)(b * SEQ + q0) * (INW / 2) + h * 256;
#pragma unroll 1
            for (int sub = 0; sub < 2; ++sub) {
                int sb = sub; asm volatile("" : "+s"(sb));
                int seqv = SEQ; asm volatile("" : "+s"(seqv));
                att2::attn_body(rowq + 3 * CW + h * 256 + sb * 128, rowk + 4 * CW + h * 256 + sb * 128, rowk + 5 * CW + h * 256, Ob, seqv, q0, lam, sb != 0, ldsl, (bf16_t*)rowq + 3 * CW + h * 256, P.in[15], P.in[9]);
            }
        }
    }
    SYNC(6);
    if (IN(8)) { pg8::Gemm g{PROJ + 2 * CW, WA, T, DM, CW, INW}; pg8::StaticOrder S; S.init(T, DM, G, (int)blockIdx.x); pg8::EpiGated<false> E{PROJ + 4 * CW, INW, GATES, 2 * DM, 0}; pg8::gemm_phase(ldsl, g, S, E); }
    if (IN(9)) { pg8::Gemm g{PROJ + 3 * CW, WB, T, DM, AW, INW}; pg8::StaticOrder S; S.init(T, DM, G, (int)blockIdx.x); pg8::EpiGated<true> E{PROJ + 4 * CW, INW, GATES, 2 * DM, DM}; pg8::gemm_phase(ldsl, g, S, E); }
    SYNC(9);
    if (IN(10)) { pg8::Gemm g{PROJ + 4 * CW, WO, T, DM, DM, INW}; pg8::StaticOrder S; S.init(T, DM, G, (int)blockIdx.x); pg8::EpiRes<true> E{RA, DM, 1.0f, RB, RSS2}; pg8::gemm_phase(ldsl, g, S, E); }
    SYNC(10);
    if (IN(12)) { pg8::Gemm g{RB, W13_2, T, 2 * FF, DM, DM}; pg8::StaticOrder S; S.init(T, 2 * FF, G, (int)blockIdx.x); pg8::EpiSwiGLU<true> E{GB, FF, RSS2}; pg8::gemm_phase(ldsl, g, S, E); }
    SYNC(12);
    if (IN(13)) { pg8::Gemm g{GB, W2_2, T, DM, FF, FF}; pg8::StaticOrder S; S.init(T, DM, G, (int)blockIdx.x); pg8::EpiRes<true> E{RB, DM, 0.5f, RA, RSS3}; pg8::gemm_phase(ldsl, g, S, E); }
    if (IN(15)) { pg8::Gemm g{P16, WPP, T, DM, PLE, PLE}; pg8::StaticOrder S; S.init(T, DM, G, (int)blockIdx.x); pg8::EpiBf16NP E{PP, DM}; pg8::gemm_phase(ldsl, g, S, E); }
    SYNC(13);
    if (IN(16)) { pg8::Gemm g{RA, WPG, T, DM, DM, DM}; pg8::StaticOrder S; S.init(T, DM, G, (int)blockIdx.x); pg8::EpiFinal E{RA, out, DM, PP, RSS3}; pg8::gemm_phase(ldsl, g, S, E); }
#undef IN
#undef SYNC
}

extern "C" void kernel_launch(void* const* d_in, const int* in_sizes, int n_in, void* d_out, int out_size, void* d_ws, size_t ws_size, hipStream_t stream) {
    static int grid_blocks = 0;
    if (grid_blocks == 0) {
        if (n_in != 28 || in_sizes[0] != T * DM || out_size != T * DM || ws_size < WS_END) {
            fprintf(stderr, "kernel_launch: shape/workspace mismatch: n_in %d in0 %d out %d ws %zu (need %zu)\n", n_in, n_in > 0 ? in_sizes[0] : -1, out_size, ws_size, (size_t)WS_END); grid_blocks = -1; return; }
        int dev = 0, cus = 0, per_cu = 0;
        hipGetDevice(&dev); hipDeviceGetAttribute(&cus, hipDeviceAttributeMultiprocessorCount, dev);
        if (hipFuncSetAttribute((const void*)mega, hipFuncAttributeMaxDynamicSharedMemorySize, LDS_BYTES) != hipSuccess) { fprintf(stderr, "kernel_launch: hipFuncSetAttribute failed\n"); grid_blocks = -1; return; }
        if (hipOccupancyMaxActiveBlocksPerMultiprocessor(&per_cu, (const void*)mega, 512, LDS_BYTES) != hipSuccess || per_cu < 1) { fprintf(stderr, "kernel_launch: occupancy query says %d\n", per_cu); per_cu = 1; }
        (void)hipGetLastError();
        grid_blocks = cus * 1;
        if (grid_blocks % 8 != 0) grid_blocks -= grid_blocks % 8;
    }
    if (grid_blocks < 0) return;
    Params p{};
    for (int i = 0; i < 28; ++i) p.in[i] = (const float*)d_in[i];
    p.out = (float*)d_out; p.ws = (unsigned char*)d_ws; p.ph_lo = 0; p.ph_hi = 17;
    void* args[] = {&p};
    hipError_t e = hipLaunchCooperativeKernel((const void*)mega, dim3(grid_blocks), dim3(512), args, LDS_BYTES, stream);
    if (e != hipSuccess) fprintf(stderr, "cooperative launch failed: %s (grid %d)\n", hipGetErrorString(e), grid_blocks);
}
```

```cpp
#include <hip/hip_runtime.h>
#include <hip/hip_cooperative_groups.h>
#include <cstdio>
#include <cstdint>
namespace cg = cooperative_groups;

#define LAS __attribute__((address_space(3)))
typedef unsigned short bf16_t;
typedef short bf16x8 __attribute__((ext_vector_type(8)));
typedef short s16x4 __attribute__((ext_vector_type(4)));
typedef float f32x2 __attribute__((ext_vector_type(2)));
typedef float f32x4 __attribute__((ext_vector_type(4)));
typedef float f32x16 __attribute__((ext_vector_type(16)));
typedef unsigned u32x2 __attribute__((ext_vector_type(2)));
typedef unsigned u32x4 __attribute__((ext_vector_type(4)));

constexpr int DM = 2048, NB = 2, SEQ = 16384, T = NB * SEQ, FF = 5632, CW = 1024, AW = 1024, INW = 6144, PLE = 256, NH = 4;
constexpr float EPS = 1e-6f;
constexpr int LDS_XB = 2 * 16384 + 3 * 32768 + 2048 + 768 * 4;
constexpr int LDS_BYTES = LDS_XB + 16;

constexpr size_t SZ_W13 = (size_t)2 * FF * DM * 2, SZ_W2 = (size_t)DM * FF * 2;
constexpr size_t WS_W13_1 = 0, WS_W2_1 = WS_W13_1 + SZ_W13, WS_W13_2 = WS_W2_1 + SZ_W2, WS_W2_2 = WS_W13_2 + SZ_W13;
constexpr size_t WS_WIG = WS_W2_2 + SZ_W2;
constexpr size_t WS_WA = WS_WIG + (size_t)(INW + 2 * DM) * DM * 2;
constexpr size_t WS_WB = WS_WA + (size_t)DM * CW * 2;
constexpr size_t WS_WO = WS_WB + (size_t)DM * AW * 2;
constexpr size_t WS_WPG = WS_WO + (size_t)DM * DM * 2;
constexpr size_t WS_WPP = WS_WPG + (size_t)DM * DM * 2;
constexpr size_t WS_A = WS_WPP + (size_t)DM * PLE * 2;
constexpr size_t WS_BIG = WS_A + (size_t)T * DM * 2;
constexpr size_t WS_PROJ = WS_BIG;
constexpr size_t WS_GATES = WS_PROJ + (size_t)T * INW * 2;
constexpr size_t WS_G = WS_BIG;
constexpr size_t WS_PP = WS_GATES + (size_t)T * DM * 2;
constexpr size_t WS_RB = WS_GATES;
constexpr size_t WS_P16 = WS_GATES + (size_t)T * 2 * DM * 2;
constexpr size_t WS_RSS = WS_P16 + (size_t)T * PLE * 2;
constexpr size_t WS_XBAR = WS_RSS + (size_t)3 * T * 4;
constexpr size_t WS_END = WS_XBAR + 16384;

struct Params { const float* in[28]; float* out; unsigned char* ws; int ph_lo, ph_hi; };

__device__ __forceinline__ unsigned cvt_pk_bf16(float lo, float hi) { unsigned r; asm volatile("v_cvt_pk_bf16_f32 %0, %1, %2" : "=v"(r) : "v"(lo), "v"(hi)); return r; }
__device__ __forceinline__ float bf_lo(unsigned w) { return __uint_as_float(w << 16); }
__device__ __forceinline__ float bf_hi(unsigned w) { return __uint_as_float(w & 0xffff0000u); }
__device__ __forceinline__ float sigmoidf_(float x) { return __builtin_amdgcn_rcpf(1.0f + __expf(-x)); }
__device__ __forceinline__ void unpack8(const u32x4 w, float* f) { f[0] = bf_lo(w.x); f[1] = bf_hi(w.x); f[2] = bf_lo(w.y); f[3] = bf_hi(w.y); f[4] = bf_lo(w.z); f[5] = bf_hi(w.z); f[6] = bf_lo(w.w); f[7] = bf_hi(w.w); }
__device__ __forceinline__ float wave_sum(float s) {
    s += __shfl_xor(s, 32); s += __shfl_xor(s, 16); s += __shfl_xor(s, 8); s += __shfl_xor(s, 4); s += __shfl_xor(s, 2); s += __shfl_xor(s, 1); return s; }

namespace pg8 {
constexpr int BM = 256, BK = 64, HALF = 128, HTB = HALF * BK * 2, STAGE_BYTES = 8 * HTB, NXCD = 8, WGM = 8;
__device__ __forceinline__ int lds_byte(int r, int c) { const int st = (r >> 4) * 2 + (c >> 5), rr = r & 15, cc = c & 31, ob = rr * 64 + cc * 2; return st * 1024 + (ob ^ (((ob >> 9) & 1) << 5)); }
__device__ __forceinline__ void stage_rc(int b, int& R, int& C) { const int st = b / 1024, sb = b % 1024, swz = sb ^ (((sb >> 9) & 1) << 5); R = (st >> 1) * 16 + swz / 64; C = (st & 1) * 32 + (swz % 64) / 2; }
__device__ __forceinline__ int perm32(int rho) { const int n = rho >> 4, i = rho & 15; return 8 * (i >> 2) + 4 * n + (i & 3); }

struct Unit { int pm, pn; };
struct Gemm { const bf16_t* A; const bf16_t* Bt; int M, N, K, lda; };

struct StaticOrder {
    int nM, nN, nwg, G, c, wgm;
    __device__ void init(int M, int N, int G_, int c_) { nM = M / BM; nN = N / BM; nwg = nM * nN; G = G_; c = c_; wgm = nN <= 8 ? 4 : WGM; }
    __device__ bool next(int i, Unit& u) const {
        const long L = (long)i * G + c; if (L >= nwg) return false;
        int wgid = (int)L; { const int q = nwg / NXCD, r = nwg % NXCD, xcd = wgid % NXCD, off = wgid / NXCD; wgid = (xcd < r ? xcd * (q + 1) : r * (q + 1) + (xcd - r) * q) + off; }
        const int nig = wgm * nN, gid = wgid / nig, fm = gid * wgm, gsz = (nM - fm) < wgm ? (nM - fm) : wgm;
        u.pm = fm + ((wgid % nig) % gsz); u.pn = (wgid % nig) / gsz; return true;
    }
};

typedef f32x4 Acc[2][2][4][2];

struct EpiSwiGLU {
    static constexpr bool PERM = true;
    bf16_t* O; int ldc; const float* rss;
    __device__ __forceinline__ void operator()(const Acc& acc, const Unit& u, int wr, int wc, int fr, int fq) const {
        const int row0 = u.pm * BM + wr * 64 + fr, col0 = u.pn * HALF + wc * 32 + 8 * fq;
        float rsv[2][4];
#pragma unroll
        for (int ai = 0; ai < 2; ++ai)
#pragma unroll
            for (int m = 0; m < 4; ++m) rsv[ai][m] = rss ? rss[row0 + ai * HALF + m * 16] : 0.f;
#pragma unroll
        for (int ai = 0; ai < 2; ++ai)
#pragma unroll
            for (int m = 0; m < 4; ++m) {
                const int row = row0 + ai * HALF + m * 16;
                const float rs = rss ? rsqrtf(rsv[ai][m] * (1.0f / DM) + EPS) : 1.0f;
                bf16_t* rowp = O + (size_t)row * ldc + col0;
                float v[8];
#pragma unroll
                for (int n = 0; n < 2; ++n)
#pragma unroll
                    for (int j = 0; j < 4; ++j) { const float g = acc[ai][0][m][n][j] * rs, up = acc[ai][1][m][n][j] * rs; v[n * 4 + j] = g * sigmoidf_(g) * up; }
                u32x4 w; w.x = cvt_pk_bf16(v[0], v[1]); w.y = cvt_pk_bf16(v[2], v[3]); w.z = cvt_pk_bf16(v[4], v[5]); w.w = cvt_pk_bf16(v[6], v[7]);
                *(u32x4*)rowp = w;
            }
    }
};
template <bool BASE_BF16> struct EpiRes {
    static constexpr bool PERM = true;
    const void* base; int ldc; float alpha; bf16_t* obf; float* rss;
    __device__ __forceinline__ void operator()(const Acc& acc, const Unit& u, int wr, int wc, int fr, int fq) const {
        const int row0 = u.pm * BM + wr * 64 + fr, col0 = u.pn * BM + wc * 32 + 8 * fq;
#pragma unroll
        for (int ai = 0; ai < 2; ++ai) {
            u32x4 wb[4][2]; f32x4 fb0[4][2], fb1[4][2];
#pragma unroll
            for (int m = 0; m < 4; ++m) { const size_t off = (size_t)(row0 + ai * HALF + m * 16) * ldc + col0;
#pragma unroll
                for (int bj = 0; bj < 2; ++bj) {
                    if (BASE_BF16) wb[m][bj] = *(const u32x4*)((const bf16_t*)base + off + bj * HALF);
                    else { fb0[m][bj] = *(const f32x4*)((const float*)base + off + bj * HALF); fb1[m][bj] = *(const f32x4*)((const float*)base + off + bj * HALF + 4); } } }
#pragma unroll
            for (int m = 0; m < 4; ++m) { const int row = row0 + ai * HALF + m * 16; const size_t off = (size_t)row * ldc + col0; float ss = 0.f;
#pragma unroll
                for (int bj = 0; bj < 2; ++bj) {
                    f32x4 b0, b1;
                    if (BASE_BF16) { const u32x4 w = wb[m][bj]; b0 = (f32x4){bf_lo(w.x), bf_hi(w.x), bf_lo(w.y), bf_hi(w.y)}; b1 = (f32x4){bf_lo(w.z), bf_hi(w.z), bf_lo(w.w), bf_hi(w.w)}; }
                    else { b0 = fb0[m][bj]; b1 = fb1[m][bj]; }
                    const f32x4 r0 = b0 + alpha * acc[ai][bj][m][0], r1 = b1 + alpha * acc[ai][bj][m][1];
                    ss += ((r0[0] * r0[0] + r0[1] * r0[1]) + (r0[2] * r0[2] + r0[3] * r0[3])) + ((r1[0] * r1[0] + r1[1] * r1[1]) + (r1[2] * r1[2] + r1[3] * r1[3]));
                    u32x4 w; w.x = cvt_pk_bf16(r0[0], r0[1]); w.y = cvt_pk_bf16(r0[2], r0[3]); w.z = cvt_pk_bf16(r1[0], r1[1]); w.w = cvt_pk_bf16(r1[2], r1[3]);
                    *(u32x4*)(obf + off + bj * HALF) = w; }
                ss += __shfl_xor(ss, 16); ss += __shfl_xor(ss, 32);
                if (fq == 0) atomicAdd(rss + row, ss); }
            asm volatile("" ::: "memory"); }
    }
};
struct EpiProjGate {
    static constexpr bool PERM = true;
    bf16_t* O0; int ld0; bf16_t* O1; int ld1; int nsplit; const float* rss;
    __device__ __forceinline__ void operator()(const Acc& acc, const Unit& u, int wr, int wc, int fr, int fq) const {
        const bool gate = u.pn >= nsplit;
        bf16_t* base = gate ? O1 : O0; const int ldc = gate ? ld1 : ld0;
        const int row0 = u.pm * BM + wr * 64 + fr, col0 = (gate ? u.pn - nsplit : u.pn) * BM + wc * 32 + 8 * fq;
        float rsv[2][4];
#pragma unroll
        for (int ai = 0; ai < 2; ++ai)
#pragma unroll
            for (int m = 0; m < 4; ++m) rsv[ai][m] = rss[row0 + ai * HALF + m * 16];
#pragma unroll
        for (int ai = 0; ai < 2; ++ai)
#pragma unroll
            for (int m = 0; m < 4; ++m) { const int row = row0 + ai * HALF + m * 16; bf16_t* rowp = base + (size_t)row * ldc + col0;
                const float rs = rsqrtf(rsv[ai][m] * (1.0f / DM) + EPS);
                if (u.pn < 8) {
                    const float rs2 = rs * rs; const f32x4 z0 = acc[ai][0][m][0] * acc[ai][1][m][0] * rs2, z1 = acc[ai][0][m][1] * acc[ai][1][m][1] * rs2;
                    u32x4 w; w.x = cvt_pk_bf16(z0[0], z0[1]); w.y = cvt_pk_bf16(z0[2], z0[3]); w.z = cvt_pk_bf16(z1[0], z1[1]); w.w = cvt_pk_bf16(z1[2], z1[3]);
                    *(u32x4*)(O0 + (size_t)row * ld0 + u.pn * HALF + wc * 32 + 8 * fq) = w;
                    continue; }
#pragma unroll
                for (int bj = 0; bj < 2; ++bj) { f32x4 v0 = acc[ai][bj][m][0] * rs, v1 = acc[ai][bj][m][1] * rs;
                    if (gate) {
#pragma unroll
                        for (int j = 0; j < 4; ++j) { v0[j] = sigmoidf_(v0[j]); v1[j] = sigmoidf_(v1[j]); } }
                    u32x4 w; w.x = cvt_pk_bf16(v0[0], v0[1]); w.y = cvt_pk_bf16(v0[2], v0[3]); w.z = cvt_pk_bf16(v1[0], v1[1]); w.w = cvt_pk_bf16(v1[2], v1[3]);
                    *(u32x4*)(rowp + bj * HALF) = w; } }
    }
};
template <bool ADD> struct EpiGated {
    static constexpr bool PERM = true;
    bf16_t* O; int ldc; const bf16_t* gate; int ldg; int goff;
    __device__ __forceinline__ void operator()(const Acc& acc, const Unit& u, int wr, int wc, int fr, int fq) const {
        const int row0 = u.pm * BM + wr * 64 + fr, col0 = u.pn * BM + wc * 32 + 8 * fq;
#pragma unroll
        for (int ai = 0; ai < 2; ++ai) {
            u32x4 g[4][2], pv[4][2];
#pragma unroll
            for (int m = 0; m < 4; ++m) { const size_t r = (size_t)(row0 + ai * HALF + m * 16);
#pragma unroll
                for (int bj = 0; bj < 2; ++bj) { g[m][bj] = *(const u32x4*)(gate + r * ldg + goff + col0 + bj * HALF); if (ADD) pv[m][bj] = *(const u32x4*)(O + r * ldc + col0 + bj * HALF); } }
#pragma unroll
            for (int m = 0; m < 4; ++m) { const size_t r = (size_t)(row0 + ai * HALF + m * 16);
#pragma unroll
                for (int bj = 0; bj < 2; ++bj) { const f32x4 v0 = acc[ai][bj][m][0], v1 = acc[ai][bj][m][1]; const u32x4 gg = g[m][bj];
                    float o[8] = {bf_lo(gg.x) * v0[0], bf_hi(gg.x) * v0[1], bf_lo(gg.y) * v0[2], bf_hi(gg.y) * v0[3], bf_lo(gg.z) * v1[0], bf_hi(gg.z) * v1[1], bf_lo(gg.w) * v1[2], bf_hi(gg.w) * v1[3]};
                    if (ADD) { const u32x4 p = pv[m][bj];
                        o[0] += bf_lo(p.x); o[1] += bf_hi(p.x); o[2] += bf_lo(p.y); o[3] += bf_hi(p.y); o[4] += bf_lo(p.z); o[5] += bf_hi(p.z); o[6] += bf_lo(p.w); o[7] += bf_hi(p.w); }
                    u32x4 w; w.x = cvt_pk_bf16(o[0], o[1]); w.y = cvt_pk_bf16(o[2], o[3]); w.z = cvt_pk_bf16(o[4], o[5]); w.w = cvt_pk_bf16(o[6], o[7]);
                    *(u32x4*)(O + r * ldc + col0 + bj * HALF) = w; } }
            asm volatile("" ::: "memory"); }
    }
};
struct EpiBf16NP {
    static constexpr bool PERM = true;
    bf16_t* O; int ldc;
    __device__ __forceinline__ void operator()(const Acc& acc, const Unit& u, int wr, int wc, int fr, int fq) const {
        const int row0 = u.pm * BM + wr * 64 + fr, col0 = u.pn * BM + wc * 32 + 8 * fq;
#pragma unroll
        for (int ai = 0; ai < 2; ++ai)
#pragma unroll
            for (int m = 0; m < 4; ++m) { const size_t off = (size_t)(row0 + ai * HALF + m * 16) * ldc + col0;
#pragma unroll
                for (int bj = 0; bj < 2; ++bj) { const f32x4 v0 = acc[ai][bj][m][0], v1 = acc[ai][bj][m][1];
                    u32x4 w; w.x = cvt_pk_bf16(v0[0], v0[1]); w.y = cvt_pk_bf16(v0[2], v0[3]); w.z = cvt_pk_bf16(v1[0], v1[1]); w.w = cvt_pk_bf16(v1[2], v1[3]);
                    *(u32x4*)(O + off + bj * HALF) = w; } }
    }
};
struct EpiFinal {
    static constexpr bool PERM = true;
    const bf16_t* base; float* out; int ldc; const bf16_t* pp; const float* rss;
    __device__ __forceinline__ void operator()(const Acc& acc, const Unit& u, int wr, int wc, int fr, int fq) const {
        const int row0 = u.pm * BM + wr * 64 + fr, col0 = u.pn * BM + wc * 32 + 8 * fq;
        float rsv[2][4];
#pragma unroll
        for (int ai = 0; ai < 2; ++ai)
#pragma unroll
            for (int m = 0; m < 4; ++m) rsv[ai][m] = rss[row0 + ai * HALF + m * 16];
#pragma unroll
        for (int ai = 0; ai < 2; ++ai) {
            u32x4 bs[4][2], pw[4][2];
#pragma unroll
            for (int m = 0; m < 4; ++m) { const size_t off = (size_t)(row0 + ai * HALF + m * 16) * ldc + col0;
#pragma unroll
                for (int bj = 0; bj < 2; ++bj) { bs[m][bj] = *(const u32x4*)(base + off + bj * HALF); pw[m][bj] = *(const u32x4*)(pp + off + bj * HALF); } }
#pragma unroll
            for (int m = 0; m < 4; ++m) { const int row = row0 + ai * HALF + m * 16; const size_t off = (size_t)row * ldc + col0; const float rs = rsqrtf(rsv[ai][m] * (1.0f / DM) + EPS);
#pragma unroll
                for (int bj = 0; bj < 2; ++bj) { const u32x4 bw = bs[m][bj], q = pw[m][bj]; const f32x4 a0 = acc[ai][bj][m][0] * rs, a1 = acc[ai][bj][m][1] * rs;
                    f32x4 r0, r1;
                    r0[0] = bf_lo(bw.x) + sigmoidf_(a0[0]) * bf_lo(q.x); r0[1] = bf_hi(bw.x) + sigmoidf_(a0[1]) * bf_hi(q.x); r0[2] = bf_lo(bw.y) + sigmoidf_(a0[2]) * bf_lo(q.y); r0[3] = bf_hi(bw.y) + sigmoidf_(a0[3]) * bf_hi(q.y);
                    r1[0] = bf_lo(bw.z) + sigmoidf_(a1[0]) * bf_lo(q.z); r1[1] = bf_hi(bw.z) + sigmoidf_(a1[1]) * bf_hi(q.z); r1[2] = bf_lo(bw.w) + sigmoidf_(a1[2]) * bf_lo(q.w); r1[3] = bf_hi(bw.w) + sigmoidf_(a1[3]) * bf_hi(q.w);
                    *(f32x4*)(out + off + bj * HALF) = r0; *(f32x4*)(out + off + bj * HALF + 4) = r1; } }
            asm volatile("" ::: "memory"); }
    }
};

template <class Epi>
__device__ __forceinline__ void gemm_phase(LAS unsigned char* lds, const Gemm g, const StaticOrder& S, const Epi& E) {
    const int tid = threadIdx.x, wid = __builtin_amdgcn_readfirstlane(tid >> 6), lane = tid & 63, wr = wid >> 2, wc = wid & 3, fr = lane & 15, fq = lane >> 4;
    const int K = g.K, nt = K / BK, lda = g.lda;
    unsigned voffA[2], voffB[2];
#pragma unroll
    for (int i = 0; i < 2; ++i) { int R, C; stage_rc(tid * 16 + i * 8192, R, C); const int Rb = Epi::PERM ? ((R & ~31) + perm32(R & 31)) : R;
        voffA[i] = (unsigned)(R * lda + C) * 2u; voffB[i] = (unsigned)(Rb * K + C) * 2u; }
    const size_t kstep = (size_t)(BK * 2);
    const size_t hstepA = (size_t)HALF * lda * 2, hstepB = (size_t)HALF * K * 2;
    const size_t tstepA = 2 * hstepA, tstepB = 2 * hstepB;
    const unsigned ldsw = (unsigned)wid * 1024u;
    const int aoff = lds_byte(wr * 64 + fr, fq * 8), boff = lds_byte(wc * 32 + fr, fq * 8);
#define PG8_SA(b, h) (((b) * 2 + (h)) * HTB)
#define PG8_SB(b, h) ((4 + (b) * 2 + (h)) * HTB)
#define PG8_STAGE(bufoff, gbase, voff) do { _Pragma("unroll") for (int _i = 0; _i < 2; ++_i) \
        __builtin_amdgcn_global_load_lds((const unsigned*)((const char*)(gbase) + (voff)[_i]), (LAS unsigned*)(lds + (bufoff) + ldsw + _i * 8192), 16, 0, 0); } while (0)
#define PG8_LDA(dst, b, h) do { _Pragma("unroll") for (int m = 0; m < 4; ++m) _Pragma("unroll") for (int k = 0; k < 2; ++k) dst[m][k] = *(const LAS bf16x8*)(lds + PG8_SA(b, h) + aoff + m * 2048 + k * 1024); } while (0)
#define PG8_LDB(dst, b, h) do { _Pragma("unroll") for (int n = 0; n < 2; ++n) _Pragma("unroll") for (int k = 0; k < 2; ++k) dst[n][k] = *(const LAS bf16x8*)(lds + PG8_SB(b, h) + boff + n * 2048 + k * 1024); } while (0)
#define PG8_MMA(ai, bj, At, Bt) do { __builtin_amdgcn_s_setprio(1); _Pragma("unroll") for (int m = 0; m < 4; ++m) _Pragma("unroll") for (int n = 0; n < 2; ++n) _Pragma("unroll") for (int k = 0; k < 2; ++k) \
        acc[ai][bj][m][n] = __builtin_amdgcn_mfma_f32_16x16x32_bf16(Bt[n][k], At[m][k], acc[ai][bj][m][n], 0, 0, 0); __builtin_amdgcn_s_setprio(0); } while (0)
#define PG8_WAIT_V(n) asm volatile("s_waitcnt vmcnt(" #n ")" ::: "memory")
#define PG8_WAIT_L(n) asm volatile("s_waitcnt lgkmcnt(" #n ")" ::: "memory")
#define PG8_BAR __builtin_amdgcn_s_barrier()
#define PG8_SCHED __builtin_amdgcn_sched_barrier(0)
    Unit cur, nxt; int ui = 0;
    if (!S.next(0, cur)) return;
    f32x4 acc[2][2][4][2];
#pragma unroll
    for (int a = 0; a < 2; ++a)
#pragma unroll
        for (int b = 0; b < 2; ++b)
#pragma unroll
            for (int m = 0; m < 4; ++m)
#pragma unroll
                for (int n = 0; n < 2; ++n) acc[a][b][m][n] = (f32x4){0.f, 0.f, 0.f, 0.f};
    bf16x8 At[4][2], B0[2][2], B1[2][2];
    const char* cA = (const char*)g.A + (size_t)cur.pm * tstepA; const char* cB = (const char*)g.Bt + (size_t)cur.pn * tstepB;
    PG8_STAGE(PG8_SB(0, 0), cB, voffB); PG8_STAGE(PG8_SA(0, 0), cA, voffA); PG8_STAGE(PG8_SB(0, 1), cB + hstepB, voffB); PG8_STAGE(PG8_SA(0, 1), cA + hstepA, voffA);
    if (wr == 1) PG8_BAR;
    PG8_WAIT_V(4); PG8_BAR;
    PG8_STAGE(PG8_SB(1, 0), cB + kstep, voffB); PG8_STAGE(PG8_SA(1, 0), cA + kstep, voffA); PG8_STAGE(PG8_SB(1, 1), cB + hstepB + kstep, voffB);
    PG8_WAIT_V(6); PG8_BAR;
    for (;;) {
        const bool has_next = S.next(ui + 1, nxt);
        const char* nA = has_next ? (const char*)g.A + (size_t)nxt.pm * tstepA : cA; const char* nB = has_next ? (const char*)g.Bt + (size_t)nxt.pn * tstepB : cB;
        for (int t = 0; t < nt; t += 2) {
            const bool last = (t == nt - 2);
            const char* a1 = cA + (size_t)(t + 1) * kstep;
            const char* a2 = last ? nA : cA + (size_t)(t + 2) * kstep; const char* b2 = last ? nB : cB + (size_t)(t + 2) * kstep;
            const char* a3 = a2 + kstep; const char* b3 = b2 + kstep;
            PG8_LDB(B0, 0, 0); PG8_SCHED; PG8_LDA(At, 0, 0); PG8_STAGE(PG8_SA(1, 1), a1 + hstepA, voffA);
            PG8_WAIT_L(8); PG8_BAR; PG8_WAIT_L(0); PG8_MMA(0, 0, At, B0); PG8_BAR; PG8_SCHED;
            PG8_LDB(B1, 0, 1); PG8_STAGE(PG8_SB(0, 0), b2, voffB);
            PG8_BAR; PG8_WAIT_L(0); PG8_MMA(0, 1, At, B1); PG8_BAR;
            PG8_LDA(At, 0, 1); PG8_STAGE(PG8_SA(0, 0), a2, voffA);
            PG8_BAR; PG8_WAIT_L(0); PG8_MMA(1, 0, At, B0); PG8_BAR; PG8_SCHED;
            PG8_STAGE(PG8_SB(0, 1), b2 + hstepB, voffB);
            PG8_WAIT_V(6); PG8_BAR; PG8_MMA(1, 1, At, B1); PG8_BAR;
            PG8_LDB(B0, 1, 0); PG8_SCHED; PG8_LDA(At, 1, 0); PG8_STAGE(PG8_SA(0, 1), a2 + hstepA, voffA);
            PG8_WAIT_L(8); PG8_BAR; PG8_WAIT_L(0); PG8_MMA(0, 0, At, B0); PG8_BAR; PG8_SCHED;
            PG8_LDB(B1, 1, 1); PG8_STAGE(PG8_SB(1, 0), b3, voffB);
            PG8_BAR; PG8_WAIT_L(0); PG8_MMA(0, 1, At, B1); PG8_BAR;
            PG8_LDA(At, 1, 1); PG8_STAGE(PG8_SA(1, 0), a3, voffA);
            PG8_BAR; PG8_WAIT_L(0); PG8_MMA(1, 0, At, B0); PG8_BAR; PG8_SCHED;
            PG8_STAGE(PG8_SB(1, 1), b3 + hstepB, voffB);
            PG8_WAIT_V(6); PG8_BAR; PG8_MMA(1, 1, At, B1); PG8_BAR;
        }
        E(acc, cur, wr, wc, fr, fq);
        if (!has_next) break;
#pragma unroll
        for (int a = 0; a < 2; ++a)
#pragma unroll
            for (int b = 0; b < 2; ++b)
#pragma unroll
                for (int m = 0; m < 4; ++m)
#pragma unroll
                    for (int n = 0; n < 2; ++n) acc[a][b][m][n] = (f32x4){0.f, 0.f, 0.f, 0.f};
        cur = nxt; cA = nA; cB = nB; ++ui;
    }
    PG8_WAIT_V(0);
    if (wr == 0) PG8_BAR;
    PG8_BAR;
#undef PG8_SA
#undef PG8_SB
#undef PG8_STAGE
#undef PG8_LDA
#undef PG8_LDB
#undef PG8_MMA
#undef PG8_WAIT_V
#undef PG8_WAIT_L
#undef PG8_BAR
#undef PG8_SCHED
}
}

namespace att {
constexpr int D = 128, NW = 8, QBLK = 32, KVBLK = 64;
constexpr float SCALE = 0.088388347648318440f;
constexpr float THR = 8.f;
#ifndef ATT_SDEPTH
#define ATT_SDEPTH 1
#endif
constexpr int LDQ = INW, LDK = INW, LDO = INW / 2;
constexpr int SHM_V = KVBLK * D * 2, SHM_K = KVBLK * D * 2;
constexpr int OFF_WS = 2 * SHM_V + 2 * SHM_K, OFF_TAB = OFF_WS + NW * 64 * 4, SHM_ATTN = OFF_TAB + 768 * 4;
#define KSWZ(row, colB) ((row) * 256 + ((colB) ^ (((row) & 7) << 4)))
#define SBAR() __builtin_amdgcn_sched_barrier(0)
__device__ __forceinline__ int crow(int r, int hi) { return (r & 3) + 8 * (r >> 2) + 4 * hi; }

__device__ __forceinline__ void partialSM(f32x16& p0, f32x16& p1, float& m_reg, float& mn, float& alpha) {
  constexpr float C = SCALE * 1.4426950408889634f;
  float pmax = p0[0];
#pragma unroll
  for (int r = 1; r < 16; ++r) pmax = fmaxf(pmax, p0[r]);
#pragma unroll
  for (int r = 0; r < 16; ++r) pmax = fmaxf(pmax, p1[r]);
  { auto rr = __builtin_amdgcn_permlane32_swap(__float_as_uint(pmax), __float_as_uint(pmax), false, false);
    pmax = fmaxf(__uint_as_float(rr[0]), __uint_as_float(rr[1])); }
  if (__builtin_expect(__all(pmax - m_reg <= THR / SCALE), 1)) { mn = m_reg; alpha = 1.f; }
  else { mn = fmaxf(m_reg, pmax); alpha = __builtin_amdgcn_exp2f((m_reg - mn) * C); m_reg = mn; }
  float mnC = -mn * C;
#pragma unroll
  for (int r = 0; r < 16; ++r) p0[r] = fmaf(p0[r], C, mnC);
#pragma unroll
  for (int r = 0; r < 16; ++r) p1[r] = fmaf(p1[r], C, mnC);
#pragma unroll
  for (int r = 0; r < 16; ++r) p0[r] = __builtin_amdgcn_exp2f(p0[r]);
}
__device__ __forceinline__ void finishSM(f32x16& p0, f32x16& p1, float alpha, float& l_reg, bf16x8& pa0, bf16x8& pa1, bf16x8& pa2, bf16x8& pa3) {
#pragma unroll
  for (int r = 0; r < 16; ++r) p1[r] = __builtin_amdgcn_exp2f(p1[r]);
  float ps = 0;
#pragma unroll
  for (int r = 0; r < 16; ++r) ps += p0[r];
#pragma unroll
  for (int r = 0; r < 16; ++r) ps += p1[r];
  { auto rr = __builtin_amdgcn_permlane32_swap(__float_as_uint(ps), __float_as_uint(ps), false, false);
    ps = __uint_as_float(rr[0]) + __uint_as_float(rr[1]); }
  l_reg = l_reg * alpha + ps;
#define PK4(P, BASE, OUT) do { unsigned a0 = cvt_pk_bf16(P[BASE + 0], P[BASE + 1]), a1 = cvt_pk_bf16(P[BASE + 2], P[BASE + 3]);   \
    unsigned b0 = cvt_pk_bf16(P[BASE + 4], P[BASE + 5]), b1 = cvt_pk_bf16(P[BASE + 6], P[BASE + 7]);                              \
    auto r0 = __builtin_amdgcn_permlane32_swap(a0, b0, false, false); auto r1 = __builtin_amdgcn_permlane32_swap(a1, b1, false, false); \
    u32x4 w = {r0[0], r1[0], r0[1], r1[1]}; OUT = *reinterpret_cast<bf16x8*>(&w); } while (0)
  PK4(p0, 0, pa0); PK4(p0, 8, pa1); PK4(p1, 0, pa2); PK4(p1, 8, pa3);
#undef PK4
}
template <bool NEAR>
__device__ __forceinline__ void qkt(f32x16& p0, f32x16& p1, const bf16_t* Ks, const bf16x8 (&qr)[8], int r32, int hi, float cfar, const float* tabp) {
  if (!NEAR) {
#pragma unroll
    for (int r = 0; r < 16; ++r) { p0[r] = cfar; p1[r] = cfar; }
  } else {
#pragma unroll
    for (int r = 0; r < 16; ++r) { p0[r] = tabp[(r & 3) + 8 * (r >> 2)]; p1[r] = tabp[32 + (r & 3) + 8 * (r >> 2)]; }
  }
#pragma unroll
  for (int d0 = 0; d0 < 8; ++d0) { int cb = (d0 * 16 + hi * 8) * 2;
    bf16x8 b0 = *reinterpret_cast<const bf16x8*>((const char*)Ks + KSWZ(r32, cb));
    bf16x8 b1 = *reinterpret_cast<const bf16x8*>((const char*)Ks + KSWZ(32 + r32, cb));
    p0 = __builtin_amdgcn_mfma_f32_32x32x16_bf16(b0, qr[d0], p0, 0, 0, 0);
    p1 = __builtin_amdgcn_mfma_f32_32x32x16_bf16(b1, qr[d0], p1, 0, 0, 0); }
}
__device__ __forceinline__ int v_st(int k, int c) { const int kk = (k & ~0xC) | ((k & 4) << 1) | ((k & 8) >> 1); return ((kk >> 3) * 4 + (c >> 5)) * 512 + ((kk & 7) * 32 + (c & 31)) * 2; }
__device__ __forceinline__ int v_rd_base(int lane) { return ((lane & 3) << 3) | (((lane >> 2) & 3) << 6) | (((lane >> 4) & 1) << 5) | (((lane >> 5) & 1) << 8); }
constexpr int v_rd_off(int d0, int ks, int half) { return d0 * 512 + ks * 4096 + half * 2048; }
template <int OFF> __device__ __forceinline__ s16x4 tr_read(int vb) {
  s16x4 r; asm volatile("ds_read_b64_tr_b16 %0, %1 offset:%2" : "=&v"(r) : "v"(vb), "i"(OFF) : "memory"); return r;
}
template <int D0> __device__ __forceinline__ void pv_one(f32x16& od, int vb, bf16x8 pa0, bf16x8 pa1, bf16x8 pa2, bf16x8 pa3) {
  const s16x4 l0 = tr_read<v_rd_off(D0, 0, 0)>(vb), h0 = tr_read<v_rd_off(D0, 0, 1)>(vb), l1 = tr_read<v_rd_off(D0, 1, 0)>(vb), h1 = tr_read<v_rd_off(D0, 1, 1)>(vb);
  const s16x4 l2 = tr_read<v_rd_off(D0, 2, 0)>(vb), h2 = tr_read<v_rd_off(D0, 2, 1)>(vb), l3 = tr_read<v_rd_off(D0, 3, 0)>(vb), h3 = tr_read<v_rd_off(D0, 3, 1)>(vb);
  asm volatile("s_waitcnt lgkmcnt(0)" ::: "memory"); SBAR();
#define PK(L, H) (bf16x8){L[0], L[1], L[2], L[3], H[0], H[1], H[2], H[3]}
  od = __builtin_amdgcn_mfma_f32_32x32x16_bf16(pa0, PK(l0, h0), od, 0, 0, 0);
  od = __builtin_amdgcn_mfma_f32_32x32x16_bf16(pa1, PK(l1, h1), od, 0, 0, 0);
  od = __builtin_amdgcn_mfma_f32_32x32x16_bf16(pa2, PK(l2, h2), od, 0, 0, 0);
  od = __builtin_amdgcn_mfma_f32_32x32x16_bf16(pa3, PK(l3, h3), od, 0, 0, 0);
#undef PK
}
__device__ __forceinline__ void pv_d0(f32x16* o, int vb, bf16x8 pa0, bf16x8 pa1, bf16x8 pa2, bf16x8 pa3) {
  pv_one<0>(o[0], vb, pa0, pa1, pa2, pa3); pv_one<1>(o[1], vb, pa0, pa1, pa2, pa3); pv_one<2>(o[2], vb, pa0, pa1, pa2, pa3); pv_one<3>(o[3], vb, pa0, pa1, pa2, pa3);
}

template <int SDEPTH>
__device__ __forceinline__ void attn_range(const bf16_t* __restrict__ Kh, const bf16_t* __restrict__ Vh, int NT, float cfar, const bf16x8 (&qr)[8],
                                           float& m_reg, float& l_reg, f32x16 (&o)[4], char* lds, int tid, int wid, int r32, int hi) {
  bf16_t* V_lds = (bf16_t*)lds; bf16_t* K_lds = (bf16_t*)(lds + 2 * SHM_V);
  float* al_l = (float*)(lds + OFF_WS) + wid * 64 + 32;
  const int sr = tid >> 4, sc = (tid & 15) * 8, vst0 = v_st(sr, sc), vst1 = v_st(32 + sr, sc);
  const int vb0 = (int)(uintptr_t)V_lds + v_rd_base(tid & 63);
  struct { bf16x8 vs0, vs1, ks0, ks1; } sr_[SDEPTH];
#define SLOAD(i, k0) do { sr_[i].vs0 = *reinterpret_cast<const bf16x8*>(&Vh[(long)((k0) + sr) * LDK + sc]); sr_[i].vs1 = *reinterpret_cast<const bf16x8*>(&Vh[(long)((k0) + 32 + sr) * LDK + sc]); \
    sr_[i].ks0 = *reinterpret_cast<const bf16x8*>(&Kh[(long)((k0) + sr) * LDK + sc]); sr_[i].ks1 = *reinterpret_cast<const bf16x8*>(&Kh[(long)((k0) + 32 + sr) * LDK + sc]); } while (0)
#define SWRITE(b, i) do { *(bf16x8*)((char*)V_lds + (b) * SHM_V + vst0) = sr_[i].vs0;          \
    *(bf16x8*)((char*)V_lds + (b) * SHM_V + vst1) = sr_[i].vs1; int kc = sc * 2;               \
    *(bf16x8*)((char*)K_lds + (b) * SHM_K + KSWZ(sr, kc)) = sr_[i].ks0;                       \
    *(bf16x8*)((char*)K_lds + (b) * SHM_K + KSWZ(32 + sr, kc)) = sr_[i].ks1; } while (0)
#define SWAIT() do { if constexpr (SDEPTH == 2) asm volatile("s_waitcnt vmcnt(4)" ::: "memory"); else asm volatile("s_waitcnt vmcnt(0)" ::: "memory"); } while (0)
#define RESC(a) do { if (__any((a) < 1.f)) { if (hi == 0) al_l[r32] = (a); asm volatile("s_waitcnt lgkmcnt(0)" ::: "memory"); \
    _Pragma("unroll") for (int d = 0; d < 4; ++d) _Pragma("unroll") for (int r = 0; r < 16; ++r) o[d][r] *= al_l[crow(r, hi)]; } } while (0)
#define QKT(P0, P1, KB, jj) qkt<false>(P0, P1, KB, qr, r32, hi, cfar, nullptr)
  f32x16 pA0, pA1, pB0, pB1; float mnA, mnB, alA, alB; bf16x8 pa0, pa1, pa2, pa3;
  constexpr int SE = 0, SO = SDEPTH - 1;
  SLOAD(SE, 0); asm volatile("s_waitcnt vmcnt(0)" ::: "memory"); SWRITE(0, SE); __syncthreads();
  QKT(pA0, pA1, K_lds, 0); partialSM(pA0, pA1, m_reg, mnA, alA);
  SLOAD(SO, KVBLK); if constexpr (SDEPTH == 2) { if (2 < NT) SLOAD(SE, 2 * KVBLK); }
  SWAIT(); SWRITE(1, SO); __syncthreads();
  RESC(alA);
  for (int j = 1; j + 1 < NT; j += 2) {
    SBAR(); QKT(pB0, pB1, (bf16_t*)((char*)K_lds + SHM_K), j);
    finishSM(pA0, pA1, alA, l_reg, pa0, pa1, pa2, pa3); SBAR();
    SLOAD(SO, (j + SDEPTH) * KVBLK); SBAR();
    pv_d0(o, vb0, pa0, pa1, pa2, pa3); partialSM(pB0, pB1, m_reg, mnB, alB);
    __syncthreads(); SWAIT(); SWRITE(0, SE);
    RESC(alB); __syncthreads();
    SBAR(); QKT(pA0, pA1, K_lds, j + 1);
    finishSM(pB0, pB1, alB, l_reg, pa0, pa1, pa2, pa3); SBAR();
    if (SDEPTH == 1 || j + 3 < NT) SLOAD(SE, (j + 1 + SDEPTH) * KVBLK); SBAR();
    pv_d0(o, vb0 + (int)SHM_V, pa0, pa1, pa2, pa3); partialSM(pA0, pA1, m_reg, mnA, alA);
    __syncthreads(); SWAIT(); SWRITE(1, SO);
    RESC(alA); __syncthreads();
  }
  SBAR(); QKT(pB0, pB1, (bf16_t*)((char*)K_lds + SHM_K), NT - 1);
  finishSM(pA0, pA1, alA, l_reg, pa0, pa1, pa2, pa3); SBAR();
  pv_d0(o, vb0, pa0, pa1, pa2, pa3); partialSM(pB0, pB1, m_reg, mnB, alB);
  __syncthreads(); RESC(alB);
  finishSM(pB0, pB1, alB, l_reg, pa0, pa1, pa2, pa3); SBAR();
  pv_d0(o, vb0 + (int)SHM_V, pa0, pa1, pa2, pa3);
#undef SLOAD
#undef SWRITE
#undef SWAIT
#undef RESC
#undef QKT
}

__device__ __forceinline__ void attn_near(const bf16_t* __restrict__ Kh, const bf16_t* __restrict__ Vh, int NT, const float* tabl, const bf16x8 (&qr)[8],
                                          float& m_reg, float& l_reg, f32x16 (&o)[4], char* lds, int tid, int wid, int r32, int hi) {
  bf16_t* V_lds = (bf16_t*)lds; bf16_t* K_lds = (bf16_t*)(lds + 2 * SHM_V);
  float* al_l = (float*)(lds + OFF_WS) + wid * 64 + 32;
  const int sr = tid >> 4, sc = (tid & 15) * 8, vst0 = v_st(sr, sc), vst1 = v_st(32 + sr, sc);
  const int vb0 = (int)(uintptr_t)V_lds + v_rd_base(tid & 63);
#pragma unroll 1
  for (int j = 0; j < NT; ++j) {
    const long k0 = (long)j * KVBLK;
    const bf16x8 vs0 = *reinterpret_cast<const bf16x8*>(&Vh[(k0 + sr) * LDK + sc]), vs1 = *reinterpret_cast<const bf16x8*>(&Vh[(k0 + 32 + sr) * LDK + sc]);
    const bf16x8 ks0 = *reinterpret_cast<const bf16x8*>(&Kh[(k0 + sr) * LDK + sc]), ks1 = *reinterpret_cast<const bf16x8*>(&Kh[(k0 + 32 + sr) * LDK + sc]);
    __syncthreads();
    *(bf16x8*)((char*)V_lds + vst0) = vs0; *(bf16x8*)((char*)V_lds + vst1) = vs1;
    *(bf16x8*)((char*)K_lds + KSWZ(sr, sc * 2)) = ks0; *(bf16x8*)((char*)K_lds + KSWZ(32 + sr, sc * 2)) = ks1;
    __syncthreads();
    f32x16 p0, p1; float mn, al; bf16x8 pa0, pa1, pa2, pa3;
    qkt<true>(p0, p1, K_lds, qr, r32, hi, 0.f, tabl + j * KVBLK);
    partialSM(p0, p1, m_reg, mn, al);
    if (__any(al < 1.f)) { if (hi == 0) al_l[r32] = al; asm volatile("s_waitcnt lgkmcnt(0)" ::: "memory");
#pragma unroll
      for (int d = 0; d < 4; ++d)
#pragma unroll
        for (int r = 0; r < 16; ++r) o[d][r] *= al_l[crow(r, hi)]; }
    finishSM(p0, p1, al, l_reg, pa0, pa1, pa2, pa3); SBAR();
    pv_d0(o, vb0, pa0, pa1, pa2, pa3);
  }
  __syncthreads();
}

__device__ __forceinline__ void attn_body(const bf16_t* __restrict__ Qb, const bf16_t* __restrict__ Kh, const bf16_t* __restrict__ Vh, float* Ob, int seq, int q0, float lam, bool SUBTRACT, char* lds) {
  int tid = threadIdx.x; asm volatile("" : "+v"(tid));
  const int wid = __builtin_amdgcn_readfirstlane(tid >> 6), lane = tid & 63, r32 = lane & 31, hi = lane >> 5;
  float* li_l = (float*)(lds + OFF_WS) + wid * 64;
  const float* tab = (const float*)(lds + OFF_TAB);
  const int NT = seq / KVBLK;
  int jn0 = q0 / KVBLK - 2, jn1 = q0 / KVBLK + 6; jn0 = jn0 < 0 ? 0 : jn0; jn1 = jn1 > NT ? NT : jn1;
  float m_reg = -1e30f, l_reg = 0; f32x16 o[4] = {}; bf16x8 qr[8];
  const bf16_t* Qw = Qb + (long)(wid * QBLK + r32) * LDQ + hi * 8;
#pragma unroll
  for (int d0 = 0; d0 < 8; ++d0) qr[d0] = *reinterpret_cast<const bf16x8*>(Qw + d0 * 16);
  { const float* tabl = tab + (384 + 4 * hi - (q0 + wid * QBLK + r32 - jn0 * KVBLK));
    attn_near(Kh + (long)jn0 * KVBLK * LDK, Vh + (long)jn0 * KVBLK * LDK, jn1 - jn0, tabl, qr, m_reg, l_reg, o, lds, tid, wid, r32, hi); }
#pragma unroll 1
  for (int rg = 0; rg < 2; ++rg) {
    int rr = rg; asm volatile("" : "+s"(rr));
    const int ja = rr ? jn1 : 0, nt = rr ? NT - jn1 : jn0;
    const float cfar = __uint_as_float(__builtin_amdgcn_readfirstlane(__float_as_uint(tab[rr ? 767 : 0])));
    if (nt > 0) attn_range<ATT_SDEPTH>(Kh + (long)ja * KVBLK * LDK, Vh + (long)ja * KVBLK * LDK, nt, cfar, qr, m_reg, l_reg, o, lds, tid, wid, r32, hi);
  }
  if (hi == 0) li_l[r32] = l_reg; asm volatile("s_waitcnt lgkmcnt(0)" ::: "memory");
  float rli[16];
#pragma unroll
  for (int r = 0; r < 16; ++r) rli[r] = __builtin_amdgcn_rcpf(li_l[crow(r, hi)]);
  int r32e = r32, hie = hi; asm volatile("" : "+v"(r32e), "+v"(hie));
  float* Ow = Ob + (long)(wid * QBLK) * LDO + (4 * hie) * LDO + r32e;
  if (SUBTRACT) {
#pragma unroll
    for (int r = 0; r < 16; ++r) {
#pragma unroll
      for (int d0 = 0; d0 < 4; ++d0) { float* op = Ow + ((r & 3) + 8 * (r >> 2)) * LDO + d0 * 32; *op = *op - lam * (o[d0][r] * rli[r]); }
      asm volatile("" ::: "memory"); }
  } else {
#pragma unroll
    for (int r = 0; r < 16; ++r) {
#pragma unroll
      for (int d0 = 0; d0 < 4; ++d0) Ow[((r & 3) + 8 * (r >> 2)) * LDO + d0 * 32] = o[d0][r] * rli[r]; }
  }
  asm volatile("s_waitcnt vmcnt(0)" ::: "memory");
  __syncthreads();
}
}

namespace att2 {
using att::crow; using att::partialSM; using att::finishSM; using att::KVBLK; using att::QBLK; using att::LDQ; using att::LDK; using att::LDO;
constexpr int KBUF = 16384, VBUF = 32768, OFF_K = 0, OFF_V = 2 * KBUF, OFF_WS = OFF_V + 3 * VBUF, OFF_TAB = OFF_WS + 2048, SHM = OFF_TAB + 768 * 4;
#define A2_WAIT_V(n) asm volatile("s_waitcnt vmcnt(" #n ")" ::: "memory")
#define A2_BAR() do { asm volatile("" ::: "memory"); __builtin_amdgcn_s_barrier(); asm volatile("" ::: "memory"); } while (0)
template <int OFF> __device__ __forceinline__ s16x4 tr_read(int vb) {
  s16x4 r; asm volatile("ds_read_b64_tr_b16 %0, %1 offset:%2" : "=&v"(r) : "v"(vb), "i"(OFF) : "memory"); return r;
}
constexpr int v_off(int d0, int ks, int half) { return (d0 >> 2) * 16384 + (d0 & 3) * 512 + ks * 4096 + half * 2048; }
struct VFrag { s16x4 l0, h0, l1, h1; };
template <int D0, int SUB> __device__ __forceinline__ void v_read(VFrag& f, int vb) {
  f.l0 = tr_read<v_off(D0, 2 * SUB, 0)>(vb); f.h0 = tr_read<v_off(D0, 2 * SUB, 1)>(vb); f.l1 = tr_read<v_off(D0, 2 * SUB + 1, 0)>(vb); f.h1 = tr_read<v_off(D0, 2 * SUB + 1, 1)>(vb);
}
__device__ __forceinline__ void v_mma(f32x16& od, const VFrag& f, bf16x8 pa0, bf16x8 pa1) {
#define PK(L, H) (bf16x8){L[0], L[1], L[2], L[3], H[0], H[1], H[2], H[3]}
  od = __builtin_amdgcn_mfma_f32_32x32x16_bf16(pa0, PK(f.l0, f.h0), od, 0, 0, 0);
  od = __builtin_amdgcn_mfma_f32_32x32x16_bf16(pa1, PK(f.l1, f.h1), od, 0, 0, 0);
#undef PK
}
#define A2_LWAIT(n) do { asm volatile("s_waitcnt lgkmcnt(" #n ")" ::: "memory"); __builtin_amdgcn_sched_barrier(0); } while (0)
template <int SUB> __device__ __forceinline__ void pv_all(f32x16 (&o)[8], int vb, bf16x8 pa0, bf16x8 pa1, VFrag& fa) {
  VFrag fb;
  __builtin_amdgcn_s_setprio(1);
  v_read<1, SUB>(fb, vb); A2_LWAIT(4); v_mma(o[0], fa, pa0, pa1); __builtin_amdgcn_sched_barrier(0);
  v_read<2, SUB>(fa, vb); A2_LWAIT(4); v_mma(o[1], fb, pa0, pa1); __builtin_amdgcn_sched_barrier(0);
  v_read<3, SUB>(fb, vb); A2_LWAIT(4); v_mma(o[2], fa, pa0, pa1); __builtin_amdgcn_sched_barrier(0);
  v_read<4, SUB>(fa, vb); A2_LWAIT(4); v_mma(o[3], fb, pa0, pa1); __builtin_amdgcn_sched_barrier(0);
  v_read<5, SUB>(fb, vb); A2_LWAIT(4); v_mma(o[4], fa, pa0, pa1); __builtin_amdgcn_sched_barrier(0);
  v_read<6, SUB>(fa, vb); A2_LWAIT(4); v_mma(o[5], fb, pa0, pa1); __builtin_amdgcn_sched_barrier(0);
  v_read<7, SUB>(fb, vb); A2_LWAIT(4); v_mma(o[6], fa, pa0, pa1); __builtin_amdgcn_sched_barrier(0);
  A2_LWAIT(0); v_mma(o[7], fb, pa0, pa1);
  __builtin_amdgcn_s_setprio(0);
}
struct Ctx { LAS unsigned char* lds; unsigned voffK, voffV; int wid, r32, hi, vb0; LAS float* al_l; };
__device__ __forceinline__ void issueK(const Ctx& c, int buf, const char* g) {
#pragma unroll
  for (int i = 0; i < 2; ++i) __builtin_amdgcn_global_load_lds((const unsigned*)(g + (size_t)i * (32 * LDK * 2) + c.voffK), (LAS unsigned*)(c.lds + OFF_K + buf * KBUF + c.wid * 1024 + i * 8192), 16, 0, 0);
}
__device__ __forceinline__ void issueV(const Ctx& c, int buf, const char* g) {
#pragma unroll
  for (int i = 0; i < 4; ++i) __builtin_amdgcn_global_load_lds((const unsigned*)(g + (size_t)(i & 1) * (32 * LDK * 2) + (i >> 1) * 256 + c.voffV), (LAS unsigned*)(c.lds + OFF_V + buf * VBUF + c.wid * 1024 + i * 8192), 16, 0, 0);
}
template <bool NEAR, int SUB, int DMA = 0>
__device__ __forceinline__ void qk_sm(const Ctx& c, const LAS unsigned char* Ks, const bf16x8 (&qr)[8], float cfar, const LAS float* tabp, float& m_reg, float& l_reg, f32x16 (&o)[8], bf16x8& pa0, bf16x8& pa1,
                                      VFrag& fa, int vbp, int dbuf = 0, const char* dsrc = nullptr, int dbuf2 = 0, const char* dsrc2 = nullptr) {
  constexpr float C = att::SCALE * 1.4426950408889634f;
  f32x16 p;
  if (!NEAR) {
#pragma unroll
    for (int r = 0; r < 16; ++r) p[r] = 0.f;
  } else {
#pragma unroll
    for (int r = 0; r < 16; ++r) p[r] = tabp[32 * SUB + (r & 3) + 8 * (r >> 2)];
  }
  { const int kb = (int)(unsigned)(uintptr_t)Ks + c.r32 * 256 + ((c.hi << 4) ^ ((c.r32 & 7) << 4));
    bf16x8 ka, kbf, kc;
#define K_RD(dst, d0) asm volatile("ds_read_b128 %0, %1 offset:%2" : "=&v"(dst) : "v"(kb ^ ((d0) << 5)), "i"(SUB * 8192) : "memory")
    __builtin_amdgcn_s_setprio(1);
    K_RD(ka, 0); K_RD(kbf, 1); K_RD(kc, 2);
    A2_LWAIT(2); p = __builtin_amdgcn_mfma_f32_32x32x16_bf16(ka, qr[0], p, 0, 0, 0); __builtin_amdgcn_sched_barrier(0); K_RD(ka, 3);
    A2_LWAIT(2); p = __builtin_amdgcn_mfma_f32_32x32x16_bf16(kbf, qr[1], p, 0, 0, 0); __builtin_amdgcn_sched_barrier(0); K_RD(kbf, 4);
    A2_LWAIT(2); p = __builtin_amdgcn_mfma_f32_32x32x16_bf16(kc, qr[2], p, 0, 0, 0); __builtin_amdgcn_sched_barrier(0); K_RD(kc, 5);
    A2_LWAIT(2); p = __builtin_amdgcn_mfma_f32_32x32x16_bf16(ka, qr[3], p, 0, 0, 0); __builtin_amdgcn_sched_barrier(0); K_RD(ka, 6);
    A2_LWAIT(2); p = __builtin_amdgcn_mfma_f32_32x32x16_bf16(kbf, qr[4], p, 0, 0, 0); __builtin_amdgcn_sched_barrier(0); K_RD(kbf, 7);
    A2_LWAIT(2); p = __builtin_amdgcn_mfma_f32_32x32x16_bf16(kc, qr[5], p, 0, 0, 0); __builtin_amdgcn_sched_barrier(0);
    A2_LWAIT(1); p = __builtin_amdgcn_mfma_f32_32x32x16_bf16(ka, qr[6], p, 0, 0, 0); __builtin_amdgcn_sched_barrier(0);
    A2_LWAIT(0); p = __builtin_amdgcn_mfma_f32_32x32x16_bf16(kbf, qr[7], p, 0, 0, 0);
    __builtin_amdgcn_s_setprio(0);
#undef K_RD
  }
  if (DMA == 1) { __builtin_amdgcn_sched_barrier(0); issueK(c, dbuf, dsrc); __builtin_amdgcn_sched_barrier(0); }
  if (DMA == 3) { __builtin_amdgcn_sched_barrier(0); issueK(c, dbuf, dsrc); issueV(c, dbuf2, dsrc2); __builtin_amdgcn_sched_barrier(0); }
  if (DMA == 2) { __builtin_amdgcn_sched_barrier(0); issueV(c, dbuf, dsrc); __builtin_amdgcn_sched_barrier(0); }
  v_read<0, SUB>(fa, vbp);
  float pmax = p[0];
#pragma unroll
  for (int r = 1; r < 16; ++r) pmax = fmaxf(pmax, p[r]);
  { auto rr = __builtin_amdgcn_permlane32_swap(__float_as_uint(pmax), __float_as_uint(pmax), false, false);
    pmax = fmaxf(__uint_as_float(rr[0]), __uint_as_float(rr[1])); }
  if (!NEAR) pmax += cfar;
  float mn, alpha;
  if (__builtin_expect(__all(pmax - m_reg <= att::THR / att::SCALE), 1)) { mn = m_reg; alpha = 1.f; }
  else { mn = fmaxf(m_reg, pmax); alpha = __builtin_amdgcn_exp2f((m_reg - mn) * C); m_reg = mn;
    if (__any(alpha < 1.f)) { if (c.hi == 0) c.al_l[c.r32] = alpha; asm volatile("s_waitcnt lgkmcnt(0)" ::: "memory");
#pragma unroll
      for (int d = 0; d < 8; ++d)
#pragma unroll
        for (int r = 0; r < 16; ++r) o[d][r] *= c.al_l[crow(r, c.hi)]; } }
  const float mnC = NEAR ? -mn * C : (cfar - mn) * C;
  float ps = 0.f;
#pragma unroll
  for (int r = 0; r < 16; ++r) { p[r] = __builtin_amdgcn_exp2f(fmaf(p[r], C, mnC)); ps += p[r]; }
  { auto rr = __builtin_amdgcn_permlane32_swap(__float_as_uint(ps), __float_as_uint(ps), false, false);
    ps = __uint_as_float(rr[0]) + __uint_as_float(rr[1]); }
  l_reg = l_reg * alpha + ps;
#define PK4(P, BASE, OUT) do { unsigned a0 = cvt_pk_bf16(P[BASE + 0], P[BASE + 1]), a1 = cvt_pk_bf16(P[BASE + 2], P[BASE + 3]);   \
    unsigned b0 = cvt_pk_bf16(P[BASE + 4], P[BASE + 5]), b1 = cvt_pk_bf16(P[BASE + 6], P[BASE + 7]);                              \
    auto r0 = __builtin_amdgcn_permlane32_swap(a0, b0, false, false); auto r1 = __builtin_amdgcn_permlane32_swap(a1, b1, false, false); \
    u32x4 w = {r0[0], r1[0], r0[1], r1[1]}; OUT = *reinterpret_cast<bf16x8*>(&w); } while (0)
  PK4(p, 0, pa0); PK4(p, 8, pa1);
#undef PK4
}
template <bool NEAR, int SUB>
__device__ __forceinline__ void sub_tile(const Ctx& c, const LAS unsigned char* Ks, int vb, const bf16x8 (&qr)[8], float cfar, const LAS float* tabp, float& m_reg, float& l_reg, f32x16 (&o)[8]) {
  bf16x8 pa0, pa1; VFrag fa;
  qk_sm<NEAR, SUB>(c, Ks, qr, cfar, tabp, m_reg, l_reg, o, pa0, pa1, fa, vb);
  __builtin_amdgcn_sched_barrier(0);
  pv_all<SUB>(o, vb, pa0, pa1, fa);
}
__device__ __forceinline__ void far_run(const Ctx& c, const char* gK, const char* gV, int NT, float cfar, const bf16x8 (&qr)[8], float& m_reg, float& l_reg, f32x16 (&o)[8]) {
  constexpr size_t TSTEP = (size_t)KVBLK * LDK * 2;
  const bool roleB = c.wid >= 4;
  issueV(c, 0, gV); issueK(c, 0, gK);
  bf16x8 pa0, pa1; VFrag fa;
  int vcur = 0, vprev = 0;
#pragma unroll 1
  for (int t = 0; t < NT; ++t) {
    const int t1 = (t + 1 < NT) ? t + 1 : NT - 1;
    const int vnext = vcur == 2 ? 0 : vcur + 1;
    const LAS unsigned char* Ks = c.lds + OFF_K + (t & 1) * KBUF;
    const int vbc = c.vb0 + vcur * VBUF;
    A2_WAIT_V(0); A2_BAR();
    if (roleB && t > 0) pv_all<1>(o, c.vb0 + vprev * VBUF, pa0, pa1, fa);
    qk_sm<false, 0, 3>(c, Ks, qr, cfar, nullptr, m_reg, l_reg, o, pa0, pa1, fa, vbc, (t + 1) & 1, gK + (size_t)t1 * TSTEP, vnext, gV + (size_t)t1 * TSTEP);
    __builtin_amdgcn_sched_barrier(0);
    pv_all<0>(o, vbc, pa0, pa1, fa);
    qk_sm<false, 1, 0>(c, Ks, qr, cfar, nullptr, m_reg, l_reg, o, pa0, pa1, fa, vbc);
    __builtin_amdgcn_sched_barrier(0);
    if (!roleB) pv_all<1>(o, vbc, pa0, pa1, fa);
    vprev = vcur; vcur = vnext;
  }
  if (roleB) pv_all<1>(o, c.vb0 + vprev * VBUF, pa0, pa1, fa);
  A2_WAIT_V(0); A2_BAR();
}
__device__ __forceinline__ void near_run(const Ctx& c, const char* gK, const char* gV, int NT, const LAS float* tabl, const bf16x8 (&qr)[8], float& m_reg, float& l_reg, f32x16 (&o)[8]) {
  constexpr size_t TSTEP = (size_t)KVBLK * LDK * 2;
  issueK(c, 0, gK); issueV(c, 0, gV);
#pragma unroll 1
  for (int j = 0; j < NT; ++j) {
    const int jn = (j + 1 < NT) ? j + 1 : NT - 1, b = j & 1;
    A2_WAIT_V(0); A2_BAR();
    issueK(c, b ^ 1, gK + (size_t)jn * TSTEP); issueV(c, b ^ 1, gV + (size_t)jn * TSTEP);
    sub_tile<true, 0>(c, c.lds + OFF_K + b * KBUF, c.vb0 + b * VBUF, qr, 0.f, tabl + j * KVBLK, m_reg, l_reg, o);
    sub_tile<true, 1>(c, c.lds + OFF_K + b * KBUF, c.vb0 + b * VBUF, qr, 0.f, tabl + j * KVBLK, m_reg, l_reg, o);
  }
  A2_WAIT_V(0); A2_BAR();
}
__device__ __forceinline__ void attn_body(const bf16_t* __restrict__ Qb, const bf16_t* __restrict__ Kh, const bf16_t* __restrict__ Vh, bf16_t* Ob, int seq, int q0, float lam, bool SUBTRACT, LAS unsigned char* lds,
                                          bf16_t* Dst, const float* __restrict__ sub_norm, const float* __restrict__ q_gain) {
  int tid = threadIdx.x; asm volatile("" : "+v"(tid));
  const int wid = __builtin_amdgcn_readfirstlane(tid >> 6), lane = tid & 63, r32 = lane & 31, hi = lane >> 5;
  Ctx c; c.lds = lds; c.wid = wid; c.r32 = r32; c.hi = hi;
  c.vb0 = (int)(unsigned)(uintptr_t)(lds + OFF_V) + att::v_rd_base(lane);
  c.al_l = (LAS float*)(lds + OFF_WS) + wid * 64 + 32;
  LAS float* li_l = (LAS float*)(lds + OFF_WS) + wid * 64;
  const LAS float* tab = (const LAS float*)(lds + OFF_TAB);
  { const int P = wid * 1024 + lane * 16, row = P >> 8, cb = (P & 255) ^ ((row & 7) << 4); c.voffK = (unsigned)(row * LDK * 2 + cb); }
  { const int P = wid * 1024 + lane * 16, sub = P >> 9, w = P & 511;
    const int kk = (sub >> 2) * 8 + (w >> 6), k = (kk & ~0xC) | ((kk & 4) << 1) | ((kk & 8) >> 1), col = (sub & 3) * 32 + ((w & 63) >> 1);
    c.voffV = (unsigned)(k * LDK * 2 + col * 2); }
  const int NT = seq / KVBLK;
  int jn0 = q0 / KVBLK - 2, jn1 = q0 / KVBLK + 6; jn0 = jn0 < 0 ? 0 : jn0; jn1 = jn1 > NT ? NT : jn1;
  float m_reg = -1e30f, l_reg = 0; f32x16 o[8] = {}; bf16x8 qr[8];
  const bf16_t* Qw = Qb + (long)(wid * QBLK + r32) * LDQ + hi * 8;
#pragma unroll
  for (int d0 = 0; d0 < 8; ++d0) qr[d0] = *reinterpret_cast<const bf16x8*>(Qw + d0 * 16);
  {
    float f[8][8]; float ss = 0.f;
#pragma unroll
    for (int d0 = 0; d0 < 8; ++d0) { unpack8(*reinterpret_cast<const u32x4*>(&qr[d0]), f[d0]);
#pragma unroll
      for (int e = 0; e < 8; ++e) ss += f[d0][e] * f[d0][e]; }
    { auto rr = __builtin_amdgcn_permlane32_swap(__float_as_uint(ss), __float_as_uint(ss), false, false); ss = __uint_as_float(rr[0]) + __uint_as_float(rr[1]); }
    const float rstd = rsqrtf(ss * (1.0f / 128.0f) + EPS);
#pragma unroll
    for (int d0 = 0; d0 < 8; ++d0) { const f32x4 g0 = *(const f32x4*)(q_gain + d0 * 16 + hi * 8), g1 = *(const f32x4*)(q_gain + d0 * 16 + hi * 8 + 4);
      u32x4 w; w.x = cvt_pk_bf16(f[d0][0] * rstd * g0[0], f[d0][1] * rstd * g0[1]); w.y = cvt_pk_bf16(f[d0][2] * rstd * g0[2], f[d0][3] * rstd * g0[3]);
      w.z = cvt_pk_bf16(f[d0][4] * rstd * g1[0], f[d0][5] * rstd * g1[1]); w.w = cvt_pk_bf16(f[d0][6] * rstd * g1[2], f[d0][7] * rstd * g1[3]);
      qr[d0] = *reinterpret_cast<bf16x8*>(&w); }
  }
  constexpr size_t TSTEP = (size_t)KVBLK * LDK * 2;
  { const LAS float* tabl = tab + (384 + 4 * hi - (q0 + wid * QBLK + r32 - jn0 * KVBLK));
    near_run(c, (const char*)Kh + (size_t)jn0 * TSTEP, (const char*)Vh + (size_t)jn0 * TSTEP, jn1 - jn0, tabl, qr, m_reg, l_reg, o); }
#pragma unroll 1
  for (int rg = 0; rg < 2; ++rg) {
    int rr = rg; asm volatile("" : "+s"(rr));
    const int ja = rr ? jn1 : 0, nt = rr ? NT - jn1 : jn0;
    const float cfar = __uint_as_float(__builtin_amdgcn_readfirstlane(__float_as_uint(tab[rr ? 767 : 0])));
    if (nt > 0) far_run(c, (const char*)Kh + (size_t)ja * TSTEP, (const char*)Vh + (size_t)ja * TSTEP, nt, cfar, qr, m_reg, l_reg, o);
  }
  if (hi == 0) li_l[r32] = l_reg; asm volatile("s_waitcnt lgkmcnt(0)" ::: "memory");
  float rli[16];
#pragma unroll
  for (int r = 0; r < 16; ++r) rli[r] = __builtin_amdgcn_rcpf(li_l[crow(r, hi)]);
  int r32e = r32, hie = hi; asm volatile("" : "+v"(r32e), "+v"(hie));
  bf16_t* Ow = Ob + (long)(wid * QBLK) * LDQ + (4 * hie) * LDQ + r32e;
  if (SUBTRACT) {
    float g[8];
#pragma unroll
    for (int d0 = 0; d0 < 8; ++d0) g[d0] = sub_norm[d0 * 32 + r32e] * 0.8f;
    bf16_t* Dw = Dst + (long)(wid * QBLK + 4 * hie) * LDQ + r32e;
#pragma unroll
    for (int r = 0; r < 16; ++r) { float v[8]; float ss = 0.f;
#pragma unroll
      for (int d0 = 0; d0 < 8; ++d0) { v[d0] = __uint_as_float((unsigned)Ow[((r & 3) + 8 * (r >> 2)) * LDQ + d0 * 32] << 16) - lam * (o[d0][r] * rli[r]); ss += v[d0] * v[d0]; }
      ss += __shfl_xor(ss, 1); ss += __shfl_xor(ss, 2); ss += __shfl_xor(ss, 4); ss += __shfl_xor(ss, 8); ss += __shfl_xor(ss, 16);
      const float rs = rsqrtf(ss * (1.0f / 256.0f) + EPS);
#pragma unroll
      for (int d0 = 0; d0 < 8; ++d0) { const float w = v[d0] * rs * g[d0]; Dw[((r & 3) + 8 * (r >> 2)) * LDQ + d0 * 32] = (bf16_t)(cvt_pk_bf16(w, w) & 0xffffu); }
      asm volatile("" ::: "memory"); }
  } else {
#pragma unroll
    for (int r = 0; r < 16; ++r) {
#pragma unroll
      for (int d0 = 0; d0 < 8; ++d0) { const float w = o[d0][r] * rli[r]; Ow[((r & 3) + 8 * (r >> 2)) * LDQ + d0 * 32] = (bf16_t)(cvt_pk_bf16(w, w) & 0xffffu); } }
  }
  asm volatile("s_waitcnt vmcnt(0)" ::: "memory");
  __syncthreads();
}
}

__device__ void transpose_cvt(unsigned char* lds, const float* __restrict__ src, bf16_t* __restrict__ dst, int K, int N, int mode, int which, const float* __restrict__ gain = nullptr, int srcld = 0) {
    bf16_t* tile = (bf16_t*)lds;
    const int t = threadIdx.x, ntn = N / 64, ntiles = (K / 64) * ntn; if (srcld == 0) srcld = N;
    for (int tl = blockIdx.x; tl < ntiles; tl += gridDim.x) {
        const int tk = tl / ntn, tn = tl % ntn;
        const int kk = t >> 4, n4 = (t & 15) * 4;
#pragma unroll
        for (int i = 0; i < 2; ++i) { const int k = kk + 32 * i;
            f32x4 v = *(const f32x4*)(src + (size_t)(tk * 64 + k) * srcld + tn * 64 + n4);
            if (gain) v = v * gain[tk * 64 + k];
            const unsigned w0 = cvt_pk_bf16(v[0], v[1]), w1 = cvt_pk_bf16(v[2], v[3]);
            tile[(n4 + 0) * 72 + k] = (bf16_t)(w0 & 0xffff); tile[(n4 + 1) * 72 + k] = (bf16_t)(w0 >> 16);
            tile[(n4 + 2) * 72 + k] = (bf16_t)(w1 & 0xffff); tile[(n4 + 3) * 72 + k] = (bf16_t)(w1 >> 16); }
        __syncthreads();
        { const int n = t >> 3, k8 = (t & 7) * 8; const u32x4 v = *(const u32x4*)(tile + n * 72 + k8);
          const int gn = tn * 64 + n; const int drow = mode ? (gn >> 7) * 256 + which * 128 + (gn & 127) : gn;
          *(u32x4*)(dst + (size_t)drow * K + tk * 64 + k8) = v; }
        __syncthreads();
    }
}
__device__ void rmsnorm_rows(const float* __restrict__ src, const float* __restrict__ gain, bf16_t* __restrict__ dst) {
    const int lane = threadIdx.x & 63, gw = blockIdx.x * 8 + (threadIdx.x >> 6), nw = gridDim.x * 8;
    for (int row = gw; row < T; row += nw) {
        const f32x4* p = (const f32x4*)(src + (size_t)row * DM);
        f32x4 v[8]; float ss = 0.f;
#pragma unroll
        for (int j = 0; j < 8; ++j) { v[j] = p[lane + 64 * j]; ss += v[j][0] * v[j][0] + v[j][1] * v[j][1] + v[j][2] * v[j][2] + v[j][3] * v[j][3]; }
        ss = wave_sum(ss);
        const float rstd = rsqrtf(ss * (1.0f / DM) + EPS);
#pragma unroll
        for (int j = 0; j < 8; ++j) { const f32x4 g = ((const f32x4*)gain)[lane + 64 * j];
            u32x2 w; w.x = cvt_pk_bf16(v[j][0] * rstd * g[0], v[j][1] * rstd * g[1]); w.y = cvt_pk_bf16(v[j][2] * rstd * g[2], v[j][3] * rstd * g[3]);
            *(u32x2*)(dst + (size_t)row * DM + (lane + 64 * j) * 4) = w; }
    }
}
__device__ void cvt_rows(const float* __restrict__ src, bf16_t* __restrict__ dst, size_t n8) {
    for (size_t i = (size_t)blockIdx.x * 512 + threadIdx.x; i < n8; i += (size_t)gridDim.x * 512) {
        const f32x4 a = *(const f32x4*)(src + i * 8), b = *(const f32x4*)(src + i * 8 + 4);
        u32x4 w; w.x = cvt_pk_bf16(a[0], a[1]); w.y = cvt_pk_bf16(a[2], a[3]); w.z = cvt_pk_bf16(b[0], b[1]); w.w = cvt_pk_bf16(b[2], b[3]);
        *(u32x4*)(dst + i * 8) = w; }
}
__device__ void conv_pass(bf16_t* proj, const float* __restrict__ conv_w) {
    const int lane = threadIdx.x & 63, gw = blockIdx.x * 8 + (threadIdx.x >> 6), nw = gridDim.x * 8;
    for (int it = gw; it < (T / 16) * 2; it += nw) {
        const int t0 = (it >> 1) * 16, ch = (it & 1) * 512 + lane * 8;
        float w0[8], w1[8], w2[8];
#pragma unroll
        for (int e = 0; e < 8; ++e) { w0[e] = conv_w[ch + e]; w1[e] = conv_w[CW + ch + e]; w2[e] = conv_w[2 * CW + ch + e]; }
        float zp[8], zc[8], zn[8], fa[8], fc[8];
        if ((t0 % SEQ) == 0) {
#pragma unroll
            for (int e = 0; e < 8; ++e) zp[e] = 0.f;
        } else { const bf16_t* r = proj + (size_t)(t0 - 1) * INW + ch; unpack8(*(const u32x4*)r, fa);
#pragma unroll
            for (int e = 0; e < 8; ++e) zp[e] = fa[e]; }
        { const bf16_t* r = proj + (size_t)t0 * INW + ch; unpack8(*(const u32x4*)r, fa);
#pragma unroll
          for (int e = 0; e < 8; ++e) zc[e] = fa[e]; }
        for (int i = 0; i < 16; ++i) { const int t = t0 + i;
            if (((t + 1) % SEQ) == 0) {
#pragma unroll
                for (int e = 0; e < 8; ++e) zn[e] = 0.f;
            } else { const bf16_t* r = proj + (size_t)(t + 1) * INW + ch; unpack8(*(const u32x4*)r, fa);
#pragma unroll
                for (int e = 0; e < 8; ++e) zn[e] = fa[e]; }
            bf16_t* bp = proj + (size_t)t * INW + 2 * CW + ch; float fb[8]; unpack8(*(const u32x4*)bp, fb);
            float y[8];
#pragma unroll
            for (int e = 0; e < 8; ++e) y[e] = fb[e] * (w0[e] * zp[e] + w1[e] * zc[e] + w2[e] * zn[e]);
            u32x4 w; w.x = cvt_pk_bf16(y[0], y[1]); w.y = cvt_pk_bf16(y[2], y[3]); w.z = cvt_pk_bf16(y[4], y[5]); w.w = cvt_pk_bf16(y[6], y[7]);
            *(u32x4*)bp = w;
#pragma unroll
            for (int e = 0; e < 8; ++e) { zp[e] = zc[e]; zc[e] = zn[e]; }
        }
    }
}
__device__ void knorm_pass(bf16_t* proj, const float* __restrict__ qg, const float* __restrict__ kg) {
    const int lane = threadIdx.x & 63, gw = blockIdx.x * 8 + (threadIdx.x >> 6), nw = gridDim.x * 8;
    for (int t = gw; t < T; t += nw) {
        bf16_t* p = proj + (size_t)t * INW + 3 * CW;
#pragma unroll
        for (int j = 2; j < 4; ++j) { const int idx = (j * 64 + lane) * 8; float f[8]; unpack8(*(const u32x4*)(p + idx), f);
            float ss = 0.f;
#pragma unroll
            for (int e = 0; e < 8; ++e) ss += f[e] * f[e];
            ss += __shfl_xor(ss, 8); ss += __shfl_xor(ss, 4); ss += __shfl_xor(ss, 2); ss += __shfl_xor(ss, 1);
            const float rstd = rsqrtf(ss * (1.0f / 128.0f) + EPS);
            const float* g = (j < 2 ? qg : kg) + (idx & 127);
#pragma unroll
            for (int e = 0; e < 8; ++e) f[e] = f[e] * rstd * g[e];
            u32x4 w; w.x = cvt_pk_bf16(f[0], f[1]); w.y = cvt_pk_bf16(f[2], f[3]); w.z = cvt_pk_bf16(f[4], f[5]); w.w = cvt_pk_bf16(f[6], f[7]);
            *(u32x4*)(p + idx) = w; }
    }
}
__device__ void attn_post(bf16_t* proj, const float* __restrict__ sub_norm) {
    const int lane = threadIdx.x & 63, gw = blockIdx.x * 8 + (threadIdx.x >> 6), nw = gridDim.x * 8;
    const f32x4 g = ((const f32x4*)sub_norm)[lane];
    for (int t = gw; t < T; t += nw) {
        const f32x4* O = (const f32x4*)((const float*)proj + (size_t)t * (INW / 2));
        bf16_t* dst = proj + (size_t)t * INW + 3 * CW;
#pragma unroll
        for (int h = 0; h < NH; ++h) { const f32x4 v = O[h * 64 + lane];
            const float ss = wave_sum(v[0] * v[0] + v[1] * v[1] + v[2] * v[2] + v[3] * v[3]);
            const float rstd = rsqrtf(ss * (1.0f / 256.0f) + EPS) * 0.8f;
            u32x2 w; w.x = cvt_pk_bf16(v[0] * rstd * g[0], v[1] * rstd * g[1]); w.y = cvt_pk_bf16(v[2] * rstd * g[2], v[3] * rstd * g[3]);
            *(u32x2*)(dst + h * 256 + lane * 4) = w; }
    }
}
__device__ __forceinline__ int t5_bucket(int rel) {
    const int ret = rel > 0 ? 16 : 0; const int n = rel < 0 ? -rel : rel;
    if (n < 8) return ret + n;
    int large = 8 + (int)(logf((float)n * 0.125f) / 2.7725887f * 8.0f);
    large = large < 15 ? large : 15;
    return ret + large;
}

#define XB_TMO      128
#define XB_XCNT(j)  (256  + 64 * (j))
#define XB_XSUB(j)  (1280 + 64 * (j))
#define XB_XGEN(j)  (2304 + 64 * (j))
#define XB_TOP      3328
#define XB_TOPGEN   3392
#define XCD_BAR_WORDS 3456
#define XB_SPIN_CAP (1u << 18)

__device__ __forceinline__ unsigned xb_ld(unsigned* p)              { return __hip_atomic_load(p, __ATOMIC_RELAXED, __HIP_MEMORY_SCOPE_AGENT); }
__device__ __forceinline__ unsigned xb_add(unsigned* p, unsigned v) { return __hip_atomic_fetch_add(p, v, __ATOMIC_RELAXED, __HIP_MEMORY_SCOPE_AGENT); }
__device__ __forceinline__ unsigned xb_xcc_id() { return (unsigned)__builtin_amdgcn_s_getreg((3 << 11) | 20) & 0xFu; }
#define XB_SPIN(cond, bar) do { unsigned _sp = 0; while (cond) { __builtin_amdgcn_s_sleep(1); \
    if ((++_sp & 255u) == 0u) { if (xb_ld(&(bar)[XB_TMO])) break; if (_sp > XB_SPIN_CAP) { atomicAdd(&(bar)[XB_TMO], 1u); break; } } } } while (0)

struct XcdBarrier {
    unsigned* bar; unsigned x;
    volatile LAS unsigned* st;
};

__device__ __forceinline__ XcdBarrier xcd_barrier_post(unsigned* bar, volatile LAS unsigned* st) {
    XcdBarrier b; b.bar = bar; b.x = xb_xcc_id(); b.st = st;
    if (threadIdx.x == 0) (void)xb_add(&bar[XB_XCNT(b.x)], 1u);
    return b;
}
__device__ __forceinline__ void xcd_barrier_complete(unsigned* bar, unsigned x, unsigned& nloc, unsigned& nx) {
    const unsigned G = gridDim.x * gridDim.y * gridDim.z;
    unsigned sum, cnt, mine, sp = 0u;
    for (;;) {
        sum = 0u; cnt = 0u; mine = 0u;
#pragma unroll
        for (unsigned j = 0; j < 16; ++j) { const unsigned c = xb_ld(&bar[XB_XCNT(j)]); sum += c; cnt += (c > 0u) ? 1u : 0u; mine = (j == x) ? c : mine; }
        if (sum == G) break;
        __builtin_amdgcn_s_sleep(1);
        if ((++sp & 255u) == 0u) { if (xb_ld(&bar[XB_TMO])) break; if (sp > XB_SPIN_CAP) { atomicAdd(&bar[XB_TMO], 1u); break; } }
    }
    nloc = mine > 0u ? mine : 1u; nx = cnt > 0u ? cnt : 1u;
}

__device__ __forceinline__ void xcd_barrier(const XcdBarrier& b) {
    asm volatile("s_waitcnt vmcnt(0)" ::: "memory");
    __syncthreads();
    if (threadIdx.x == 0) {
        unsigned* bar = b.bar;
        __builtin_amdgcn_s_waitcnt(0);
        unsigned nloc = b.st[0], nx = b.st[1];
        if (nloc == 0u) { xcd_barrier_complete(bar, b.x, nloc, nx); b.st[0] = nloc; b.st[1] = nx; }
        const unsigned old = xb_add(&bar[XB_XSUB(b.x)], 1u);
        const unsigned gen = old / nloc;
        if (old + 1u == (gen + 1u) * nloc) {
            __builtin_amdgcn_fence(__ATOMIC_RELEASE, "agent");
            asm volatile("s_waitcnt vmcnt(0)" ::: "memory");
            const unsigned og = xb_add(&bar[XB_TOP], 1u);
            const unsigned tg = og / nx;
            if (og + 1u == (tg + 1u) * nx) xb_add(&bar[XB_TOPGEN], 1u);
            else XB_SPIN(xb_ld(&bar[XB_TOPGEN]) == tg, bar);
            __builtin_amdgcn_fence(__ATOMIC_ACQUIRE, "agent");
            xb_add(&bar[XB_XGEN(b.x)], 1u);
            asm volatile("s_waitcnt vmcnt(0)" ::: "memory");
        } else {
            XB_SPIN(xb_ld(&bar[XB_XGEN(b.x)]) == gen, bar);
            __builtin_amdgcn_fence(__ATOMIC_ACQUIRE, "agent");
            asm volatile("s_waitcnt vmcnt(0)" ::: "memory");
        }
    }
    __syncthreads();
}

__global__ void __launch_bounds__(512, 2) mega(Params P) {
    extern __shared__ __attribute__((aligned(16))) unsigned char lds[];
    cg::grid_group grid = cg::this_grid();
    LAS unsigned char* ldsl = (LAS unsigned char*)lds;
    const int G = gridDim.x, lo = P.ph_lo, hi = P.ph_hi;
    volatile LAS unsigned* xbst = (volatile LAS unsigned*)(ldsl + LDS_XB);
    if (threadIdx.x < 4) xbst[threadIdx.x] = 0u;
    __syncthreads();
    unsigned char* ws = P.ws;
    const float* x = P.in[0]; const float* pin = P.in[1];
    bf16_t* W13_1 = (bf16_t*)(ws + WS_W13_1); bf16_t* W2_1 = (bf16_t*)(ws + WS_W2_1); bf16_t* W13_2 = (bf16_t*)(ws + WS_W13_2); bf16_t* W2_2 = (bf16_t*)(ws + WS_W2_2);
    bf16_t* WIG = (bf16_t*)(ws + WS_WIG); bf16_t* WA = (bf16_t*)(ws + WS_WA); bf16_t* WB = (bf16_t*)(ws + WS_WB); bf16_t* WO = (bf16_t*)(ws + WS_WO);
    bf16_t* WPG = (bf16_t*)(ws + WS_WPG); bf16_t* WPP = (bf16_t*)(ws + WS_WPP);
    bf16_t* RA = (bf16_t*)(ws + WS_A); bf16_t* PROJ = (bf16_t*)(ws + WS_PROJ); bf16_t* GATES = (bf16_t*)(ws + WS_GATES); bf16_t* GB = (bf16_t*)(ws + WS_G);
    bf16_t* PP = (bf16_t*)(ws + WS_PP); bf16_t* P16 = (bf16_t*)(ws + WS_P16); bf16_t* RB = (bf16_t*)(ws + WS_RB);
    float* RSS1 = (float*)(ws + WS_RSS); float* RSS2 = RSS1 + T; float* RSS3 = RSS2 + T;
    float* out = P.out;
#ifndef PHASE_MASK
#define PHASE_MASK 0x1FFFF
#endif
#define IN(k) (((PHASE_MASK >> (k)) & 1) && lo <= (k) && (k) < hi)
#define SYNC(k) do { if (lo <= (k) && (k) + 1 < hi) xcd_barrier(xbar); } while (0)

    if (IN(0)) {
        for (int i = blockIdx.x * 512 + threadIdx.x; i < 3 * T; i += G * 512) RSS1[i] = 0.f;
        if (blockIdx.x == 0) for (int i = threadIdx.x; i < XCD_BAR_WORDS; i += 512) ((unsigned*)(ws + WS_XBAR))[i] = 0u;
        cvt_rows(pin, P16, (size_t)T * PLE / 8);
        transpose_cvt(lds, P.in[3], W13_1, DM, FF, 1, 0); transpose_cvt(lds, P.in[4], W13_1, DM, FF, 1, 1); transpose_cvt(lds, P.in[5], W2_1, FF, DM, 0, 0);
        transpose_cvt(lds, P.in[22], W13_2, DM, FF, 1, 0, P.in[21]); transpose_cvt(lds, P.in[23], W13_2, DM, FF, 1, 1, P.in[21]); transpose_cvt(lds, P.in[24], W2_2, FF, DM, 0, 0);
        transpose_cvt(lds, P.in[7], WIG, DM, CW, 1, 0, P.in[6], INW); transpose_cvt(lds, P.in[7] + CW, WIG, DM, CW, 1, 1, P.in[6], INW);
        transpose_cvt(lds, P.in[7] + 2 * CW, WIG + (size_t)2 * CW * DM, DM, INW - 2 * CW, 0, 0, P.in[6], INW); transpose_cvt(lds, P.in[19], WIG + (size_t)INW * DM, DM, 2 * DM, 0, 0, P.in[6]);
        transpose_cvt(lds, P.in[17], WA, CW, DM, 0, 0); transpose_cvt(lds, P.in[18], WB, AW, DM, 0, 0);
        transpose_cvt(lds, P.in[20], WO, DM, DM, 0, 0); transpose_cvt(lds, P.in[26], WPG, DM, DM, 0, 0, P.in[25]); transpose_cvt(lds, P.in[27], WPP, PLE, DM, 0, 0);
        rmsnorm_rows(x, P.in[2], RA);
    }
    if (lo <= 0 && 1 < hi) grid.sync();
    XcdBarrier xbar = xcd_barrier_post((unsigned*)(ws + WS_XBAR), xbst);
    if (IN(1)) { pg8::Gemm g{RA, W13_1, T, 2 * FF, DM, DM}; pg8::StaticOrder S; S.init(T, 2 * FF, G, (int)blockIdx.x); pg8::EpiSwiGLU E{GB, FF, nullptr}; pg8::gemm_phase(ldsl, g, S, E); }
    SYNC(1);
    if (IN(2)) { pg8::Gemm g{GB, W2_1, T, DM, FF, FF}; pg8::StaticOrder S; S.init(T, DM, G, (int)blockIdx.x); pg8::EpiRes<false> E{x, DM, 0.5f, RA, RSS1}; pg8::gemm_phase(ldsl, g, S, E); }
    SYNC(2);
    if (IN(4)) { pg8::Gemm g{RA, WIG, T, INW + 2 * DM, DM, DM}; pg8::StaticOrder S; S.init(T, INW + 2 * DM, G, (int)blockIdx.x); pg8::EpiProjGate E{PROJ, INW, GATES, 2 * DM, INW / 256, RSS1}; pg8::gemm_phase(ldsl, g, S, E); }
    SYNC(4);
    if (IN(5)) knorm_pass(PROJ, P.in[9], P.in[10]);
    SYNC(5);
    if (IN(6)) {
        LAS float* tab = (LAS float*)(ldsl + att2::OFF_TAB);
        float s1 = 0.f, s2 = 0.f;
        { const int l = threadIdx.x & 63; s1 = P.in[11][l] * P.in[12][l] + P.in[11][l + 64] * P.in[12][l + 64]; s2 = P.in[13][l] * P.in[14][l] + P.in[13][l + 64] * P.in[14][l + 64]; s1 = wave_sum(s1); s2 = wave_sum(s2); }
        const float lam = __uint_as_float(__builtin_amdgcn_readfirstlane(__float_as_uint(__expf(s1) - __expf(s2) + 0.2f)));
        for (int it = blockIdx.x; it < NB * NH * (SEQ / 256); it += G) {
            const int bh = it & 7, qb = it >> 3, b = bh >> 2, h = bh & 3, q0 = qb * 256;
            __syncthreads();
            for (int i = threadIdx.x; i < 768; i += 512) tab[i] = P.in[16][t5_bucket(i - 384) * NH + h] * (1.0f / att::SCALE);
            __syncthreads();
            const bf16_t* rowq = PROJ + (size_t)(b * SEQ + q0) * INW; const bf16_t* rowk = PROJ + (size_t)(b * SEQ) * INW;
            bf16_t* Ob = PROJ + (size_t)(b * SEQ + q0) * INW + CW + h * 256;
#pragma unroll 1
            for (int sub = 0; sub < 2; ++sub) {
                int sb = sub; asm volatile("" : "+s"(sb));
                int seqv = SEQ; asm volatile("" : "+s"(seqv));
                att2::attn_body(rowq + 3 * CW + h * 256 + sb * 128, rowk + 4 * CW + h * 256 + sb * 128, rowk + 5 * CW + h * 256, Ob, seqv, q0, lam, sb != 0, ldsl, (bf16_t*)rowq + 3 * CW + h * 256, P.in[15], P.in[9]);
            }
        }
    }
    if (IN(6)) conv_pass(PROJ, P.in[8]);
    SYNC(6);
    if (IN(8)) { pg8::Gemm g{PROJ + 2 * CW, WA, T, DM, CW, INW}; pg8::StaticOrder S; S.init(T, DM, G, (int)blockIdx.x); pg8::EpiGated<false> E{PROJ + 4 * CW, INW, GATES, 2 * DM, 0}; pg8::gemm_phase(ldsl, g, S, E); }
    if (IN(9)) { pg8::Gemm g{PROJ + 3 * CW, WB, T, DM, AW, INW}; pg8::StaticOrder S; S.init(T, DM, G, (int)blockIdx.x); pg8::EpiGated<true> E{PROJ + 4 * CW, INW, GATES, 2 * DM, DM}; pg8::gemm_phase(ldsl, g, S, E); }
    SYNC(9);
    if (IN(10)) { pg8::Gemm g{PROJ + 4 * CW, WO, T, DM, DM, INW}; pg8::StaticOrder S; S.init(T, DM, G, (int)blockIdx.x); pg8::EpiRes<true> E{RA, DM, 1.0f, RB, RSS2}; pg8::gemm_phase(ldsl, g, S, E); }
    SYNC(10);
    if (IN(12)) { pg8::Gemm g{RB, W13_2, T, 2 * FF, DM, DM}; pg8::StaticOrder S; S.init(T, 2 * FF, G, (int)blockIdx.x); pg8::EpiSwiGLU E{GB, FF, RSS2}; pg8::gemm_phase(ldsl, g, S, E); }
    SYNC(12);
    if (IN(13)) { pg8::Gemm g{GB, W2_2, T, DM, FF, FF}; pg8::StaticOrder S; S.init(T, DM, G, (int)blockIdx.x); pg8::EpiRes<true> E{RB, DM, 0.5f, RA, RSS3}; pg8::gemm_phase(ldsl, g, S, E); }
    if (IN(15)) { pg8::Gemm g{P16, WPP, T, DM, PLE, PLE}; pg8::StaticOrder S; S.init(T, DM, G, (int)blockIdx.x); pg8::EpiBf16NP E{PP, DM}; pg8::gemm_phase(ldsl, g, S, E); }
    SYNC(13);
    if (IN(16)) { pg8::Gemm g{RA, WPG, T, DM, DM, DM}; pg8::StaticOrder S; S.init(T, DM, G, (int)blockIdx.x); pg8::EpiFinal E{RA, out, DM, PP, RSS3}; pg8::gemm_phase(ldsl, g, S, E); }
#undef IN
#undef SYNC
}

extern "C" void kernel_launch(void* const* d_in, const int* in_sizes, int n_in, void* d_out, int out_size, void* d_ws, size_t ws_size, hipStream_t stream) {
    static int grid_blocks = 0;
    if (grid_blocks == 0) {
        if (n_in != 28 || in_sizes[0] != T * DM || out_size != T * DM || ws_size < WS_END) {
            fprintf(stderr, "kernel_launch: shape/workspace mismatch: n_in %d in0 %d out %d ws %zu (need %zu)\n", n_in, n_in > 0 ? in_sizes[0] : -1, out_size, ws_size, (size_t)WS_END); grid_blocks = -1; return; }
        int dev = 0, cus = 0, per_cu = 0;
        hipGetDevice(&dev); hipDeviceGetAttribute(&cus, hipDeviceAttributeMultiprocessorCount, dev);
        if (hipFuncSetAttribute((const void*)mega, hipFuncAttributeMaxDynamicSharedMemorySize, LDS_BYTES) != hipSuccess) { fprintf(stderr, "kernel_launch: hipFuncSetAttribute failed\n"); grid_blocks = -1; return; }
        if (hipOccupancyMaxActiveBlocksPerMultiprocessor(&per_cu, (const void*)mega, 512, LDS_BYTES) != hipSuccess || per_cu < 1) { fprintf(stderr, "kernel_launch: occupancy query says %d\n", per_cu); per_cu = 1; }
        (void)hipGetLastError();
        grid_blocks = cus * 1;
        if (grid_blocks % 8 != 0) grid_blocks -= grid_blocks % 8;
    }
    if (grid_blocks < 0) return;
    Params p{};
    for (int i = 0; i < 28; ++i) p.in[i] = (const float*)d_in[i];
    p.out = (float*)d_out; p.ws = (unsigned char*)d_ws; p.ph_lo = 0; p.ph_hi = 17;
    void* args[] = {&p};
    hipError_t e = hipLaunchCooperativeKernel((const void*)mega, dim3(grid_blocks), dim3(512), args, LDS_BYTES, stream);
    if (e != hipSuccess) fprintf(stderr, "cooperative launch failed: %s (grid %d)\n", hipGetErrorString(e), grid_blocks);
}
```

```cpp
#include <hip/hip_runtime.h>
#include <hip/hip_cooperative_groups.h>
#include <cstdio>
#include <cstdint>
namespace cg = cooperative_groups;

#define LAS __attribute__((address_space(3)))
typedef unsigned short bf16_t;
typedef short bf16x8 __attribute__((ext_vector_type(8)));
typedef short s16x4 __attribute__((ext_vector_type(4)));
typedef float f32x2 __attribute__((ext_vector_type(2)));
typedef float f32x4 __attribute__((ext_vector_type(4)));
typedef float f32x16 __attribute__((ext_vector_type(16)));
typedef unsigned u32x2 __attribute__((ext_vector_type(2)));
typedef unsigned u32x4 __attribute__((ext_vector_type(4)));

constexpr int DM = 2048, NB = 2, SEQ = 16384, T = NB * SEQ, FF = 5632, CW = 1024, AW = 1024, INW = 6144, PLE = 256, NH = 4;
constexpr float EPS = 1e-6f;
constexpr int LDS_XB = 2 * 16384 + 3 * 32768 + 2048 + 768 * 4;
constexpr int LDS_BYTES = LDS_XB + 16;

constexpr size_t SZ_W13 = (size_t)2 * FF * DM * 2, SZ_W2 = (size_t)DM * FF * 2;
constexpr size_t WS_W13_1 = 0, WS_W2_1 = WS_W13_1 + SZ_W13, WS_W13_2 = WS_W2_1 + SZ_W2, WS_W2_2 = WS_W13_2 + SZ_W13;
constexpr size_t WS_WIG = WS_W2_2 + SZ_W2;
constexpr size_t WS_WA = WS_WIG + (size_t)(INW + 2 * DM) * DM * 2;
constexpr size_t WS_WB = WS_WA + (size_t)DM * CW * 2;
constexpr size_t WS_WO = WS_WB + (size_t)DM * AW * 2;
constexpr size_t WS_WPG = WS_WO + (size_t)DM * DM * 2;
constexpr size_t WS_WPP = WS_WPG + (size_t)DM * DM * 2;
constexpr size_t WS_A = WS_WPP + (size_t)DM * PLE * 2;
constexpr size_t WS_BIG = WS_A + (size_t)T * DM * 2;
constexpr size_t WS_PROJ = WS_BIG;
constexpr size_t WS_GATES = WS_PROJ + (size_t)T * INW * 2;
constexpr size_t WS_G = WS_BIG;
constexpr size_t WS_PP = WS_GATES + (size_t)T * DM * 2;
constexpr size_t WS_RB = WS_GATES;
constexpr size_t WS_P16 = WS_GATES + (size_t)T * 2 * DM * 2;
constexpr size_t WS_RSS = WS_P16 + (size_t)T * PLE * 2;
constexpr size_t WS_XBAR = WS_RSS + (size_t)3 * T * 4;
constexpr size_t WS_END = WS_XBAR + 16384;

struct Params { const float* in[28]; float* out; unsigned char* ws; int ph_lo, ph_hi; };

__device__ __forceinline__ unsigned cvt_pk_bf16(float lo, float hi) { unsigned r; asm volatile("v_cvt_pk_bf16_f32 %0, %1, %2" : "=v"(r) : "v"(lo), "v"(hi)); return r; }
__device__ __forceinline__ float bf_lo(unsigned w) { return __uint_as_float(w << 16); }
__device__ __forceinline__ float bf_hi(unsigned w) { return __uint_as_float(w & 0xffff0000u); }
__device__ __forceinline__ float sigmoidf_(float x) { return __builtin_amdgcn_rcpf(1.0f + __expf(-x)); }
__device__ __forceinline__ void unpack8(const u32x4 w, float* f) { f[0] = bf_lo(w.x); f[1] = bf_hi(w.x); f[2] = bf_lo(w.y); f[3] = bf_hi(w.y); f[4] = bf_lo(w.z); f[5] = bf_hi(w.z); f[6] = bf_lo(w.w); f[7] = bf_hi(w.w); }
__device__ __forceinline__ float wave_sum(float s) {
    s += __shfl_xor(s, 32); s += __shfl_xor(s, 16); s += __shfl_xor(s, 8); s += __shfl_xor(s, 4); s += __shfl_xor(s, 2); s += __shfl_xor(s, 1); return s; }

namespace pg8 {
constexpr int BM = 256, BK = 64, HALF = 128, HTB = HALF * BK * 2, STAGE_BYTES = 8 * HTB, NXCD = 8, WGM = 8;
__device__ __forceinline__ int lds_byte(int r, int c) { const int st = (r >> 4) * 2 + (c >> 5), rr = r & 15, cc = c & 31, ob = rr * 64 + cc * 2; return st * 1024 + (ob ^ (((ob >> 9) & 1) << 5)); }
__device__ __forceinline__ void stage_rc(int b, int& R, int& C) { const int st = b / 1024, sb = b % 1024, swz = sb ^ (((sb >> 9) & 1) << 5); R = (st >> 1) * 16 + swz / 64; C = (st & 1) * 32 + (swz % 64) / 2; }
__device__ __forceinline__ int perm32(int rho) { const int n = rho >> 4, i = rho & 15; return 8 * (i >> 2) + 4 * n + (i & 3); }

struct Unit { int pm, pn; };
struct Gemm { const bf16_t* A; const bf16_t* Bt; int M, N, K, lda; };

struct StaticOrder {
    int nM, nN, nwg, G, c, wgm;
    __device__ void init(int M, int N, int G_, int c_) { nM = M / BM; nN = N / BM; nwg = nM * nN; G = G_; c = c_; wgm = nN <= 8 ? 4 : WGM; }
    __device__ bool next(int i, Unit& u) const {
        const long L = (long)i * G + c; if (L >= nwg) return false;
        int wgid = (int)L; { const int q = nwg / NXCD, r = nwg % NXCD, xcd = wgid % NXCD, off = wgid / NXCD; wgid = (xcd < r ? xcd * (q + 1) : r * (q + 1) + (xcd - r) * q) + off; }
        const int nig = wgm * nN, gid = wgid / nig, fm = gid * wgm, gsz = (nM - fm) < wgm ? (nM - fm) : wgm;
        u.pm = fm + ((wgid % nig) % gsz); u.pn = (wgid % nig) / gsz; return true;
    }
};

typedef f32x4 Acc[2][2][4][2];

struct EpiSwiGLU {
    static constexpr bool PERM = true;
    bf16_t* O; int ldc; const float* rss;
    __device__ __forceinline__ void operator()(const Acc& acc, const Unit& u, int wr, int wc, int fr, int fq) const {
        const int row0 = u.pm * BM + wr * 64 + fr, col0 = u.pn * HALF + wc * 32 + 8 * fq;
        float rsv[2][4];
#pragma unroll
        for (int ai = 0; ai < 2; ++ai)
#pragma unroll
            for (int m = 0; m < 4; ++m) rsv[ai][m] = rss ? rss[row0 + ai * HALF + m * 16] : 0.f;
#pragma unroll
        for (int ai = 0; ai < 2; ++ai)
#pragma unroll
            for (int m = 0; m < 4; ++m) {
                const int row = row0 + ai * HALF + m * 16;
                const float rs = rss ? rsqrtf(rsv[ai][m] * (1.0f / DM) + EPS) : 1.0f;
                bf16_t* rowp = O + (size_t)row * ldc + col0;
                float v[8];
#pragma unroll
                for (int n = 0; n < 2; ++n)
#pragma unroll
                    for (int j = 0; j < 4; ++j) { const float g = acc[ai][0][m][n][j] * rs, up = acc[ai][1][m][n][j] * rs; v[n * 4 + j] = g * sigmoidf_(g) * up; }
                u32x4 w; w.x = cvt_pk_bf16(v[0], v[1]); w.y = cvt_pk_bf16(v[2], v[3]); w.z = cvt_pk_bf16(v[4], v[5]); w.w = cvt_pk_bf16(v[6], v[7]);
                *(u32x4*)rowp = w;
            }
    }
};
template <bool BASE_BF16> struct EpiRes {
    static constexpr bool PERM = true;
    const void* base; int ldc; float alpha; bf16_t* obf; float* rss;
    __device__ __forceinline__ void operator()(const Acc& acc, const Unit& u, int wr, int wc, int fr, int fq) const {
        const int row0 = u.pm * BM + wr * 64 + fr, col0 = u.pn * BM + wc * 32 + 8 * fq;
#pragma unroll
        for (int ai = 0; ai < 2; ++ai) {
            u32x4 wb[4][2]; f32x4 fb0[4][2], fb1[4][2];
#pragma unroll
            for (int m = 0; m < 4; ++m) { const size_t off = (size_t)(row0 + ai * HALF + m * 16) * ldc + col0;
#pragma unroll
                for (int bj = 0; bj < 2; ++bj) {
                    if (BASE_BF16) wb[m][bj] = *(const u32x4*)((const bf16_t*)base + off + bj * HALF);
                    else { fb0[m][bj] = *(const f32x4*)((const float*)base + off + bj * HALF); fb1[m][bj] = *(const f32x4*)((const float*)base + off + bj * HALF + 4); } } }
#pragma unroll
            for (int m = 0; m < 4; ++m) { const int row = row0 + ai * HALF + m * 16; const size_t off = (size_t)row * ldc + col0; float ss = 0.f;
#pragma unroll
                for (int bj = 0; bj < 2; ++bj) {
                    f32x4 b0, b1;
                    if (BASE_BF16) { const u32x4 w = wb[m][bj]; b0 = (f32x4){bf_lo(w.x), bf_hi(w.x), bf_lo(w.y), bf_hi(w.y)}; b1 = (f32x4){bf_lo(w.z), bf_hi(w.z), bf_lo(w.w), bf_hi(w.w)}; }
                    else { b0 = fb0[m][bj]; b1 = fb1[m][bj]; }
                    const f32x4 r0 = b0 + alpha * acc[ai][bj][m][0], r1 = b1 + alpha * acc[ai][bj][m][1];
                    ss += ((r0[0] * r0[0] + r0[1] * r0[1]) + (r0[2] * r0[2] + r0[3] * r0[3])) + ((r1[0] * r1[0] + r1[1] * r1[1]) + (r1[2] * r1[2] + r1[3] * r1[3]));
                    u32x4 w; w.x = cvt_pk_bf16(r0[0], r0[1]); w.y = cvt_pk_bf16(r0[2], r0[3]); w.z = cvt_pk_bf16(r1[0], r1[1]); w.w = cvt_pk_bf16(r1[2], r1[3]);
                    *(u32x4*)(obf + off + bj * HALF) = w; }
                ss += __shfl_xor(ss, 16); ss += __shfl_xor(ss, 32);
                if (fq == 0) atomicAdd(rss + row, ss); }
            asm volatile("" ::: "memory"); }
    }
};
struct EpiProjGate {
    static constexpr bool PERM = true;
    bf16_t* O0; int ld0; bf16_t* O1; int ld1; int nsplit; const float* rss;
    __device__ __forceinline__ void operator()(const Acc& acc, const Unit& u, int wr, int wc, int fr, int fq) const {
        const bool gate = u.pn >= nsplit;
        bf16_t* base = gate ? O1 : O0; const int ldc = gate ? ld1 : ld0;
        const int row0 = u.pm * BM + wr * 64 + fr, col0 = (gate ? u.pn - nsplit : u.pn) * BM + wc * 32 + 8 * fq;
        float rsv[2][4];
#pragma unroll
        for (int ai = 0; ai < 2; ++ai)
#pragma unroll
            for (int m = 0; m < 4; ++m) rsv[ai][m] = rss[row0 + ai * HALF + m * 16];
#pragma unroll
        for (int ai = 0; ai < 2; ++ai)
#pragma unroll
            for (int m = 0; m < 4; ++m) { const int row = row0 + ai * HALF + m * 16; bf16_t* rowp = base + (size_t)row * ldc + col0;
                const float rs = rsqrtf(rsv[ai][m] * (1.0f / DM) + EPS);
                if (u.pn < 8) {
                    const float rs2 = rs * rs; const f32x4 z0 = acc[ai][0][m][0] * acc[ai][1][m][0] * rs2, z1 = acc[ai][0][m][1] * acc[ai][1][m][1] * rs2;
                    u32x4 w; w.x = cvt_pk_bf16(z0[0], z0[1]); w.y = cvt_pk_bf16(z0[2], z0[3]); w.z = cvt_pk_bf16(z1[0], z1[1]); w.w = cvt_pk_bf16(z1[2], z1[3]);
                    *(u32x4*)(O0 + (size_t)row * ld0 + u.pn * HALF + wc * 32 + 8 * fq) = w;
                    continue; }
#pragma unroll
                for (int bj = 0; bj < 2; ++bj) { f32x4 v0 = acc[ai][bj][m][0] * rs, v1 = acc[ai][bj][m][1] * rs;
                    if (gate) {
#pragma unroll
                        for (int j = 0; j < 4; ++j) { v0[j] = sigmoidf_(v0[j]); v1[j] = sigmoidf_(v1[j]); } }
                    u32x4 w; w.x = cvt_pk_bf16(v0[0], v0[1]); w.y = cvt_pk_bf16(v0[2], v0[3]); w.z = cvt_pk_bf16(v1[0], v1[1]); w.w = cvt_pk_bf16(v1[2], v1[3]);
                    *(u32x4*)(rowp + bj * HALF) = w; } }
    }
};
template <bool ADD> struct EpiGated {
    static constexpr bool PERM = true;
    bf16_t* O; int ldc; const bf16_t* gate; int ldg; int goff;
    __device__ __forceinline__ void operator()(const Acc& acc, const Unit& u, int wr, int wc, int fr, int fq) const {
        const int row0 = u.pm * BM + wr * 64 + fr, col0 = u.pn * BM + wc * 32 + 8 * fq;
#pragma unroll
        for (int ai = 0; ai < 2; ++ai) {
            u32x4 g[4][2], pv[4][2];
#pragma unroll
            for (int m = 0; m < 4; ++m) { const size_t r = (size_t)(row0 + ai * HALF + m * 16);
#pragma unroll
                for (int bj = 0; bj < 2; ++bj) { g[m][bj] = *(const u32x4*)(gate + r * ldg + goff + col0 + bj * HALF); if (ADD) pv[m][bj] = *(const u32x4*)(O + r * ldc + col0 + bj * HALF); } }
#pragma unroll
            for (int m = 0; m < 4; ++m) { const size_t r = (size_t)(row0 + ai * HALF + m * 16);
#pragma unroll
                for (int bj = 0; bj < 2; ++bj) { const f32x4 v0 = acc[ai][bj][m][0], v1 = acc[ai][bj][m][1]; const u32x4 gg = g[m][bj];
                    float o[8] = {bf_lo(gg.x) * v0[0], bf_hi(gg.x) * v0[1], bf_lo(gg.y) * v0[2], bf_hi(gg.y) * v0[3], bf_lo(gg.z) * v1[0], bf_hi(gg.z) * v1[1], bf_lo(gg.w) * v1[2], bf_hi(gg.w) * v1[3]};
                    if (ADD) { const u32x4 p = pv[m][bj];
                        o[0] += bf_lo(p.x); o[1] += bf_hi(p.x); o[2] += bf_lo(p.y); o[3] += bf_hi(p.y); o[4] += bf_lo(p.z); o[5] += bf_hi(p.z); o[6] += bf_lo(p.w); o[7] += bf_hi(p.w); }
                    u32x4 w; w.x = cvt_pk_bf16(o[0], o[1]); w.y = cvt_pk_bf16(o[2], o[3]); w.z = cvt_pk_bf16(o[4], o[5]); w.w = cvt_pk_bf16(o[6], o[7]);
                    *(u32x4*)(O + r * ldc + col0 + bj * HALF) = w; } }
            asm volatile("" ::: "memory"); }
    }
};
struct EpiBf16NP {
    static constexpr bool PERM = true;
    bf16_t* O; int ldc;
    __device__ __forceinline__ void operator()(const Acc& acc, const Unit& u, int wr, int wc, int fr, int fq) const {
        const int row0 = u.pm * BM + wr * 64 + fr, col0 = u.pn * BM + wc * 32 + 8 * fq;
#pragma unroll
        for (int ai = 0; ai < 2; ++ai)
#pragma unroll
            for (int m = 0; m < 4; ++m) { const size_t off = (size_t)(row0 + ai * HALF + m * 16) * ldc + col0;
#pragma unroll
                for (int bj = 0; bj < 2; ++bj) { const f32x4 v0 = acc[ai][bj][m][0], v1 = acc[ai][bj][m][1];
                    u32x4 w; w.x = cvt_pk_bf16(v0[0], v0[1]); w.y = cvt_pk_bf16(v0[2], v0[3]); w.z = cvt_pk_bf16(v1[0], v1[1]); w.w = cvt_pk_bf16(v1[2], v1[3]);
                    *(u32x4*)(O + off + bj * HALF) = w; } }
    }
};
struct EpiFinal {
    static constexpr bool PERM = true;
    const bf16_t* base; float* out; int ldc; const bf16_t* pp; const float* rss;
    __device__ __forceinline__ void operator()(const Acc& acc, const Unit& u, int wr, int wc, int fr, int fq) const {
        const int row0 = u.pm * BM + wr * 64 + fr, col0 = u.pn * BM + wc * 32 + 8 * fq;
        float rsv[2][4];
#pragma unroll
        for (int ai = 0; ai < 2; ++ai)
#pragma unroll
            for (int m = 0; m < 4; ++m) rsv[ai][m] = rss[row0 + ai * HALF + m * 16];
#pragma unroll
        for (int ai = 0; ai < 2; ++ai) {
            u32x4 bs[4][2], pw[4][2];
#pragma unroll
            for (int m = 0; m < 4; ++m) { const size_t off = (size_t)(row0 + ai * HALF + m * 16) * ldc + col0;
#pragma unroll
                for (int bj = 0; bj < 2; ++bj) { bs[m][bj] = *(const u32x4*)(base + off + bj * HALF); pw[m][bj] = *(const u32x4*)(pp + off + bj * HALF); } }
#pragma unroll
            for (int m = 0; m < 4; ++m) { const int row = row0 + ai * HALF + m * 16; const size_t off = (size_t)row * ldc + col0; const float rs = rsqrtf(rsv[ai][m] * (1.0f / DM) + EPS);
#pragma unroll
                for (int bj = 0; bj < 2; ++bj) { const u32x4 bw = bs[m][bj], q = pw[m][bj]; const f32x4 a0 = acc[ai][bj][m][0] * rs, a1 = acc[ai][bj][m][1] * rs;
                    f32x4 r0, r1;
                    r0[0] = bf_lo(bw.x) + sigmoidf_(a0[0]) * bf_lo(q.x); r0[1] = bf_hi(bw.x) + sigmoidf_(a0[1]) * bf_hi(q.x); r0[2] = bf_lo(bw.y) + sigmoidf_(a0[2]) * bf_lo(q.y); r0[3] = bf_hi(bw.y) + sigmoidf_(a0[3]) * bf_hi(q.y);
                    r1[0] = bf_lo(bw.z) + sigmoidf_(a1[0]) * bf_lo(q.z); r1[1] = bf_hi(bw.z) + sigmoidf_(a1[1]) * bf_hi(q.z); r1[2] = bf_lo(bw.w) + sigmoidf_(a1[2]) * bf_lo(q.w); r1[3] = bf_hi(bw.w) + sigmoidf_(a1[3]) * bf_hi(q.w);
                    *(f32x4*)(out + off + bj * HALF) = r0; *(f32x4*)(out + off + bj * HALF + 4) = r1; } }
            asm volatile("" ::: "memory"); }
    }
};

template <class Epi>
__device__ __forceinline__ void gemm_phase(LAS unsigned char* lds, const Gemm g, const StaticOrder& S, const Epi& E) {
    const int tid = threadIdx.x, wid = __builtin_amdgcn_readfirstlane(tid >> 6), lane = tid & 63, wr = wid >> 2, wc = wid & 3, fr = lane & 15, fq = lane >> 4;
    const int K = g.K, nt = K / BK, lda = g.lda;
    unsigned voffA[2], voffB[2];
#pragma unroll
    for (int i = 0; i < 2; ++i) { int R, C; stage_rc(tid * 16 + i * 8192, R, C); const int Rb = Epi::PERM ? ((R & ~31) + perm32(R & 31)) : R;
        voffA[i] = (unsigned)(R * lda + C) * 2u; voffB[i] = (unsigned)(Rb * K + C) * 2u; }
    const size_t kstep = (size_t)(BK * 2);
    const size_t hstepA = (size_t)HALF * lda * 2, hstepB = (size_t)HALF * K * 2;
    const size_t tstepA = 2 * hstepA, tstepB = 2 * hstepB;
    const unsigned ldsw = (unsigned)wid * 1024u;
    const int aoff = lds_byte(wr * 64 + fr, fq * 8), boff = lds_byte(wc * 32 + fr, fq * 8);
#define PG8_SA(b, h) (((b) * 2 + (h)) * HTB)
#define PG8_SB(b, h) ((4 + (b) * 2 + (h)) * HTB)
#define PG8_STAGE(bufoff, gbase, voff) do { _Pragma("unroll") for (int _i = 0; _i < 2; ++_i) \
        __builtin_amdgcn_global_load_lds((const unsigned*)((const char*)(gbase) + (voff)[_i]), (LAS unsigned*)(lds + (bufoff) + ldsw + _i * 8192), 16, 0, 0); } while (0)
#define PG8_LDA(dst, b, h) do { _Pragma("unroll") for (int m = 0; m < 4; ++m) _Pragma("unroll") for (int k = 0; k < 2; ++k) dst[m][k] = *(const LAS bf16x8*)(lds + PG8_SA(b, h) + aoff + m * 2048 + k * 1024); } while (0)
#define PG8_LDB(dst, b, h) do { _Pragma("unroll") for (int n = 0; n < 2; ++n) _Pragma("unroll") for (int k = 0; k < 2; ++k) dst[n][k] = *(const LAS bf16x8*)(lds + PG8_SB(b, h) + boff + n * 2048 + k * 1024); } while (0)
#define PG8_MMA(ai, bj, At, Bt) do { __builtin_amdgcn_s_setprio(1); _Pragma("unroll") for (int m = 0; m < 4; ++m) _Pragma("unroll") for (int n = 0; n < 2; ++n) _Pragma("unroll") for (int k = 0; k < 2; ++k) \
        acc[ai][bj][m][n] = __builtin_amdgcn_mfma_f32_16x16x32_bf16(Bt[n][k], At[m][k], acc[ai][bj][m][n], 0, 0, 0); __builtin_amdgcn_s_setprio(0); } while (0)
#define PG8_WAIT_V(n) asm volatile("s_waitcnt vmcnt(" #n ")" ::: "memory")
#define PG8_WAIT_L(n) asm volatile("s_waitcnt lgkmcnt(" #n ")" ::: "memory")
#define PG8_BAR __builtin_amdgcn_s_barrier()
#define PG8_SCHED __builtin_amdgcn_sched_barrier(0)
    Unit cur, nxt; int ui = 0;
    if (!S.next(0, cur)) return;
    f32x4 acc[2][2][4][2];
#pragma unroll
    for (int a = 0; a < 2; ++a)
#pragma unroll
        for (int b = 0; b < 2; ++b)
#pragma unroll
            for (int m = 0; m < 4; ++m)
#pragma unroll
                for (int n = 0; n < 2; ++n) acc[a][b][m][n] = (f32x4){0.f, 0.f, 0.f, 0.f};
    bf16x8 At[4][2], B0[2][2], B1[2][2];
    const char* cA = (const char*)g.A + (size_t)cur.pm * tstepA; const char* cB = (const char*)g.Bt + (size_t)cur.pn * tstepB;
    PG8_STAGE(PG8_SB(0, 0), cB, voffB); PG8_STAGE(PG8_SA(0, 0), cA, voffA); PG8_STAGE(PG8_SB(0, 1), cB + hstepB, voffB); PG8_STAGE(PG8_SA(0, 1), cA + hstepA, voffA);
    if (wr == 1) PG8_BAR;
    PG8_WAIT_V(4); PG8_BAR;
    PG8_STAGE(PG8_SB(1, 0), cB + kstep, voffB); PG8_STAGE(PG8_SA(1, 0), cA + kstep, voffA); PG8_STAGE(PG8_SB(1, 1), cB + hstepB + kstep, voffB);
    PG8_WAIT_V(6); PG8_BAR;
    for (;;) {
        const bool has_next = S.next(ui + 1, nxt);
        const char* nA = has_next ? (const char*)g.A + (size_t)nxt.pm * tstepA : cA; const char* nB = has_next ? (const char*)g.Bt + (size_t)nxt.pn * tstepB : cB;
        for (int t = 0; t < nt; t += 2) {
            const bool last = (t == nt - 2);
            const char* a1 = cA + (size_t)(t + 1) * kstep;
            const char* a2 = last ? nA : cA + (size_t)(t + 2) * kstep; const char* b2 = last ? nB : cB + (size_t)(t + 2) * kstep;
            const char* a3 = a2 + kstep; const char* b3 = b2 + kstep;
            PG8_LDB(B0, 0, 0); PG8_SCHED; PG8_LDA(At, 0, 0); PG8_STAGE(PG8_SA(1, 1), a1 + hstepA, voffA);
            PG8_WAIT_L(8); PG8_BAR; PG8_WAIT_L(0); PG8_MMA(0, 0, At, B0); PG8_BAR; PG8_SCHED;
            PG8_LDB(B1, 0, 1); PG8_STAGE(PG8_SB(0, 0), b2, voffB);
            PG8_BAR; PG8_WAIT_L(0); PG8_MMA(0, 1, At, B1); PG8_BAR;
            PG8_LDA(At, 0, 1); PG8_STAGE(PG8_SA(0, 0), a2, voffA);
            PG8_BAR; PG8_WAIT_L(0); PG8_MMA(1, 0, At, B0); PG8_BAR; PG8_SCHED;
            PG8_STAGE(PG8_SB(0, 1), b2 + hstepB, voffB);
            PG8_WAIT_V(6); PG8_BAR; PG8_MMA(1, 1, At, B1); PG8_BAR;
            PG8_LDB(B0, 1, 0); PG8_SCHED; PG8_LDA(At, 1, 0); PG8_STAGE(PG8_SA(0, 1), a2 + hstepA, voffA);
            PG8_WAIT_L(8); PG8_BAR; PG8_WAIT_L(0); PG8_MMA(0, 0, At, B0); PG8_BAR; PG8_SCHED;
            PG8_LDB(B1, 1, 1); PG8_STAGE(PG8_SB(1, 0), b3, voffB);
            PG8_BAR; PG8_WAIT_L(0); PG8_MMA(0, 1, At, B1); PG8_BAR;
            PG8_LDA(At, 1, 1); PG8_STAGE(PG8_SA(1, 0), a3, voffA);
            PG8_BAR; PG8_WAIT_L(0); PG8_MMA(1, 0, At, B0); PG8_BAR; PG8_SCHED;
            PG8_STAGE(PG8_SB(1, 1), b3 + hstepB, voffB);
            PG8_WAIT_V(6); PG8_BAR; PG8_MMA(1, 1, At, B1); PG8_BAR;
        }
        E(acc, cur, wr, wc, fr, fq);
        if (!has_next) break;
#pragma unroll
        for (int a = 0; a < 2; ++a)
#pragma unroll
            for (int b = 0; b < 2; ++b)
#pragma unroll
                for (int m = 0; m < 4; ++m)
#pragma unroll
                    for (int n = 0; n < 2; ++n) acc[a][b][m][n] = (f32x4){0.f, 0.f, 0.f, 0.f};
        cur = nxt; cA = nA; cB = nB; ++ui;
    }
    PG8_WAIT_V(0);
    if (wr == 0) PG8_BAR;
    PG8_BAR;
#undef PG8_SA
#undef PG8_SB
#undef PG8_STAGE
#undef PG8_LDA
#undef PG8_LDB
#undef PG8_MMA
#undef PG8_WAIT_V
#undef PG8_WAIT_L
#undef PG8_BAR
#undef PG8_SCHED
}
}

namespace att {
constexpr int D = 128, NW = 8, QBLK = 32, KVBLK = 64;
constexpr float SCALE = 0.088388347648318440f;
constexpr float THR = 8.f;
#ifndef ATT_SDEPTH
#define ATT_SDEPTH 1
#endif
constexpr int LDQ = INW, LDK = INW, LDO = INW / 2;
constexpr int SHM_V = KVBLK * D * 2, SHM_K = KVBLK * D * 2;
constexpr int OFF_WS = 2 * SHM_V + 2 * SHM_K, OFF_TAB = OFF_WS + NW * 64 * 4, SHM_ATTN = OFF_TAB + 768 * 4;
#define KSWZ(row, colB) ((row) * 256 + ((colB) ^ (((row) & 7) << 4)))
#define SBAR() __builtin_amdgcn_sched_barrier(0)
__device__ __forceinline__ int crow(int r, int hi) { return (r & 3) + 8 * (r >> 2) + 4 * hi; }

__device__ __forceinline__ void partialSM(f32x16& p0, f32x16& p1, float& m_reg, float& mn, float& alpha) {
  constexpr float C = SCALE * 1.4426950408889634f;
  float pmax = p0[0];
#pragma unroll
  for (int r = 1; r < 16; ++r) pmax = fmaxf(pmax, p0[r]);
#pragma unroll
  for (int r = 0; r < 16; ++r) pmax = fmaxf(pmax, p1[r]);
  { auto rr = __builtin_amdgcn_permlane32_swap(__float_as_uint(pmax), __float_as_uint(pmax), false, false);
    pmax = fmaxf(__uint_as_float(rr[0]), __uint_as_float(rr[1])); }
  if (__builtin_expect(__all(pmax - m_reg <= THR / SCALE), 1)) { mn = m_reg; alpha = 1.f; }
  else { mn = fmaxf(m_reg, pmax); alpha = __builtin_amdgcn_exp2f((m_reg - mn) * C); m_reg = mn; }
  float mnC = -mn * C;
#pragma unroll
  for (int r = 0; r < 16; ++r) p0[r] = fmaf(p0[r], C, mnC);
#pragma unroll
  for (int r = 0; r < 16; ++r) p1[r] = fmaf(p1[r], C, mnC);
#pragma unroll
  for (int r = 0; r < 16; ++r) p0[r] = __builtin_amdgcn_exp2f(p0[r]);
}
__device__ __forceinline__ void finishSM(f32x16& p0, f32x16& p1, float alpha, float& l_reg, bf16x8& pa0, bf16x8& pa1, bf16x8& pa2, bf16x8& pa3) {
#pragma unroll
  for (int r = 0; r < 16; ++r) p1[r] = __builtin_amdgcn_exp2f(p1[r]);
  float ps = 0;
#pragma unroll
  for (int r = 0; r < 16; ++r) ps += p0[r];
#pragma unroll
  for (int r = 0; r < 16; ++r) ps += p1[r];
  { auto rr = __builtin_amdgcn_permlane32_swap(__float_as_uint(ps), __float_as_uint(ps), false, false);
    ps = __uint_as_float(rr[0]) + __uint_as_float(rr[1]); }
  l_reg = l_reg * alpha + ps;
#define PK4(P, BASE, OUT) do { unsigned a0 = cvt_pk_bf16(P[BASE + 0], P[BASE + 1]), a1 = cvt_pk_bf16(P[BASE + 2], P[BASE + 3]);   \
    unsigned b0 = cvt_pk_bf16(P[BASE + 4], P[BASE + 5]), b1 = cvt_pk_bf16(P[BASE + 6], P[BASE + 7]);                              \
    auto r0 = __builtin_amdgcn_permlane32_swap(a0, b0, false, false); auto r1 = __builtin_amdgcn_permlane32_swap(a1, b1, false, false); \
    u32x4 w = {r0[0], r1[0], r0[1], r1[1]}; OUT = *reinterpret_cast<bf16x8*>(&w); } while (0)
  PK4(p0, 0, pa0); PK4(p0, 8, pa1); PK4(p1, 0, pa2); PK4(p1, 8, pa3);
#undef PK4
}
template <bool NEAR>
__device__ __forceinline__ void qkt(f32x16& p0, f32x16& p1, const bf16_t* Ks, const bf16x8 (&qr)[8], int r32, int hi, float cfar, const float* tabp) {
  if (!NEAR) {
#pragma unroll
    for (int r = 0; r < 16; ++r) { p0[r] = cfar; p1[r] = cfar; }
  } else {
#pragma unroll
    for (int r = 0; r < 16; ++r) { p0[r] = tabp[(r & 3) + 8 * (r >> 2)]; p1[r] = tabp[32 + (r & 3) + 8 * (r >> 2)]; }
  }
#pragma unroll
  for (int d0 = 0; d0 < 8; ++d0) { int cb = (d0 * 16 + hi * 8) * 2;
    bf16x8 b0 = *reinterpret_cast<const bf16x8*>((const char*)Ks + KSWZ(r32, cb));
    bf16x8 b1 = *reinterpret_cast<const bf16x8*>((const char*)Ks + KSWZ(32 + r32, cb));
    p0 = __builtin_amdgcn_mfma_f32_32x32x16_bf16(b0, qr[d0], p0, 0, 0, 0);
    p1 = __builtin_amdgcn_mfma_f32_32x32x16_bf16(b1, qr[d0], p1, 0, 0, 0); }
}
__device__ __forceinline__ int v_st(int k, int c) { const int kk = (k & ~0xC) | ((k & 4) << 1) | ((k & 8) >> 1); return ((kk >> 3) * 4 + (c >> 5)) * 512 + ((kk & 7) * 32 + (c & 31)) * 2; }
__device__ __forceinline__ int v_rd_base(int lane) { return ((lane & 3) << 3) | (((lane >> 2) & 3) << 6) | (((lane >> 4) & 1) << 5) | (((lane >> 5) & 1) << 8); }
constexpr int v_rd_off(int d0, int ks, int half) { return d0 * 512 + ks * 4096 + half * 2048; }
template <int OFF> __device__ __forceinline__ s16x4 tr_read(int vb) {
  s16x4 r; asm volatile("ds_read_b64_tr_b16 %0, %1 offset:%2" : "=&v"(r) : "v"(vb), "i"(OFF) : "memory"); return r;
}
template <int D0> __device__ __forceinline__ void pv_one(f32x16& od, int vb, bf16x8 pa0, bf16x8 pa1, bf16x8 pa2, bf16x8 pa3) {
  const s16x4 l0 = tr_read<v_rd_off(D0, 0, 0)>(vb), h0 = tr_read<v_rd_off(D0, 0, 1)>(vb), l1 = tr_read<v_rd_off(D0, 1, 0)>(vb), h1 = tr_read<v_rd_off(D0, 1, 1)>(vb);
  const s16x4 l2 = tr_read<v_rd_off(D0, 2, 0)>(vb), h2 = tr_read<v_rd_off(D0, 2, 1)>(vb), l3 = tr_read<v_rd_off(D0, 3, 0)>(vb), h3 = tr_read<v_rd_off(D0, 3, 1)>(vb);
  asm volatile("s_waitcnt lgkmcnt(0)" ::: "memory"); SBAR();
#define PK(L, H) (bf16x8){L[0], L[1], L[2], L[3], H[0], H[1], H[2], H[3]}
  od = __builtin_amdgcn_mfma_f32_32x32x16_bf16(pa0, PK(l0, h0), od, 0, 0, 0);
  od = __builtin_amdgcn_mfma_f32_32x32x16_bf16(pa1, PK(l1, h1), od, 0, 0, 0);
  od = __builtin_amdgcn_mfma_f32_32x32x16_bf16(pa2, PK(l2, h2), od, 0, 0, 0);
  od = __builtin_amdgcn_mfma_f32_32x32x16_bf16(pa3, PK(l3, h3), od, 0, 0, 0);
#undef PK
}
__device__ __forceinline__ void pv_d0(f32x16* o, int vb, bf16x8 pa0, bf16x8 pa1, bf16x8 pa2, bf16x8 pa3) {
  pv_one<0>(o[0], vb, pa0, pa1, pa2, pa3); pv_one<1>(o[1], vb, pa0, pa1, pa2, pa3); pv_one<2>(o[2], vb, pa0, pa1, pa2, pa3); pv_one<3>(o[3], vb, pa0, pa1, pa2, pa3);
}

template <int SDEPTH>
__device__ __forceinline__ void attn_range(const bf16_t* __restrict__ Kh, const bf16_t* __restrict__ Vh, int NT, float cfar, const bf16x8 (&qr)[8],
                                           float& m_reg, float& l_reg, f32x16 (&o)[4], char* lds, int tid, int wid, int r32, int hi) {
  bf16_t* V_lds = (bf16_t*)lds; bf16_t* K_lds = (bf16_t*)(lds + 2 * SHM_V);
  float* al_l = (float*)(lds + OFF_WS) + wid * 64 + 32;
  const int sr = tid >> 4, sc = (tid & 15) * 8, vst0 = v_st(sr, sc), vst1 = v_st(32 + sr, sc);
  const int vb0 = (int)(uintptr_t)V_lds + v_rd_base(tid & 63);
  struct { bf16x8 vs0, vs1, ks0, ks1; } sr_[SDEPTH];
#define SLOAD(i, k0) do { sr_[i].vs0 = *reinterpret_cast<const bf16x8*>(&Vh[(long)((k0) + sr) * LDK + sc]); sr_[i].vs1 = *reinterpret_cast<const bf16x8*>(&Vh[(long)((k0) + 32 + sr) * LDK + sc]); \
    sr_[i].ks0 = *reinterpret_cast<const bf16x8*>(&Kh[(long)((k0) + sr) * LDK + sc]); sr_[i].ks1 = *reinterpret_cast<const bf16x8*>(&Kh[(long)((k0) + 32 + sr) * LDK + sc]); } while (0)
#define SWRITE(b, i) do { *(bf16x8*)((char*)V_lds + (b) * SHM_V + vst0) = sr_[i].vs0;          \
    *(bf16x8*)((char*)V_lds + (b) * SHM_V + vst1) = sr_[i].vs1; int kc = sc * 2;               \
    *(bf16x8*)((char*)K_lds + (b) * SHM_K + KSWZ(sr, kc)) = sr_[i].ks0;                       \
    *(bf16x8*)((char*)K_lds + (b) * SHM_K + KSWZ(32 + sr, kc)) = sr_[i].ks1; } while (0)
#define SWAIT() do { if constexpr (SDEPTH == 2) asm volatile("s_waitcnt vmcnt(4)" ::: "memory"); else asm volatile("s_waitcnt vmcnt(0)" ::: "memory"); } while (0)
#define RESC(a) do { if (__any((a) < 1.f)) { if (hi == 0) al_l[r32] = (a); asm volatile("s_waitcnt lgkmcnt(0)" ::: "memory"); \
    _Pragma("unroll") for (int d = 0; d < 4; ++d) _Pragma("unroll") for (int r = 0; r < 16; ++r) o[d][r] *= al_l[crow(r, hi)]; } } while (0)
#define QKT(P0, P1, KB, jj) qkt<false>(P0, P1, KB, qr, r32, hi, cfar, nullptr)
  f32x16 pA0, pA1, pB0, pB1; float mnA, mnB, alA, alB; bf16x8 pa0, pa1, pa2, pa3;
  constexpr int SE = 0, SO = SDEPTH - 1;
  SLOAD(SE, 0); asm volatile("s_waitcnt vmcnt(0)" ::: "memory"); SWRITE(0, SE); __syncthreads();
  QKT(pA0, pA1, K_lds, 0); partialSM(pA0, pA1, m_reg, mnA, alA);
  SLOAD(SO, KVBLK); if constexpr (SDEPTH == 2) { if (2 < NT) SLOAD(SE, 2 * KVBLK); }
  SWAIT(); SWRITE(1, SO); __syncthreads();
  RESC(alA);
  for (int j = 1; j + 1 < NT; j += 2) {
    SBAR(); QKT(pB0, pB1, (bf16_t*)((char*)K_lds + SHM_K), j);
    finishSM(pA0, pA1, alA, l_reg, pa0, pa1, pa2, pa3); SBAR();
    SLOAD(SO, (j + SDEPTH) * KVBLK); SBAR();
    pv_d0(o, vb0, pa0, pa1, pa2, pa3); partialSM(pB0, pB1, m_reg, mnB, alB);
    __syncthreads(); SWAIT(); SWRITE(0, SE);
    RESC(alB); __syncthreads();
    SBAR(); QKT(pA0, pA1, K_lds, j + 1);
    finishSM(pB0, pB1, alB, l_reg, pa0, pa1, pa2, pa3); SBAR();
    if (SDEPTH == 1 || j + 3 < NT) SLOAD(SE, (j + 1 + SDEPTH) * KVBLK); SBAR();
    pv_d0(o, vb0 + (int)SHM_V, pa0, pa1, pa2, pa3); partialSM(pA0, pA1, m_reg, mnA, alA);
    __syncthreads(); SWAIT(); SWRITE(1, SO);
    RESC(alA); __syncthreads();
  }
  SBAR(); QKT(pB0, pB1, (bf16_t*)((char*)K_lds + SHM_K), NT - 1);
  finishSM(pA0, pA1, alA, l_reg, pa0, pa1, pa2, pa3); SBAR();
  pv_d0(o, vb0, pa0, pa1, pa2, pa3); partialSM(pB0, pB1, m_reg, mnB, alB);
  __syncthreads(); RESC(alB);
  finishSM(pB0, pB1, alB, l_reg, pa0, pa1, pa2, pa3); SBAR();
  pv_d0(o, vb0 + (int)SHM_V, pa0, pa1, pa2, pa3);
#undef SLOAD
#undef SWRITE
#undef SWAIT
#undef RESC
#undef QKT
}

__device__ __forceinline__ void attn_near(const bf16_t* __restrict__ Kh, const bf16_t* __restrict__ Vh, int NT, const float* tabl, const bf16x8 (&qr)[8],
                                          float& m_reg, float& l_reg, f32x16 (&o)[4], char* lds, int tid, int wid, int r32, int hi) {
  bf16_t* V_lds = (bf16_t*)lds; bf16_t* K_lds = (bf16_t*)(lds + 2 * SHM_V);
  float* al_l = (float*)(lds + OFF_WS) + wid * 64 + 32;
  const int sr = tid >> 4, sc = (tid & 15) * 8, vst0 = v_st(sr, sc), vst1 = v_st(32 + sr, sc);
  const int vb0 = (int)(uintptr_t)V_lds + v_rd_base(tid & 63);
#pragma unroll 1
  for (int j = 0; j < NT; ++j) {
    const long k0 = (long)j * KVBLK;
    const bf16x8 vs0 = *reinterpret_cast<const bf16x8*>(&Vh[(k0 + sr) * LDK + sc]), vs1 = *reinterpret_cast<const bf16x8*>(&Vh[(k0 + 32 + sr) * LDK + sc]);
    const bf16x8 ks0 = *reinterpret_cast<const bf16x8*>(&Kh[(k0 + sr) * LDK + sc]), ks1 = *reinterpret_cast<const bf16x8*>(&Kh[(k0 + 32 + sr) * LDK + sc]);
    __syncthreads();
    *(bf16x8*)((char*)V_lds + vst0) = vs0; *(bf16x8*)((char*)V_lds + vst1) = vs1;
    *(bf16x8*)((char*)K_lds + KSWZ(sr, sc * 2)) = ks0; *(bf16x8*)((char*)K_lds + KSWZ(32 + sr, sc * 2)) = ks1;
    __syncthreads();
    f32x16 p0, p1; float mn, al; bf16x8 pa0, pa1, pa2, pa3;
    qkt<true>(p0, p1, K_lds, qr, r32, hi, 0.f, tabl + j * KVBLK);
    partialSM(p0, p1, m_reg, mn, al);
    if (__any(al < 1.f)) { if (hi == 0) al_l[r32] = al; asm volatile("s_waitcnt lgkmcnt(0)" ::: "memory");
#pragma unroll
      for (int d = 0; d < 4; ++d)
#pragma unroll
        for (int r = 0; r < 16; ++r) o[d][r] *= al_l[crow(r, hi)]; }
    finishSM(p0, p1, al, l_reg, pa0, pa1, pa2, pa3); SBAR();
    pv_d0(o, vb0, pa0, pa1, pa2, pa3);
  }
  __syncthreads();
}

__device__ __forceinline__ void attn_body(const bf16_t* __restrict__ Qb, const bf16_t* __restrict__ Kh, const bf16_t* __restrict__ Vh, float* Ob, int seq, int q0, float lam, bool SUBTRACT, char* lds) {
  int tid = threadIdx.x; asm volatile("" : "+v"(tid));
  const int wid = __builtin_amdgcn_readfirstlane(tid >> 6), lane = tid & 63, r32 = lane & 31, hi = lane >> 5;
  float* li_l = (float*)(lds + OFF_WS) + wid * 64;
  const float* tab = (const float*)(lds + OFF_TAB);
  const int NT = seq / KVBLK;
  int jn0 = q0 / KVBLK - 2, jn1 = q0 / KVBLK + 6; jn0 = jn0 < 0 ? 0 : jn0; jn1 = jn1 > NT ? NT : jn1;
  float m_reg = -1e30f, l_reg = 0; f32x16 o[4] = {}; bf16x8 qr[8];
  const bf16_t* Qw = Qb + (long)(wid * QBLK + r32) * LDQ + hi * 8;
#pragma unroll
  for (int d0 = 0; d0 < 8; ++d0) qr[d0] = *reinterpret_cast<const bf16x8*>(Qw + d0 * 16);
  { const float* tabl = tab + (384 + 4 * hi - (q0 + wid * QBLK + r32 - jn0 * KVBLK));
    attn_near(Kh + (long)jn0 * KVBLK * LDK, Vh + (long)jn0 * KVBLK * LDK, jn1 - jn0, tabl, qr, m_reg, l_reg, o, lds, tid, wid, r32, hi); }
#pragma unroll 1
  for (int rg = 0; rg < 2; ++rg) {
    int rr = rg; asm volatile("" : "+s"(rr));
    const int ja = rr ? jn1 : 0, nt = rr ? NT - jn1 : jn0;
    const float cfar = __uint_as_float(__builtin_amdgcn_readfirstlane(__float_as_uint(tab[rr ? 767 : 0])));
    if (nt > 0) attn_range<ATT_SDEPTH>(Kh + (long)ja * KVBLK * LDK, Vh + (long)ja * KVBLK * LDK, nt, cfar, qr, m_reg, l_reg, o, lds, tid, wid, r32, hi);
  }
  if (hi == 0) li_l[r32] = l_reg; asm volatile("s_waitcnt lgkmcnt(0)" ::: "memory");
  float rli[16];
#pragma unroll
  for (int r = 0; r < 16; ++r) rli[r] = __builtin_amdgcn_rcpf(li_l[crow(r, hi)]);
  int r32e = r32, hie = hi; asm volatile("" : "+v"(r32e), "+v"(hie));
  float* Ow = Ob + (long)(wid * QBLK) * LDO + (4 * hie) * LDO + r32e;
  if (SUBTRACT) {
#pragma unroll
    for (int r = 0; r < 16; ++r) {
#pragma unroll
      for (int d0 = 0; d0 < 4; ++d0) { float* op = Ow + ((r & 3) + 8 * (r >> 2)) * LDO + d0 * 32; *op = *op - lam * (o[d0][r] * rli[r]); }
      asm volatile("" ::: "memory"); }
  } else {
#pragma unroll
    for (int r = 0; r < 16; ++r) {
#pragma unroll
      for (int d0 = 0; d0 < 4; ++d0) Ow[((r & 3) + 8 * (r >> 2)) * LDO + d0 * 32] = o[d0][r] * rli[r]; }
  }
  asm volatile("s_waitcnt vmcnt(0)" ::: "memory");
  __syncthreads();
}
}

namespace att2 {
using att::crow; using att::partialSM; using att::finishSM; using att::KVBLK; using att::QBLK; using att::LDQ; using att::LDK; using att::LDO;
constexpr int KBUF = 16384, VBUF = 32768, OFF_K = 0, OFF_V = 2 * KBUF, OFF_WS = OFF_V + 3 * VBUF, OFF_TAB = OFF_WS + 2048, SHM = OFF_TAB + 768 * 4;
#define A2_WAIT_V(n) asm volatile("s_waitcnt vmcnt(" #n ")" ::: "memory")
#define A2_BAR() do { asm volatile("" ::: "memory"); __builtin_amdgcn_s_barrier(); asm volatile("" ::: "memory"); } while (0)
template <int OFF> __device__ __forceinline__ s16x4 tr_read(int vb) {
  s16x4 r; asm volatile("ds_read_b64_tr_b16 %0, %1 offset:%2" : "=&v"(r) : "v"(vb), "i"(OFF) : "memory"); return r;
}
constexpr int v_off(int d0, int ks, int half) { return (d0 >> 2) * 16384 + (d0 & 3) * 512 + ks * 4096 + half * 2048; }
struct VFrag { s16x4 l0, h0, l1, h1; };
template <int D0, int SUB> __device__ __forceinline__ void v_read(VFrag& f, int vb) {
  f.l0 = tr_read<v_off(D0, 2 * SUB, 0)>(vb); f.h0 = tr_read<v_off(D0, 2 * SUB, 1)>(vb); f.l1 = tr_read<v_off(D0, 2 * SUB + 1, 0)>(vb); f.h1 = tr_read<v_off(D0, 2 * SUB + 1, 1)>(vb);
}
__device__ __forceinline__ void v_mma(f32x16& od, const VFrag& f, bf16x8 pa0, bf16x8 pa1) {
#define PK(L, H) (bf16x8){L[0], L[1], L[2], L[3], H[0], H[1], H[2], H[3]}
  od = __builtin_amdgcn_mfma_f32_32x32x16_bf16(pa0, PK(f.l0, f.h0), od, 0, 0, 0);
  od = __builtin_amdgcn_mfma_f32_32x32x16_bf16(pa1, PK(f.l1, f.h1), od, 0, 0, 0);
#undef PK
}
#define A2_LWAIT(n) do { asm volatile("s_waitcnt lgkmcnt(" #n ")" ::: "memory"); __builtin_amdgcn_sched_barrier(0); } while (0)
template <int SUB> __device__ __forceinline__ void pv_all(f32x16 (&o)[8], int vb, bf16x8 pa0, bf16x8 pa1, VFrag& fa) {
  VFrag fb;
  __builtin_amdgcn_s_setprio(1);
  v_read<1, SUB>(fb, vb); A2_LWAIT(4); v_mma(o[0], fa, pa0, pa1); __builtin_amdgcn_sched_barrier(0);
  v_read<2, SUB>(fa, vb); A2_LWAIT(4); v_mma(o[1], fb, pa0, pa1); __builtin_amdgcn_sched_barrier(0);
  v_read<3, SUB>(fb, vb); A2_LWAIT(4); v_mma(o[2], fa, pa0, pa1); __builtin_amdgcn_sched_barrier(0);
  v_read<4, SUB>(fa, vb); A2_LWAIT(4); v_mma(o[3], fb, pa0, pa1); __builtin_amdgcn_sched_barrier(0);
  v_read<5, SUB>(fb, vb); A2_LWAIT(4); v_mma(o[4], fa, pa0, pa1); __builtin_amdgcn_sched_barrier(0);
  v_read<6, SUB>(fa, vb); A2_LWAIT(4); v_mma(o[5], fb, pa0, pa1); __builtin_amdgcn_sched_barrier(0);
  v_read<7, SUB>(fb, vb); A2_LWAIT(4); v_mma(o[6], fa, pa0, pa1); __builtin_amdgcn_sched_barrier(0);
  A2_LWAIT(0); v_mma(o[7], fb, pa0, pa1);
  __builtin_amdgcn_s_setprio(0);
}
struct Ctx { LAS unsigned char* lds; unsigned voffK, voffV; int wid, r32, hi, vb0; LAS float* al_l; };
__device__ __forceinline__ void issueK(const Ctx& c, int buf, const char* g) {
#pragma unroll
  for (int i = 0; i < 2; ++i) __builtin_amdgcn_global_load_lds((const unsigned*)(g + (size_t)i * (32 * LDK * 2) + c.voffK), (LAS unsigned*)(c.lds + OFF_K + buf * KBUF + c.wid * 1024 + i * 8192), 16, 0, 0);
}
__device__ __forceinline__ void issueV(const Ctx& c, int buf, const char* g) {
#pragma unroll
  for (int i = 0; i < 4; ++i) __builtin_amdgcn_global_load_lds((const unsigned*)(g + (size_t)(i & 1) * (32 * LDK * 2) + (i >> 1) * 256 + c.voffV), (LAS unsigned*)(c.lds + OFF_V + buf * VBUF + c.wid * 1024 + i * 8192), 16, 0, 0);
}
template <bool NEAR, int SUB, int DMA = 0>
__device__ __forceinline__ void qk_sm(const Ctx& c, const LAS unsigned char* Ks, const bf16x8 (&qr)[8], float cfar, const LAS float* tabp, float& m_reg, float& l_reg, f32x16 (&o)[8], bf16x8& pa0, bf16x8& pa1,
                                      VFrag& fa, int vbp, int dbuf = 0, const char* dsrc = nullptr, int dbuf2 = 0, const char* dsrc2 = nullptr) {
  constexpr float C = att::SCALE * 1.4426950408889634f;
  f32x16 p;
  if (!NEAR) {
#pragma unroll
    for (int r = 0; r < 16; ++r) p[r] = 0.f;
  } else {
#pragma unroll
    for (int r = 0; r < 16; ++r) p[r] = tabp[32 * SUB + (r & 3) + 8 * (r >> 2)];
  }
  { const int kb = (int)(unsigned)(uintptr_t)Ks + c.r32 * 256 + ((c.hi << 4) ^ ((c.r32 & 7) << 4));
    bf16x8 ka, kbf, kc;
#define K_RD(dst, d0) asm volatile("ds_read_b128 %0, %1 offset:%2" : "=&v"(dst) : "v"(kb ^ ((d0) << 5)), "i"(SUB * 8192) : "memory")
    __builtin_amdgcn_s_setprio(1);
    K_RD(ka, 0); K_RD(kbf, 1); K_RD(kc, 2);
    A2_LWAIT(2); p = __builtin_amdgcn_mfma_f32_32x32x16_bf16(ka, qr[0], p, 0, 0, 0); __builtin_amdgcn_sched_barrier(0); K_RD(ka, 3);
    A2_LWAIT(2); p = __builtin_amdgcn_mfma_f32_32x32x16_bf16(kbf, qr[1], p, 0, 0, 0); __builtin_amdgcn_sched_barrier(0); K_RD(kbf, 4);
    A2_LWAIT(2); p = __builtin_amdgcn_mfma_f32_32x32x16_bf16(kc, qr[2], p, 0, 0, 0); __builtin_amdgcn_sched_barrier(0); K_RD(kc, 5);
    A2_LWAIT(2); p = __builtin_amdgcn_mfma_f32_32x32x16_bf16(ka, qr[3], p, 0, 0, 0); __builtin_amdgcn_sched_barrier(0); K_RD(ka, 6);
    A2_LWAIT(2); p = __builtin_amdgcn_mfma_f32_32x32x16_bf16(kbf, qr[4], p, 0, 0, 0); __builtin_amdgcn_sched_barrier(0); K_RD(kbf, 7);
    A2_LWAIT(2); p = __builtin_amdgcn_mfma_f32_32x32x16_bf16(kc, qr[5], p, 0, 0, 0); __builtin_amdgcn_sched_barrier(0);
    A2_LWAIT(1); p = __builtin_amdgcn_mfma_f32_32x32x16_bf16(ka, qr[6], p, 0, 0, 0); __builtin_amdgcn_sched_barrier(0);
    A2_LWAIT(0); p = __builtin_amdgcn_mfma_f32_32x32x16_bf16(kbf, qr[7], p, 0, 0, 0);
    __builtin_amdgcn_s_setprio(0);
#undef K_RD
  }
  if (DMA == 1) { __builtin_amdgcn_sched_barrier(0); issueK(c, dbuf, dsrc); __builtin_amdgcn_sched_barrier(0); }
  if (DMA == 3) { __builtin_amdgcn_sched_barrier(0); issueK(c, dbuf, dsrc); issueV(c, dbuf2, dsrc2); __builtin_amdgcn_sched_barrier(0); }
  if (DMA == 2) { __builtin_amdgcn_sched_barrier(0); issueV(c, dbuf, dsrc); __builtin_amdgcn_sched_barrier(0); }
  v_read<0, SUB>(fa, vbp);
  float pmax = p[0];
#pragma unroll
  for (int r = 1; r < 16; ++r) pmax = fmaxf(pmax, p[r]);
  { auto rr = __builtin_amdgcn_permlane32_swap(__float_as_uint(pmax), __float_as_uint(pmax), false, false);
    pmax = fmaxf(__uint_as_float(rr[0]), __uint_as_float(rr[1])); }
  if (!NEAR) pmax += cfar;
  float mn, alpha;
  if (__builtin_expect(__all(pmax - m_reg <= att::THR / att::SCALE), 1)) { mn = m_reg; alpha = 1.f; }
  else { mn = fmaxf(m_reg, pmax); alpha = __builtin_amdgcn_exp2f((m_reg - mn) * C); m_reg = mn;
    if (__any(alpha < 1.f)) { if (c.hi == 0) c.al_l[c.r32] = alpha; asm volatile("s_waitcnt lgkmcnt(0)" ::: "memory");
#pragma unroll
      for (int d = 0; d < 8; ++d)
#pragma unroll
        for (int r = 0; r < 16; ++r) o[d][r] *= c.al_l[crow(r, c.hi)]; } }
  const float mnC = NEAR ? -mn * C : (cfar - mn) * C;
  float ps = 0.f;
#pragma unroll
  for (int r = 0; r < 16; ++r) { p[r] = __builtin_amdgcn_exp2f(fmaf(p[r], C, mnC)); ps += p[r]; }
  { auto rr = __builtin_amdgcn_permlane32_swap(__float_as_uint(ps), __float_as_uint(ps), false, false);
    ps = __uint_as_float(rr[0]) + __uint_as_float(rr[1]); }
  l_reg = l_reg * alpha + ps;
#define PK4(P, BASE, OUT) do { unsigned a0 = cvt_pk_bf16(P[BASE + 0], P[BASE + 1]), a1 = cvt_pk_bf16(P[BASE + 2], P[BASE + 3]);   \
    unsigned b0 = cvt_pk_bf16(P[BASE + 4], P[BASE + 5]), b1 = cvt_pk_bf16(P[BASE + 6], P[BASE + 7]);                              \
    auto r0 = __builtin_amdgcn_permlane32_swap(a0, b0, false, false); auto r1 = __builtin_amdgcn_permlane32_swap(a1, b1, false, false); \
    u32x4 w = {r0[0], r1[0], r0[1], r1[1]}; OUT = *reinterpret_cast<bf16x8*>(&w); } while (0)
  PK4(p, 0, pa0); PK4(p, 8, pa1);
#undef PK4
}
template <bool NEAR, int SUB>
__device__ __forceinline__ void sub_tile(const Ctx& c, const LAS unsigned char* Ks, int vb, const bf16x8 (&qr)[8], float cfar, const LAS float* tabp, float& m_reg, float& l_reg, f32x16 (&o)[8]) {
  bf16x8 pa0, pa1; VFrag fa;
  qk_sm<NEAR, SUB>(c, Ks, qr, cfar, tabp, m_reg, l_reg, o, pa0, pa1, fa, vb);
  __builtin_amdgcn_sched_barrier(0);
  pv_all<SUB>(o, vb, pa0, pa1, fa);
}
__device__ __forceinline__ void far_run(const Ctx& c, const char* gK, const char* gV, int NT, int nleft, int nskip, float cneg, float cpos, const bf16x8 (&qr)[8], float& m_reg, float& l_reg, f32x16 (&o)[8]) {
  constexpr size_t TSTEP = (size_t)KVBLK * LDK * 2;
  const bool roleB = c.wid >= 4;
#define KT(t_) ((t_) < nleft ? (t_) : (t_) + nskip)
  issueV(c, 0, gV + (size_t)KT(0) * TSTEP); issueK(c, 0, gK + (size_t)KT(0) * TSTEP);
  bf16x8 pa0, pa1; VFrag fa;
  int vcur = 0, vprev = 0;
#pragma unroll 1
  for (int t = 0; t < NT; ++t) {
    const int t1l = (t + 1 < NT) ? t + 1 : NT - 1, t1 = KT(t1l);
    const float cfar = t < nleft ? cneg : cpos;
    const int vnext = vcur == 2 ? 0 : vcur + 1;
    const LAS unsigned char* Ks = c.lds + OFF_K + (t & 1) * KBUF;
    const int vbc = c.vb0 + vcur * VBUF;
    A2_WAIT_V(0); A2_BAR();
    if (roleB && t > 0) pv_all<1>(o, c.vb0 + vprev * VBUF, pa0, pa1, fa);
    qk_sm<false, 0, 3>(c, Ks, qr, cfar, nullptr, m_reg, l_reg, o, pa0, pa1, fa, vbc, (t + 1) & 1, gK + (size_t)t1 * TSTEP, vnext, gV + (size_t)t1 * TSTEP);
    __builtin_amdgcn_sched_barrier(0);
    pv_all<0>(o, vbc, pa0, pa1, fa);
    qk_sm<false, 1, 0>(c, Ks, qr, cfar, nullptr, m_reg, l_reg, o, pa0, pa1, fa, vbc);
    __builtin_amdgcn_sched_barrier(0);
    if (!roleB) pv_all<1>(o, vbc, pa0, pa1, fa);
    vprev = vcur; vcur = vnext;
  }
  if (roleB) pv_all<1>(o, c.vb0 + vprev * VBUF, pa0, pa1, fa);
  A2_WAIT_V(0); A2_BAR();
#undef KT
}
__device__ __forceinline__ void near_run(const Ctx& c, const char* gK, const char* gV, int NT, const LAS float* tabl, const bf16x8 (&qr)[8], float& m_reg, float& l_reg, f32x16 (&o)[8]) {
  constexpr size_t TSTEP = (size_t)KVBLK * LDK * 2;
  issueK(c, 0, gK); issueV(c, 0, gV);
#pragma unroll 1
  for (int j = 0; j < NT; ++j) {
    const int jn = (j + 1 < NT) ? j + 1 : NT - 1, b = j & 1;
    A2_WAIT_V(0); A2_BAR();
    issueK(c, b ^ 1, gK + (size_t)jn * TSTEP); issueV(c, b ^ 1, gV + (size_t)jn * TSTEP);
    sub_tile<true, 0>(c, c.lds + OFF_K + b * KBUF, c.vb0 + b * VBUF, qr, 0.f, tabl + j * KVBLK, m_reg, l_reg, o);
    sub_tile<true, 1>(c, c.lds + OFF_K + b * KBUF, c.vb0 + b * VBUF, qr, 0.f, tabl + j * KVBLK, m_reg, l_reg, o);
  }
  A2_WAIT_V(0); A2_BAR();
}
__device__ __forceinline__ void attn_body(const bf16_t* __restrict__ Qb, const bf16_t* __restrict__ Kh, const bf16_t* __restrict__ Vh, bf16_t* Ob, int seq, int q0, float lam, bool SUBTRACT, LAS unsigned char* lds,
                                          bf16_t* Dst, const float* __restrict__ sub_norm, const float* __restrict__ q_gain) {
  int tid = threadIdx.x; asm volatile("" : "+v"(tid));
  const int wid = __builtin_amdgcn_readfirstlane(tid >> 6), lane = tid & 63, r32 = lane & 31, hi = lane >> 5;
  Ctx c; c.lds = lds; c.wid = wid; c.r32 = r32; c.hi = hi;
  c.vb0 = (int)(unsigned)(uintptr_t)(lds + OFF_V) + att::v_rd_base(lane);
  c.al_l = (LAS float*)(lds + OFF_WS) + wid * 64 + 32;
  LAS float* li_l = (LAS float*)(lds + OFF_WS) + wid * 64;
  const LAS float* tab = (const LAS float*)(lds + OFF_TAB);
  { const int P = wid * 1024 + lane * 16, row = P >> 8, cb = (P & 255) ^ ((row & 7) << 4); c.voffK = (unsigned)(row * LDK * 2 + cb); }
  { const int P = wid * 1024 + lane * 16, sub = P >> 9, w = P & 511;
    const int kk = (sub >> 2) * 8 + (w >> 6), k = (kk & ~0xC) | ((kk & 4) << 1) | ((kk & 8) >> 1), col = (sub & 3) * 32 + ((w & 63) >> 1);
    c.voffV = (unsigned)(k * LDK * 2 + col * 2); }
  const int NT = seq / KVBLK;
  int jn0 = q0 / KVBLK - 2, jn1 = q0 / KVBLK + 6; jn0 = jn0 < 0 ? 0 : jn0; jn1 = jn1 > NT ? NT : jn1;
  float m_reg = -1e30f, l_reg = 0; f32x16 o[8] = {}; bf16x8 qr[8];
  const bf16_t* Qw = Qb + (long)(wid * QBLK + r32) * LDQ + hi * 8;
#pragma unroll
  for (int d0 = 0; d0 < 8; ++d0) qr[d0] = *reinterpret_cast<const bf16x8*>(Qw + d0 * 16);
  {
    float f[8][8]; float ss = 0.f;
#pragma unroll
    for (int d0 = 0; d0 < 8; ++d0) { unpack8(*reinterpret_cast<const u32x4*>(&qr[d0]), f[d0]);
#pragma unroll
      for (int e = 0; e < 8; ++e) ss += f[d0][e] * f[d0][e]; }
    { auto rr = __builtin_amdgcn_permlane32_swap(__float_as_uint(ss), __float_as_uint(ss), false, false); ss = __uint_as_float(rr[0]) + __uint_as_float(rr[1]); }
    const float rstd = rsqrtf(ss * (1.0f / 128.0f) + EPS);
#pragma unroll
    for (int d0 = 0; d0 < 8; ++d0) { const f32x4 g0 = *(const f32x4*)(q_gain + d0 * 16 + hi * 8), g1 = *(const f32x4*)(q_gain + d0 * 16 + hi * 8 + 4);
      u32x4 w; w.x = cvt_pk_bf16(f[d0][0] * rstd * g0[0], f[d0][1] * rstd * g0[1]); w.y = cvt_pk_bf16(f[d0][2] * rstd * g0[2], f[d0][3] * rstd * g0[3]);
      w.z = cvt_pk_bf16(f[d0][4] * rstd * g1[0], f[d0][5] * rstd * g1[1]); w.w = cvt_pk_bf16(f[d0][6] * rstd * g1[2], f[d0][7] * rstd * g1[3]);
      qr[d0] = *reinterpret_cast<bf16x8*>(&w); }
  }
  constexpr size_t TSTEP = (size_t)KVBLK * LDK * 2;
  { const LAS float* tabl = tab + (384 + 4 * hi - (q0 + wid * QBLK + r32 - jn0 * KVBLK));
    near_run(c, (const char*)Kh + (size_t)jn0 * TSTEP, (const char*)Vh + (size_t)jn0 * TSTEP, jn1 - jn0, tabl, qr, m_reg, l_reg, o); }
  { const float cneg = __uint_as_float(__builtin_amdgcn_readfirstlane(__float_as_uint(tab[0]))), cpos = __uint_as_float(__builtin_amdgcn_readfirstlane(__float_as_uint(tab[767])));
    const int nfar = jn0 + (NT - jn1);
    if (nfar > 0) far_run(c, (const char*)Kh, (const char*)Vh, nfar, jn0, jn1 - jn0, cneg, cpos, qr, m_reg, l_reg, o); }
  if (hi == 0) li_l[r32] = l_reg; asm volatile("s_waitcnt lgkmcnt(0)" ::: "memory");
  float rli[16];
#pragma unroll
  for (int r = 0; r < 16; ++r) rli[r] = __builtin_amdgcn_rcpf(li_l[crow(r, hi)]);
  int r32e = r32, hie = hi; asm volatile("" : "+v"(r32e), "+v"(hie));
  bf16_t* Ow = Ob + (long)(wid * QBLK) * LDQ + (4 * hie) * LDQ + r32e;
  if (SUBTRACT) {
    float g[8];
#pragma unroll
    for (int d0 = 0; d0 < 8; ++d0) g[d0] = sub_norm[d0 * 32 + r32e] * 0.8f;
    bf16_t* Dw = Dst + (long)(wid * QBLK + 4 * hie) * LDQ + r32e;
#pragma unroll
    for (int r = 0; r < 16; ++r) { float v[8]; float ss = 0.f;
#pragma unroll
      for (int d0 = 0; d0 < 8; ++d0) { v[d0] = __uint_as_float((unsigned)Ow[((r & 3) + 8 * (r >> 2)) * LDQ + d0 * 32] << 16) - lam * (o[d0][r] * rli[r]); ss += v[d0] * v[d0]; }
      ss += __shfl_xor(ss, 1); ss += __shfl_xor(ss, 2); ss += __shfl_xor(ss, 4); ss += __shfl_xor(ss, 8); ss += __shfl_xor(ss, 16);
      const float rs = rsqrtf(ss * (1.0f / 256.0f) + EPS);
#pragma unroll
      for (int d0 = 0; d0 < 8; ++d0) { const float w = v[d0] * rs * g[d0]; Dw[((r & 3) + 8 * (r >> 2)) * LDQ + d0 * 32] = (bf16_t)(cvt_pk_bf16(w, w) & 0xffffu); }
      asm volatile("" ::: "memory"); }
  } else {
#pragma unroll
    for (int r = 0; r < 16; ++r) {
#pragma unroll
      for (int d0 = 0; d0 < 8; ++d0) { const float w = o[d0][r] * rli[r]; Ow[((r & 3) + 8 * (r >> 2)) * LDQ + d0 * 32] = (bf16_t)(cvt_pk_bf16(w, w) & 0xffffu); } }
  }
  asm volatile("s_waitcnt vmcnt(0)" ::: "memory");
  __syncthreads();
}
}

__device__ void transpose_cvt(unsigned char* lds, const float* __restrict__ src, bf16_t* __restrict__ dst, int K, int N, int mode, int which, const float* __restrict__ gain = nullptr, int srcld = 0) {
    bf16_t* tile = (bf16_t*)lds;
    const int t = threadIdx.x, ntn = N / 64, ntiles = (K / 64) * ntn; if (srcld == 0) srcld = N;
    for (int tl = blockIdx.x; tl < ntiles; tl += gridDim.x) {
        const int tk = tl / ntn, tn = tl % ntn;
        const int kk = t >> 4, n4 = (t & 15) * 4;
#pragma unroll
        for (int i = 0; i < 2; ++i) { const int k = kk + 32 * i;
            f32x4 v = *(const f32x4*)(src + (size_t)(tk * 64 + k) * srcld + tn * 64 + n4);
            if (gain) v = v * gain[tk * 64 + k];
            const unsigned w0 = cvt_pk_bf16(v[0], v[1]), w1 = cvt_pk_bf16(v[2], v[3]);
            tile[(n4 + 0) * 72 + k] = (bf16_t)(w0 & 0xffff); tile[(n4 + 1) * 72 + k] = (bf16_t)(w0 >> 16);
            tile[(n4 + 2) * 72 + k] = (bf16_t)(w1 & 0xffff); tile[(n4 + 3) * 72 + k] = (bf16_t)(w1 >> 16); }
        __syncthreads();
        { const int n = t >> 3, k8 = (t & 7) * 8; const u32x4 v = *(const u32x4*)(tile + n * 72 + k8);
          const int gn = tn * 64 + n; const int drow = mode ? (gn >> 7) * 256 + which * 128 + (gn & 127) : gn;
          *(u32x4*)(dst + (size_t)drow * K + tk * 64 + k8) = v; }
        __syncthreads();
    }
}
__device__ void rmsnorm_rows(const float* __restrict__ src, const float* __restrict__ gain, bf16_t* __restrict__ dst) {
    const int lane = threadIdx.x & 63, gw = blockIdx.x * 8 + (threadIdx.x >> 6), nw = gridDim.x * 8;
    for (int row = gw; row < T; row += nw) {
        const f32x4* p = (const f32x4*)(src + (size_t)row * DM);
        f32x4 v[8]; float ss = 0.f;
#pragma unroll
        for (int j = 0; j < 8; ++j) { v[j] = p[lane + 64 * j]; ss += v[j][0] * v[j][0] + v[j][1] * v[j][1] + v[j][2] * v[j][2] + v[j][3] * v[j][3]; }
        ss = wave_sum(ss);
        const float rstd = rsqrtf(ss * (1.0f / DM) + EPS);
#pragma unroll
        for (int j = 0; j < 8; ++j) { const f32x4 g = ((const f32x4*)gain)[lane + 64 * j];
            u32x2 w; w.x = cvt_pk_bf16(v[j][0] * rstd * g[0], v[j][1] * rstd * g[1]); w.y = cvt_pk_bf16(v[j][2] * rstd * g[2], v[j][3] * rstd * g[3]);
            *(u32x2*)(dst + (size_t)row * DM + (lane + 64 * j) * 4) = w; }
    }
}
__device__ void cvt_rows(const float* __restrict__ src, bf16_t* __restrict__ dst, size_t n8) {
    for (size_t i = (size_t)blockIdx.x * 512 + threadIdx.x; i < n8; i += (size_t)gridDim.x * 512) {
        const f32x4 a = *(const f32x4*)(src + i * 8), b = *(const f32x4*)(src + i * 8 + 4);
        u32x4 w; w.x = cvt_pk_bf16(a[0], a[1]); w.y = cvt_pk_bf16(a[2], a[3]); w.z = cvt_pk_bf16(b[0], b[1]); w.w = cvt_pk_bf16(b[2], b[3]);
        *(u32x4*)(dst + i * 8) = w; }
}
__device__ void conv_pass(bf16_t* proj, const float* __restrict__ conv_w) {
    const int lane = threadIdx.x & 63, gw = blockIdx.x * 8 + (threadIdx.x >> 6), nw = gridDim.x * 8;
    for (int it = gw; it < (T / 16) * 2; it += nw) {
        const int t0 = (it >> 1) * 16, ch = (it & 1) * 512 + lane * 8;
        float w0[8], w1[8], w2[8];
#pragma unroll
        for (int e = 0; e < 8; ++e) { w0[e] = conv_w[ch + e]; w1[e] = conv_w[CW + ch + e]; w2[e] = conv_w[2 * CW + ch + e]; }
        float zp[8], zc[8], zn[8], fa[8], fc[8];
        if ((t0 % SEQ) == 0) {
#pragma unroll
            for (int e = 0; e < 8; ++e) zp[e] = 0.f;
        } else { const bf16_t* r = proj + (size_t)(t0 - 1) * INW + ch; unpack8(*(const u32x4*)r, fa);
#pragma unroll
            for (int e = 0; e < 8; ++e) zp[e] = fa[e]; }
        { const bf16_t* r = proj + (size_t)t0 * INW + ch; unpack8(*(const u32x4*)r, fa);
#pragma unroll
          for (int e = 0; e < 8; ++e) zc[e] = fa[e]; }
        for (int i = 0; i < 16; ++i) { const int t = t0 + i;
            if (((t + 1) % SEQ) == 0) {
#pragma unroll
                for (int e = 0; e < 8; ++e) zn[e] = 0.f;
            } else { const bf16_t* r = proj + (size_t)(t + 1) * INW + ch; unpack8(*(const u32x4*)r, fa);
#pragma unroll
                for (int e = 0; e < 8; ++e) zn[e] = fa[e]; }
            bf16_t* bp = proj + (size_t)t * INW + 2 * CW + ch; float fb[8]; unpack8(*(const u32x4*)bp, fb);
            float y[8];
#pragma unroll
            for (int e = 0; e < 8; ++e) y[e] = fb[e] * (w0[e] * zp[e] + w1[e] * zc[e] + w2[e] * zn[e]);
            u32x4 w; w.x = cvt_pk_bf16(y[0], y[1]); w.y = cvt_pk_bf16(y[2], y[3]); w.z = cvt_pk_bf16(y[4], y[5]); w.w = cvt_pk_bf16(y[6], y[7]);
            *(u32x4*)bp = w;
#pragma unroll
            for (int e = 0; e < 8; ++e) { zp[e] = zc[e]; zc[e] = zn[e]; }
        }
    }
}
__device__ void knorm_pass(bf16_t* proj, const float* __restrict__ qg, const float* __restrict__ kg) {
    const int lane = threadIdx.x & 63, gw = blockIdx.x * 8 + (threadIdx.x >> 6), nw = gridDim.x * 8;
    for (int t = gw; t < T; t += nw) {
        bf16_t* p = proj + (size_t)t * INW + 3 * CW;
#pragma unroll
        for (int j = 2; j < 4; ++j) { const int idx = (j * 64 + lane) * 8; float f[8]; unpack8(*(const u32x4*)(p + idx), f);
            float ss = 0.f;
#pragma unroll
            for (int e = 0; e < 8; ++e) ss += f[e] * f[e];
            ss += __shfl_xor(ss, 8); ss += __shfl_xor(ss, 4); ss += __shfl_xor(ss, 2); ss += __shfl_xor(ss, 1);
            const float rstd = rsqrtf(ss * (1.0f / 128.0f) + EPS);
            const float* g = (j < 2 ? qg : kg) + (idx & 127);
#pragma unroll
            for (int e = 0; e < 8; ++e) f[e] = f[e] * rstd * g[e];
            u32x4 w; w.x = cvt_pk_bf16(f[0], f[1]); w.y = cvt_pk_bf16(f[2], f[3]); w.z = cvt_pk_bf16(f[4], f[5]); w.w = cvt_pk_bf16(f[6], f[7]);
            *(u32x4*)(p + idx) = w; }
    }
}
__device__ void attn_post(bf16_t* proj, const float* __restrict__ sub_norm) {
    const int lane = threadIdx.x & 63, gw = blockIdx.x * 8 + (threadIdx.x >> 6), nw = gridDim.x * 8;
    const f32x4 g = ((const f32x4*)sub_norm)[lane];
    for (int t = gw; t < T; t += nw) {
        const f32x4* O = (const f32x4*)((const float*)proj + (size_t)t * (INW / 2));
        bf16_t* dst = proj + (size_t)t * INW + 3 * CW;
#pragma unroll
        for (int h = 0; h < NH; ++h) { const f32x4 v = O[h * 64 + lane];
            const float ss = wave_sum(v[0] * v[0] + v[1] * v[1] + v[2] * v[2] + v[3] * v[3]);
            const float rstd = rsqrtf(ss * (1.0f / 256.0f) + EPS) * 0.8f;
            u32x2 w; w.x = cvt_pk_bf16(v[0] * rstd * g[0], v[1] * rstd * g[1]); w.y = cvt_pk_bf16(v[2] * rstd * g[2], v[3] * rstd * g[3]);
            *(u32x2*)(dst + h * 256 + lane * 4) = w; }
    }
}
__device__ __forceinline__ int t5_bucket(int rel) {
    const int ret = rel > 0 ? 16 : 0; const int n = rel < 0 ? -rel : rel;
    if (n < 8) return ret + n;
    int large = 8 + (int)(logf((float)n * 0.125f) / 2.7725887f * 8.0f);
    large = large < 15 ? large : 15;
    return ret + large;
}

#define XB_TMO      128
#define XB_XCNT(j)  (256  + 64 * (j))
#define XB_XSUB(j)  (1280 + 64 * (j))
#define XB_XGEN(j)  (2304 + 64 * (j))
#define XB_TOP      3328
#define XB_TOPGEN   3392
#define XCD_BAR_WORDS 3456
#define XB_SPIN_CAP (1u << 18)

__device__ __forceinline__ unsigned xb_ld(unsigned* p)              { return __hip_atomic_load(p, __ATOMIC_RELAXED, __HIP_MEMORY_SCOPE_AGENT); }
__device__ __forceinline__ unsigned xb_add(unsigned* p, unsigned v) { return __hip_atomic_fetch_add(p, v, __ATOMIC_RELAXED, __HIP_MEMORY_SCOPE_AGENT); }
__device__ __forceinline__ unsigned xb_xcc_id() { return (unsigned)__builtin_amdgcn_s_getreg((3 << 11) | 20) & 0xFu; }
#define XB_SPIN(cond, bar) do { unsigned _sp = 0; while (cond) { __builtin_amdgcn_s_sleep(1); \
    if ((++_sp & 255u) == 0u) { if (xb_ld(&(bar)[XB_TMO])) break; if (_sp > XB_SPIN_CAP) { atomicAdd(&(bar)[XB_TMO], 1u); break; } } } } while (0)

struct XcdBarrier {
    unsigned* bar; unsigned x;
    volatile LAS unsigned* st;
};

__device__ __forceinline__ XcdBarrier xcd_barrier_post(unsigned* bar, volatile LAS unsigned* st) {
    XcdBarrier b; b.bar = bar; b.x = xb_xcc_id(); b.st = st;
    if (threadIdx.x == 0) (void)xb_add(&bar[XB_XCNT(b.x)], 1u);
    return b;
}
__device__ __forceinline__ void xcd_barrier_complete(unsigned* bar, unsigned x, unsigned& nloc, unsigned& nx) {
    const unsigned G = gridDim.x * gridDim.y * gridDim.z;
    unsigned sum, cnt, mine, sp = 0u;
    for (;;) {
        sum = 0u; cnt = 0u; mine = 0u;
#pragma unroll
        for (unsigned j = 0; j < 16; ++j) { const unsigned c = xb_ld(&bar[XB_XCNT(j)]); sum += c; cnt += (c > 0u) ? 1u : 0u; mine = (j == x) ? c : mine; }
        if (sum == G) break;
        __builtin_amdgcn_s_sleep(1);
        if ((++sp & 255u) == 0u) { if (xb_ld(&bar[XB_TMO])) break; if (sp > XB_SPIN_CAP) { atomicAdd(&bar[XB_TMO], 1u); break; } }
    }
    nloc = mine > 0u ? mine : 1u; nx = cnt > 0u ? cnt : 1u;
}

__device__ __forceinline__ void xcd_barrier(const XcdBarrier& b) {
    asm volatile("s_waitcnt vmcnt(0)" ::: "memory");
    __syncthreads();
    if (threadIdx.x == 0) {
        unsigned* bar = b.bar;
        __builtin_amdgcn_s_waitcnt(0);
        unsigned nloc = b.st[0], nx = b.st[1];
        if (nloc == 0u) { xcd_barrier_complete(bar, b.x, nloc, nx); b.st[0] = nloc; b.st[1] = nx; }
        const unsigned old = xb_add(&bar[XB_XSUB(b.x)], 1u);
        const unsigned gen = old / nloc;
        if (old + 1u == (gen + 1u) * nloc) {
            __builtin_amdgcn_fence(__ATOMIC_RELEASE, "agent");
            asm volatile("s_waitcnt vmcnt(0)" ::: "memory");
            const unsigned og = xb_add(&bar[XB_TOP], 1u);
            const unsigned tg = og / nx;
            if (og + 1u == (tg + 1u) * nx) xb_add(&bar[XB_TOPGEN], 1u);
            else XB_SPIN(xb_ld(&bar[XB_TOPGEN]) == tg, bar);
            __builtin_amdgcn_fence(__ATOMIC_ACQUIRE, "agent");
            xb_add(&bar[XB_XGEN(b.x)], 1u);
            asm volatile("s_waitcnt vmcnt(0)" ::: "memory");
        } else {
            XB_SPIN(xb_ld(&bar[XB_XGEN(b.x)]) == gen, bar);
            __builtin_amdgcn_fence(__ATOMIC_ACQUIRE, "agent");
            asm volatile("s_waitcnt vmcnt(0)" ::: "memory");
        }
    }
    __syncthreads();
}

__global__ void __launch_bounds__(512, 2) mega(Params P) {
    extern __shared__ __attribute__((aligned(16))) unsigned char lds[];
    cg::grid_group grid = cg::this_grid();
    LAS unsigned char* ldsl = (LAS unsigned char*)lds;
    const int G = gridDim.x, lo = P.ph_lo, hi = P.ph_hi;
    volatile LAS unsigned* xbst = (volatile LAS unsigned*)(ldsl + LDS_XB);
    if (threadIdx.x < 4) xbst[threadIdx.x] = 0u;
    __syncthreads();
    unsigned char* ws = P.ws;
    const float* x = P.in[0]; const float* pin = P.in[1];
    bf16_t* W13_1 = (bf16_t*)(ws + WS_W13_1); bf16_t* W2_1 = (bf16_t*)(ws + WS_W2_1); bf16_t* W13_2 = (bf16_t*)(ws + WS_W13_2); bf16_t* W2_2 = (bf16_t*)(ws + WS_W2_2);
    bf16_t* WIG = (bf16_t*)(ws + WS_WIG); bf16_t* WA = (bf16_t*)(ws + WS_WA); bf16_t* WB = (bf16_t*)(ws + WS_WB); bf16_t* WO = (bf16_t*)(ws + WS_WO);
    bf16_t* WPG = (bf16_t*)(ws + WS_WPG); bf16_t* WPP = (bf16_t*)(ws + WS_WPP);
    bf16_t* RA = (bf16_t*)(ws + WS_A); bf16_t* PROJ = (bf16_t*)(ws + WS_PROJ); bf16_t* GATES = (bf16_t*)(ws + WS_GATES); bf16_t* GB = (bf16_t*)(ws + WS_G);
    bf16_t* PP = (bf16_t*)(ws + WS_PP); bf16_t* P16 = (bf16_t*)(ws + WS_P16); bf16_t* RB = (bf16_t*)(ws + WS_RB);
    float* RSS1 = (float*)(ws + WS_RSS); float* RSS2 = RSS1 + T; float* RSS3 = RSS2 + T;
    float* out = P.out;
#ifndef PHASE_MASK
#define PHASE_MASK 0x1FFFF
#endif
#define IN(k) (((PHASE_MASK >> (k)) & 1) && lo <= (k) && (k) < hi)
#define SYNC(k) do { if (lo <= (k) && (k) + 1 < hi) xcd_barrier(xbar); } while (0)

    if (IN(0)) {
        for (int i = blockIdx.x * 512 + threadIdx.x; i < 3 * T; i += G * 512) RSS1[i] = 0.f;
        if (blockIdx.x == 0) for (int i = threadIdx.x; i < XCD_BAR_WORDS; i += 512) ((unsigned*)(ws + WS_XBAR))[i] = 0u;
        cvt_rows(pin, P16, (size_t)T * PLE / 8);
        transpose_cvt(lds, P.in[3], W13_1, DM, FF, 1, 0); transpose_cvt(lds, P.in[4], W13_1, DM, FF, 1, 1); transpose_cvt(lds, P.in[5], W2_1, FF, DM, 0, 0);
        transpose_cvt(lds, P.in[22], W13_2, DM, FF, 1, 0, P.in[21]); transpose_cvt(lds, P.in[23], W13_2, DM, FF, 1, 1, P.in[21]); transpose_cvt(lds, P.in[24], W2_2, FF, DM, 0, 0);
        transpose_cvt(lds, P.in[7], WIG, DM, CW, 1, 0, P.in[6], INW); transpose_cvt(lds, P.in[7] + CW, WIG, DM, CW, 1, 1, P.in[6], INW);
        transpose_cvt(lds, P.in[7] + 2 * CW, WIG + (size_t)2 * CW * DM, DM, INW - 2 * CW, 0, 0, P.in[6], INW); transpose_cvt(lds, P.in[19], WIG + (size_t)INW * DM, DM, 2 * DM, 0, 0, P.in[6]);
        transpose_cvt(lds, P.in[17], WA, CW, DM, 0, 0); transpose_cvt(lds, P.in[18], WB, AW, DM, 0, 0);
        transpose_cvt(lds, P.in[20], WO, DM, DM, 0, 0); transpose_cvt(lds, P.in[26], WPG, DM, DM, 0, 0, P.in[25]); transpose_cvt(lds, P.in[27], WPP, PLE, DM, 0, 0);
        rmsnorm_rows(x, P.in[2], RA);
    }
    if (lo <= 0 && 1 < hi) grid.sync();
    XcdBarrier xbar = xcd_barrier_post((unsigned*)(ws + WS_XBAR), xbst);
    if (IN(1)) { pg8::Gemm g{RA, W13_1, T, 2 * FF, DM, DM}; pg8::StaticOrder S; S.init(T, 2 * FF, G, (int)blockIdx.x); pg8::EpiSwiGLU E{GB, FF, nullptr}; pg8::gemm_phase(ldsl, g, S, E); }
    SYNC(1);
    if (IN(2)) { pg8::Gemm g{GB, W2_1, T, DM, FF, FF}; pg8::StaticOrder S; S.init(T, DM, G, (int)blockIdx.x); pg8::EpiRes<false> E{x, DM, 0.5f, RA, RSS1}; pg8::gemm_phase(ldsl, g, S, E); }
    SYNC(2);
    if (IN(4)) { pg8::Gemm g{RA, WIG, T, INW + 2 * DM, DM, DM}; pg8::StaticOrder S; S.init(T, INW + 2 * DM, G, (int)blockIdx.x); pg8::EpiProjGate E{PROJ, INW, GATES, 2 * DM, INW / 256, RSS1}; pg8::gemm_phase(ldsl, g, S, E); }
    SYNC(4);
    if (IN(5)) knorm_pass(PROJ, P.in[9], P.in[10]);
    SYNC(5);
    if (IN(6)) {
        LAS float* tab = (LAS float*)(ldsl + att2::OFF_TAB);
        float s1 = 0.f, s2 = 0.f;
        { const int l = threadIdx.x & 63; s1 = P.in[11][l] * P.in[12][l] + P.in[11][l + 64] * P.in[12][l + 64]; s2 = P.in[13][l] * P.in[14][l] + P.in[13][l + 64] * P.in[14][l + 64]; s1 = wave_sum(s1); s2 = wave_sum(s2); }
        const float lam = __uint_as_float(__builtin_amdgcn_readfirstlane(__float_as_uint(__expf(s1) - __expf(s2) + 0.2f)));
        for (int it = blockIdx.x; it < NB * NH * (SEQ / 256); it += G) {
            const int bh = it & 7, qb = it >> 3, b = bh >> 2, h = bh & 3, q0 = qb * 256;
            __syncthreads();
            for (int i = threadIdx.x; i < 768; i += 512) tab[i] = P.in[16][t5_bucket(i - 384) * NH + h] * (1.0f / att::SCALE);
            __syncthreads();
            const bf16_t* rowq = PROJ + (size_t)(b * SEQ + q0) * INW; const bf16_t* rowk = PROJ + (size_t)(b * SEQ) * INW;
            bf16_t* Ob = PROJ + (size_t)(b * SEQ + q0) * INW + CW + h * 256;
#pragma unroll 1
            for (int sub = 0; sub < 2; ++sub) {
                int sb = sub; asm volatile("" : "+s"(sb));
                int seqv = SEQ; asm volatile("" : "+s"(seqv));
                att2::attn_body(rowq + 3 * CW + h * 256 + sb * 128, rowk + 4 * CW + h * 256 + sb * 128, rowk + 5 * CW + h * 256, Ob, seqv, q0, lam, sb != 0, ldsl, (bf16_t*)rowq + 3 * CW + h * 256, P.in[15], P.in[9]);
            }
        }
    }
    if (IN(6)) conv_pass(PROJ, P.in[8]);
    SYNC(6);
    if (IN(8)) { pg8::Gemm g{PROJ + 2 * CW, WA, T, DM, CW, INW}; pg8::StaticOrder S; S.init(T, DM, G, (int)blockIdx.x); pg8::EpiGated<false> E{PROJ + 4 * CW, INW, GATES, 2 * DM, 0}; pg8::gemm_phase(ldsl, g, S, E); }
    if (IN(9)) { pg8::Gemm g{PROJ + 3 * CW, WB, T, DM, AW, INW}; pg8::StaticOrder S; S.init(T, DM, G, (int)blockIdx.x); pg8::EpiGated<true> E{PROJ + 4 * CW, INW, GATES, 2 * DM, DM}; pg8::gemm_phase(ldsl, g, S, E); }
    SYNC(9);
    if (IN(10)) { pg8::Gemm g{PROJ + 4 * CW, WO, T, DM, DM, INW}; pg8::StaticOrder S; S.init(T, DM, G, (int)blockIdx.x); pg8::EpiRes<true> E{RA, DM, 1.0f, RB, RSS2}; pg8::gemm_phase(ldsl, g, S, E); }
    SYNC(10);
    if (IN(12)) { pg8::Gemm g{RB, W13_2, T, 2 * FF, DM, DM}; pg8::StaticOrder S; S.init(T, 2 * FF, G, (int)blockIdx.x); pg8::EpiSwiGLU E{GB, FF, RSS2}; pg8::gemm_phase(ldsl, g, S, E); }
    SYNC(12);
    if (IN(13)) { pg8::Gemm g{GB, W2_2, T, DM, FF, FF}; pg8::StaticOrder S; S.init(T, DM, G, (int)blockIdx.x); pg8::EpiRes<true> E{RB, DM, 0.5f, RA, RSS3}; pg8::gemm_phase(ldsl, g, S, E); }
    if (IN(15)) { pg8::Gemm g{P16, WPP, T, DM, PLE, PLE}; pg8::StaticOrder S; S.init(T, DM, G, (int)blockIdx.x); pg8::EpiBf16NP E{PP, DM}; pg8::gemm_phase(ldsl, g, S, E); }
    SYNC(13);
    if (IN(16)) { pg8::Gemm g{RA, WPG, T, DM, DM, DM}; pg8::StaticOrder S; S.init(T, DM, G, (int)blockIdx.x); pg8::EpiFinal E{RA, out, DM, PP, RSS3}; pg8::gemm_phase(ldsl, g, S, E); }
#undef IN
#undef SYNC
}

extern "C" void kernel_launch(void* const* d_in, const int* in_sizes, int n_in, void* d_out, int out_size, void* d_ws, size_t ws_size, hipStream_t stream) {
    static int grid_blocks = 0;
    if (grid_blocks == 0) {
        if (n_in != 28 || in_sizes[0] != T * DM || out_size != T * DM || ws_size < WS_END) {
            fprintf(stderr, "kernel_launch: shape/workspace mismatch: n_in %d in0 %d out %d ws %zu (need %zu)\n", n_in, n_in > 0 ? in_sizes[0] : -1, out_size, ws_size, (size_t)WS_END); grid_blocks = -1; return; }
        int dev = 0, cus = 0, per_cu = 0;
        hipGetDevice(&dev); hipDeviceGetAttribute(&cus, hipDeviceAttributeMultiprocessorCount, dev);
        if (hipFuncSetAttribute((const void*)mega, hipFuncAttributeMaxDynamicSharedMemorySize, LDS_BYTES) != hipSuccess) { fprintf(stderr, "kernel_launch: hipFuncSetAttribute failed\n"); grid_blocks = -1; return; }
        if (hipOccupancyMaxActiveBlocksPerMultiprocessor(&per_cu, (const void*)mega, 512, LDS_BYTES) != hipSuccess || per_cu < 1) { fprintf(stderr, "kernel_launch: occupancy query says %d\n", per_cu); per_cu = 1; }
        (void)hipGetLastError();
        grid_blocks = cus * 1;
        if (grid_blocks % 8 != 0) grid_blocks -= grid_blocks % 8;
    }
    if (grid_blocks < 0) return;
    Params p{};
    for (int i = 0; i < 28; ++i) p.in[i] = (const float*)d_in[i];
    p.out = (float*)d_out; p.ws = (unsigned char*)d_ws; p.ph_lo = 0; p.ph_hi = 17;
    void* args[] = {&p};
    hipError_t e = hipLaunchCooperativeKernel((const void*)mega, dim3(grid_blocks), dim3(512), args, LDS_BYTES, stream);
    if (e != hipSuccess) fprintf(stderr, "cooperative launch failed: %s (grid %d)\n", hipGetErrorString(e), grid_blocks);
}
```

```cpp
#include <hip/hip_runtime.h>
#include <hip/hip_cooperative_groups.h>
#include <cstdio>
#include <cstdint>
namespace cg = cooperative_groups;

#define LAS __attribute__((address_space(3)))
typedef unsigned short bf16_t;
typedef short bf16x8 __attribute__((ext_vector_type(8)));
typedef short s16x4 __attribute__((ext_vector_type(4)));
typedef float f32x2 __attribute__((ext_vector_type(2)));
typedef float f32x4 __attribute__((ext_vector_type(4)));
typedef float f32x16 __attribute__((ext_vector_type(16)));
typedef unsigned u32x2 __attribute__((ext_vector_type(2)));
typedef unsigned u32x4 __attribute__((ext_vector_type(4)));

constexpr int DM = 2048, NB = 2, SEQ = 16384, T = NB * SEQ, FF = 5632, CW = 1024, AW = 1024, INW = 6144, PLE = 256, NH = 4;
constexpr float EPS = 1e-6f;
constexpr int LDS_XB = 2 * 16384 + 3 * 32768 + 2048 + 768 * 4;
constexpr int LDS_BYTES = LDS_XB + 16;

constexpr size_t SZ_W13 = (size_t)2 * FF * DM * 2, SZ_W2 = (size_t)DM * FF * 2;
constexpr size_t WS_W13_1 = 0, WS_W2_1 = WS_W13_1 + SZ_W13, WS_W13_2 = WS_W2_1 + SZ_W2, WS_W2_2 = WS_W13_2 + SZ_W13;
constexpr size_t WS_WIG = WS_W2_2 + SZ_W2;
constexpr size_t WS_WA = WS_WIG + (size_t)(INW + 2 * DM) * DM * 2;
constexpr size_t WS_WB = WS_WA + (size_t)DM * CW * 2;
constexpr size_t WS_WO = WS_WB + (size_t)DM * AW * 2;
constexpr size_t WS_WPG = WS_WO + (size_t)DM * DM * 2;
constexpr size_t WS_WPP = WS_WPG + (size_t)DM * DM * 2;
constexpr size_t WS_A = WS_WPP + (size_t)DM * PLE * 2;
constexpr size_t WS_BIG = WS_A + (size_t)T * DM * 2;
constexpr size_t WS_PROJ = WS_BIG;
constexpr size_t WS_GATES = WS_PROJ + (size_t)T * INW * 2;
constexpr size_t WS_G = WS_BIG;
constexpr size_t WS_PP = WS_GATES + (size_t)T * DM * 2;
constexpr size_t WS_RB = WS_GATES;
constexpr size_t WS_P16 = WS_GATES + (size_t)T * 2 * DM * 2;
constexpr size_t WS_RSS = WS_P16 + (size_t)T * PLE * 2;
constexpr size_t WS_XBAR = WS_RSS + (size_t)3 * T * 4;
constexpr size_t WS_END = WS_XBAR + 16384;

struct Params { const float* in[28]; float* out; unsigned char* ws; int ph_lo, ph_hi; };

__device__ __forceinline__ unsigned cvt_pk_bf16(float lo, float hi) { unsigned r; asm volatile("v_cvt_pk_bf16_f32 %0, %1, %2" : "=v"(r) : "v"(lo), "v"(hi)); return r; }
__device__ __forceinline__ float bf_lo(unsigned w) { return __uint_as_float(w << 16); }
__device__ __forceinline__ float bf_hi(unsigned w) { return __uint_as_float(w & 0xffff0000u); }
__device__ __forceinline__ float sigmoidf_(float x) { return __builtin_amdgcn_rcpf(1.0f + __expf(-x)); }
__device__ __forceinline__ void unpack8(const u32x4 w, float* f) { f[0] = bf_lo(w.x); f[1] = bf_hi(w.x); f[2] = bf_lo(w.y); f[3] = bf_hi(w.y); f[4] = bf_lo(w.z); f[5] = bf_hi(w.z); f[6] = bf_lo(w.w); f[7] = bf_hi(w.w); }
__device__ __forceinline__ float wave_sum(float s) {
    s += __shfl_xor(s, 32); s += __shfl_xor(s, 16); s += __shfl_xor(s, 8); s += __shfl_xor(s, 4); s += __shfl_xor(s, 2); s += __shfl_xor(s, 1); return s; }

namespace pg8 {
constexpr int BM = 256, BK = 64, HALF = 128, HTB = HALF * BK * 2, STAGE_BYTES = 8 * HTB, NXCD = 8, WGM = 8;
__device__ __forceinline__ int lds_byte(int r, int c) { const int st = (r >> 4) * 2 + (c >> 5), rr = r & 15, cc = c & 31, ob = rr * 64 + cc * 2; return st * 1024 + (ob ^ (((ob >> 9) & 1) << 5)); }
__device__ __forceinline__ void stage_rc(int b, int& R, int& C) { const int st = b / 1024, sb = b % 1024, swz = sb ^ (((sb >> 9) & 1) << 5); R = (st >> 1) * 16 + swz / 64; C = (st & 1) * 32 + (swz % 64) / 2; }
__device__ __forceinline__ int perm32(int rho) { const int n = rho >> 4, i = rho & 15; return 8 * (i >> 2) + 4 * n + (i & 3); }

struct Unit { int pm, pn; };
struct Gemm { const bf16_t* A; const bf16_t* Bt; int M, N, K, lda; };

struct StaticOrder {
    int nM, nN, nwg, G, c, wgm;
    __device__ void init(int M, int N, int G_, int c_) { nM = M / BM; nN = N / BM; nwg = nM * nN; G = G_; c = c_; wgm = nN <= 8 ? 4 : WGM; }
    __device__ bool next(int i, Unit& u) const {
        const long L = (long)i * G + c; if (L >= nwg) return false;
        int wgid = (int)L; { const int q = nwg / NXCD, r = nwg % NXCD, xcd = wgid % NXCD, off = wgid / NXCD; wgid = (xcd < r ? xcd * (q + 1) : r * (q + 1) + (xcd - r) * q) + off; }
        const int nig = wgm * nN, gid = wgid / nig, fm = gid * wgm, gsz = (nM - fm) < wgm ? (nM - fm) : wgm;
        u.pm = fm + ((wgid % nig) % gsz); u.pn = (wgid % nig) / gsz; return true;
    }
};

typedef f32x4 Acc[2][2][4][2];

struct EpiSwiGLU {
    static constexpr bool PERM = true;
    bf16_t* O; int ldc; const float* rss;
    __device__ __forceinline__ void operator()(const Acc& acc, const Unit& u, int wr, int wc, int fr, int fq) const {
        const int row0 = u.pm * BM + wr * 64 + fr, col0 = u.pn * HALF + wc * 32 + 8 * fq;
        float rsv[2][4];
#pragma unroll
        for (int ai = 0; ai < 2; ++ai)
#pragma unroll
            for (int m = 0; m < 4; ++m) rsv[ai][m] = rss ? rss[row0 + ai * HALF + m * 16] : 0.f;
#pragma unroll
        for (int ai = 0; ai < 2; ++ai)
#pragma unroll
            for (int m = 0; m < 4; ++m) {
                const int row = row0 + ai * HALF + m * 16;
                const float rs = rss ? rsqrtf(rsv[ai][m] * (1.0f / DM) + EPS) : 1.0f;
                bf16_t* rowp = O + (size_t)row * ldc + col0;
                float v[8];
#pragma unroll
                for (int n = 0; n < 2; ++n)
#pragma unroll
                    for (int j = 0; j < 4; ++j) { const float g = acc[ai][0][m][n][j] * rs, up = acc[ai][1][m][n][j] * rs; v[n * 4 + j] = g * sigmoidf_(g) * up; }
                u32x4 w; w.x = cvt_pk_bf16(v[0], v[1]); w.y = cvt_pk_bf16(v[2], v[3]); w.z = cvt_pk_bf16(v[4], v[5]); w.w = cvt_pk_bf16(v[6], v[7]);
                *(u32x4*)rowp = w;
            }
    }
};
template <bool BASE_BF16> struct EpiRes {
    static constexpr bool PERM = true;
    const void* base; int ldc; float alpha; bf16_t* obf; float* rss;
    __device__ __forceinline__ void operator()(const Acc& acc, const Unit& u, int wr, int wc, int fr, int fq) const {
        const int row0 = u.pm * BM + wr * 64 + fr, col0 = u.pn * BM + wc * 32 + 8 * fq;
#pragma unroll
        for (int ai = 0; ai < 2; ++ai) {
            u32x4 wb[4][2]; f32x4 fb0[4][2], fb1[4][2];
#pragma unroll
            for (int m = 0; m < 4; ++m) { const size_t off = (size_t)(row0 + ai * HALF + m * 16) * ldc + col0;
#pragma unroll
                for (int bj = 0; bj < 2; ++bj) {
                    if (BASE_BF16) wb[m][bj] = *(const u32x4*)((const bf16_t*)base + off + bj * HALF);
                    else { fb0[m][bj] = *(const f32x4*)((const float*)base + off + bj * HALF); fb1[m][bj] = *(const f32x4*)((const float*)base + off + bj * HALF + 4); } } }
#pragma unroll
            for (int m = 0; m < 4; ++m) { const int row = row0 + ai * HALF + m * 16; const size_t off = (size_t)row * ldc + col0; float ss = 0.f;
#pragma unroll
                for (int bj = 0; bj < 2; ++bj) {
                    f32x4 b0, b1;
                    if (BASE_BF16) { const u32x4 w = wb[m][bj]; b0 = (f32x4){bf_lo(w.x), bf_hi(w.x), bf_lo(w.y), bf_hi(w.y)}; b1 = (f32x4){bf_lo(w.z), bf_hi(w.z), bf_lo(w.w), bf_hi(w.w)}; }
                    else { b0 = fb0[m][bj]; b1 = fb1[m][bj]; }
                    const f32x4 r0 = b0 + alpha * acc[ai][bj][m][0], r1 = b1 + alpha * acc[ai][bj][m][1];
                    ss += ((r0[0] * r0[0] + r0[1] * r0[1]) + (r0[2] * r0[2] + r0[3] * r0[3])) + ((r1[0] * r1[0] + r1[1] * r1[1]) + (r1[2] * r1[2] + r1[3] * r1[3]));
                    u32x4 w; w.x = cvt_pk_bf16(r0[0], r0[1]); w.y = cvt_pk_bf16(r0[2], r0[3]); w.z = cvt_pk_bf16(r1[0], r1[1]); w.w = cvt_pk_bf16(r1[2], r1[3]);
                    *(u32x4*)(obf + off + bj * HALF) = w; }
                ss += __shfl_xor(ss, 16); ss += __shfl_xor(ss, 32);
                if (fq == 0) atomicAdd(rss + row, ss); }
            asm volatile("" ::: "memory"); }
    }
};
struct EpiProjGate {
    static constexpr bool PERM = true;
    bf16_t* O0; int ld0; bf16_t* O1; int ld1; int nsplit; const float* rss;
    __device__ __forceinline__ void operator()(const Acc& acc, const Unit& u, int wr, int wc, int fr, int fq) const {
        const bool gate = u.pn >= nsplit;
        bf16_t* base = gate ? O1 : O0; const int ldc = gate ? ld1 : ld0;
        const int row0 = u.pm * BM + wr * 64 + fr, col0 = (gate ? u.pn - nsplit : u.pn) * BM + wc * 32 + 8 * fq;
        float rsv[2][4];
#pragma unroll
        for (int ai = 0; ai < 2; ++ai)
#pragma unroll
            for (int m = 0; m < 4; ++m) rsv[ai][m] = rss[row0 + ai * HALF + m * 16];
#pragma unroll
        for (int ai = 0; ai < 2; ++ai)
#pragma unroll
            for (int m = 0; m < 4; ++m) { const int row = row0 + ai * HALF + m * 16; bf16_t* rowp = base + (size_t)row * ldc + col0;
                const float rs = rsqrtf(rsv[ai][m] * (1.0f / DM) + EPS);
                if (u.pn < 8) {
                    const float rs2 = rs * rs; const f32x4 z0 = acc[ai][0][m][0] * acc[ai][1][m][0] * rs2, z1 = acc[ai][0][m][1] * acc[ai][1][m][1] * rs2;
                    u32x4 w; w.x = cvt_pk_bf16(z0[0], z0[1]); w.y = cvt_pk_bf16(z0[2], z0[3]); w.z = cvt_pk_bf16(z1[0], z1[1]); w.w = cvt_pk_bf16(z1[2], z1[3]);
                    *(u32x4*)(O0 + (size_t)row * ld0 + u.pn * HALF + wc * 32 + 8 * fq) = w;
                    continue; }
#pragma unroll
                for (int bj = 0; bj < 2; ++bj) { f32x4 v0 = acc[ai][bj][m][0] * rs, v1 = acc[ai][bj][m][1] * rs;
                    if (gate) {
#pragma unroll
                        for (int j = 0; j < 4; ++j) { v0[j] = sigmoidf_(v0[j]); v1[j] = sigmoidf_(v1[j]); } }
                    u32x4 w; w.x = cvt_pk_bf16(v0[0], v0[1]); w.y = cvt_pk_bf16(v0[2], v0[3]); w.z = cvt_pk_bf16(v1[0], v1[1]); w.w = cvt_pk_bf16(v1[2], v1[3]);
                    *(u32x4*)(rowp + bj * HALF) = w; } }
    }
};
template <bool ADD> struct EpiGated {
    static constexpr bool PERM = true;
    bf16_t* O; int ldc; const bf16_t* gate; int ldg; int goff;
    __device__ __forceinline__ void operator()(const Acc& acc, const Unit& u, int wr, int wc, int fr, int fq) const {
        const int row0 = u.pm * BM + wr * 64 + fr, col0 = u.pn * BM + wc * 32 + 8 * fq;
#pragma unroll
        for (int ai = 0; ai < 2; ++ai) {
            u32x4 g[4][2], pv[4][2];
#pragma unroll
            for (int m = 0; m < 4; ++m) { const size_t r = (size_t)(row0 + ai * HALF + m * 16);
#pragma unroll
                for (int bj = 0; bj < 2; ++bj) { g[m][bj] = *(const u32x4*)(gate + r * ldg + goff + col0 + bj * HALF); if (ADD) pv[m][bj] = *(const u32x4*)(O + r * ldc + col0 + bj * HALF); } }
#pragma unroll
            for (int m = 0; m < 4; ++m) { const size_t r = (size_t)(row0 + ai * HALF + m * 16);
#pragma unroll
                for (int bj = 0; bj < 2; ++bj) { const f32x4 v0 = acc[ai][bj][m][0], v1 = acc[ai][bj][m][1]; const u32x4 gg = g[m][bj];
                    float o[8] = {bf_lo(gg.x) * v0[0], bf_hi(gg.x) * v0[1], bf_lo(gg.y) * v0[2], bf_hi(gg.y) * v0[3], bf_lo(gg.z) * v1[0], bf_hi(gg.z) * v1[1], bf_lo(gg.w) * v1[2], bf_hi(gg.w) * v1[3]};
                    if (ADD) { const u32x4 p = pv[m][bj];
                        o[0] += bf_lo(p.x); o[1] += bf_hi(p.x); o[2] += bf_lo(p.y); o[3] += bf_hi(p.y); o[4] += bf_lo(p.z); o[5] += bf_hi(p.z); o[6] += bf_lo(p.w); o[7] += bf_hi(p.w); }
                    u32x4 w; w.x = cvt_pk_bf16(o[0], o[1]); w.y = cvt_pk_bf16(o[2], o[3]); w.z = cvt_pk_bf16(o[4], o[5]); w.w = cvt_pk_bf16(o[6], o[7]);
                    *(u32x4*)(O + r * ldc + col0 + bj * HALF) = w; } }
            asm volatile("" ::: "memory"); }
    }
};
struct EpiBf16NP {
    static constexpr bool PERM = true;
    bf16_t* O; int ldc;
    __device__ __forceinline__ void operator()(const Acc& acc, const Unit& u, int wr, int wc, int fr, int fq) const {
        const int row0 = u.pm * BM + wr * 64 + fr, col0 = u.pn * BM + wc * 32 + 8 * fq;
#pragma unroll
        for (int ai = 0; ai < 2; ++ai)
#pragma unroll
            for (int m = 0; m < 4; ++m) { const size_t off = (size_t)(row0 + ai * HALF + m * 16) * ldc + col0;
#pragma unroll
                for (int bj = 0; bj < 2; ++bj) { const f32x4 v0 = acc[ai][bj][m][0], v1 = acc[ai][bj][m][1];
                    u32x4 w; w.x = cvt_pk_bf16(v0[0], v0[1]); w.y = cvt_pk_bf16(v0[2], v0[3]); w.z = cvt_pk_bf16(v1[0], v1[1]); w.w = cvt_pk_bf16(v1[2], v1[3]);
                    *(u32x4*)(O + off + bj * HALF) = w; } }
    }
};
struct EpiFinal {
    static constexpr bool PERM = true;
    const bf16_t* base; float* out; int ldc; const bf16_t* pp; const float* rss;
    __device__ __forceinline__ void operator()(const Acc& acc, const Unit& u, int wr, int wc, int fr, int fq) const {
        const int row0 = u.pm * BM + wr * 64 + fr, col0 = u.pn * BM + wc * 32 + 8 * fq;
        float rsv[2][4];
#pragma unroll
        for (int ai = 0; ai < 2; ++ai)
#pragma unroll
            for (int m = 0; m < 4; ++m) rsv[ai][m] = rss[row0 + ai * HALF + m * 16];
#pragma unroll
        for (int ai = 0; ai < 2; ++ai) {
            u32x4 bs[4][2], pw[4][2];
#pragma unroll
            for (int m = 0; m < 4; ++m) { const size_t off = (size_t)(row0 + ai * HALF + m * 16) * ldc + col0;
#pragma unroll
                for (int bj = 0; bj < 2; ++bj) { bs[m][bj] = *(const u32x4*)(base + off + bj * HALF); pw[m][bj] = *(const u32x4*)(pp + off + bj * HALF); } }
#pragma unroll
            for (int m = 0; m < 4; ++m) { const int row = row0 + ai * HALF + m * 16; const size_t off = (size_t)row * ldc + col0; const float rs = rsqrtf(rsv[ai][m] * (1.0f / DM) + EPS);
#pragma unroll
                for (int bj = 0; bj < 2; ++bj) { const u32x4 bw = bs[m][bj], q = pw[m][bj]; const f32x4 a0 = acc[ai][bj][m][0] * rs, a1 = acc[ai][bj][m][1] * rs;
                    f32x4 r0, r1;
                    r0[0] = bf_lo(bw.x) + sigmoidf_(a0[0]) * bf_lo(q.x); r0[1] = bf_hi(bw.x) + sigmoidf_(a0[1]) * bf_hi(q.x); r0[2] = bf_lo(bw.y) + sigmoidf_(a0[2]) * bf_lo(q.y); r0[3] = bf_hi(bw.y) + sigmoidf_(a0[3]) * bf_hi(q.y);
                    r1[0] = bf_lo(bw.z) + sigmoidf_(a1[0]) * bf_lo(q.z); r1[1] = bf_hi(bw.z) + sigmoidf_(a1[1]) * bf_hi(q.z); r1[2] = bf_lo(bw.w) + sigmoidf_(a1[2]) * bf_lo(q.w); r1[3] = bf_hi(bw.w) + sigmoidf_(a1[3]) * bf_hi(q.w);
                    *(f32x4*)(out + off + bj * HALF) = r0; *(f32x4*)(out + off + bj * HALF + 4) = r1; } }
            asm volatile("" ::: "memory"); }
    }
};

template <class Epi>
__device__ __forceinline__ void gemm_phase(LAS unsigned char* lds, const Gemm g, const StaticOrder& S, const Epi& E) {
    const int tid = threadIdx.x, wid = __builtin_amdgcn_readfirstlane(tid >> 6), lane = tid & 63, wr = wid >> 2, wc = wid & 3, fr = lane & 15, fq = lane >> 4;
    const int K = g.K, nt = K / BK, lda = g.lda;
    unsigned voffA[2], voffB[2];
#pragma unroll
    for (int i = 0; i < 2; ++i) { int R, C; stage_rc(tid * 16 + i * 8192, R, C); const int Rb = Epi::PERM ? ((R & ~31) + perm32(R & 31)) : R;
        voffA[i] = (unsigned)(R * lda + C) * 2u; voffB[i] = (unsigned)(Rb * K + C) * 2u; }
    const size_t kstep = (size_t)(BK * 2);
    const size_t hstepA = (size_t)HALF * lda * 2, hstepB = (size_t)HALF * K * 2;
    const size_t tstepA = 2 * hstepA, tstepB = 2 * hstepB;
    const unsigned ldsw = (unsigned)wid * 1024u;
    const int aoff = lds_byte(wr * 64 + fr, fq * 8), boff = lds_byte(wc * 32 + fr, fq * 8);
#define PG8_SA(b, h) (((b) * 2 + (h)) * HTB)
#define PG8_SB(b, h) ((4 + (b) * 2 + (h)) * HTB)
#define PG8_STAGE(bufoff, gbase, voff) do { _Pragma("unroll") for (int _i = 0; _i < 2; ++_i) \
        __builtin_amdgcn_global_load_lds((const unsigned*)((const char*)(gbase) + (voff)[_i]), (LAS unsigned*)(lds + (bufoff) + ldsw + _i * 8192), 16, 0, 0); } while (0)
#define PG8_LDA(dst, b, h) do { _Pragma("unroll") for (int m = 0; m < 4; ++m) _Pragma("unroll") for (int k = 0; k < 2; ++k) dst[m][k] = *(const LAS bf16x8*)(lds + PG8_SA(b, h) + aoff + m * 2048 + k * 1024); } while (0)
#define PG8_LDB(dst, b, h) do { _Pragma("unroll") for (int n = 0; n < 2; ++n) _Pragma("unroll") for (int k = 0; k < 2; ++k) dst[n][k] = *(const LAS bf16x8*)(lds + PG8_SB(b, h) + boff + n * 2048 + k * 1024); } while (0)
#define PG8_MMA(ai, bj, At, Bt) do { __builtin_amdgcn_s_setprio(1); _Pragma("unroll") for (int m = 0; m < 4; ++m) _Pragma("unroll") for (int n = 0; n < 2; ++n) _Pragma("unroll") for (int k = 0; k < 2; ++k) \
        acc[ai][bj][m][n] = __builtin_amdgcn_mfma_f32_16x16x32_bf16(Bt[n][k], At[m][k], acc[ai][bj][m][n], 0, 0, 0); __builtin_amdgcn_s_setprio(0); } while (0)
#define PG8_WAIT_V(n) asm volatile("s_waitcnt vmcnt(" #n ")" ::: "memory")
#define PG8_WAIT_L(n) asm volatile("s_waitcnt lgkmcnt(" #n ")" ::: "memory")
#define PG8_BAR __builtin_amdgcn_s_barrier()
#define PG8_SCHED __builtin_amdgcn_sched_barrier(0)
    Unit cur, nxt; int ui = 0;
    if (!S.next(0, cur)) return;
    f32x4 acc[2][2][4][2];
#pragma unroll
    for (int a = 0; a < 2; ++a)
#pragma unroll
        for (int b = 0; b < 2; ++b)
#pragma unroll
            for (int m = 0; m < 4; ++m)
#pragma unroll
                for (int n = 0; n < 2; ++n) acc[a][b][m][n] = (f32x4){0.f, 0.f, 0.f, 0.f};
    bf16x8 At[4][2], B0[2][2], B1[2][2];
    const char* cA = (const char*)g.A + (size_t)cur.pm * tstepA; const char* cB = (const char*)g.Bt + (size_t)cur.pn * tstepB;
    PG8_STAGE(PG8_SB(0, 0), cB, voffB); PG8_STAGE(PG8_SA(0, 0), cA, voffA); PG8_STAGE(PG8_SB(0, 1), cB + hstepB, voffB); PG8_STAGE(PG8_SA(0, 1), cA + hstepA, voffA);
    if (wr == 1) PG8_BAR;
    PG8_WAIT_V(4); PG8_BAR;
    PG8_STAGE(PG8_SB(1, 0), cB + kstep, voffB); PG8_STAGE(PG8_SA(1, 0), cA + kstep, voffA); PG8_STAGE(PG8_SB(1, 1), cB + hstepB + kstep, voffB);
    PG8_WAIT_V(6); PG8_BAR;
    for (;;) {
        const bool has_next = S.next(ui + 1, nxt);
        const char* nA = has_next ? (const char*)g.A + (size_t)nxt.pm * tstepA : cA; const char* nB = has_next ? (const char*)g.Bt + (size_t)nxt.pn * tstepB : cB;
        for (int t = 0; t < nt; t += 2) {
            const bool last = (t == nt - 2);
            const char* a1 = cA + (size_t)(t + 1) * kstep;
            const char* a2 = last ? nA : cA + (size_t)(t + 2) * kstep; const char* b2 = last ? nB : cB + (size_t)(t + 2) * kstep;
            const char* a3 = a2 + kstep; const char* b3 = b2 + kstep;
            PG8_LDB(B0, 0, 0); PG8_SCHED; PG8_LDA(At, 0, 0); PG8_STAGE(PG8_SA(1, 1), a1 + hstepA, voffA);
            PG8_WAIT_L(8); PG8_BAR; PG8_WAIT_L(0); PG8_MMA(0, 0, At, B0); PG8_BAR; PG8_SCHED;
            PG8_LDB(B1, 0, 1); PG8_STAGE(PG8_SB(0, 0), b2, voffB);
            PG8_BAR; PG8_WAIT_L(0); PG8_MMA(0, 1, At, B1); PG8_BAR;
            PG8_LDA(At, 0, 1); PG8_STAGE(PG8_SA(0, 0), a2, voffA);
            PG8_BAR; PG8_WAIT_L(0); PG8_MMA(1, 0, At, B0); PG8_BAR; PG8_SCHED;
            PG8_STAGE(PG8_SB(0, 1), b2 + hstepB, voffB);
            PG8_WAIT_V(6); PG8_BAR; PG8_MMA(1, 1, At, B1); PG8_BAR;
            PG8_LDB(B0, 1, 0); PG8_SCHED; PG8_LDA(At, 1, 0); PG8_STAGE(PG8_SA(0, 1), a2 + hstepA, voffA);
            PG8_WAIT_L(8); PG8_BAR; PG8_WAIT_L(0); PG8_MMA(0, 0, At, B0); PG8_BAR; PG8_SCHED;
            PG8_LDB(B1, 1, 1); PG8_STAGE(PG8_SB(1, 0), b3, voffB);
            PG8_BAR; PG8_WAIT_L(0); PG8_MMA(0, 1, At, B1); PG8_BAR;
            PG8_LDA(At, 1, 1); PG8_STAGE(PG8_SA(1, 0), a3, voffA);
            PG8_BAR; PG8_WAIT_L(0); PG8_MMA(1, 0, At, B0); PG8_BAR; PG8_SCHED;
            PG8_STAGE(PG8_SB(1, 1), b3 + hstepB, voffB);
            PG8_WAIT_V(6); PG8_BAR; PG8_MMA(1, 1, At, B1); PG8_BAR;
        }
        E(acc, cur, wr, wc, fr, fq);
        if (!has_next) break;
#pragma unroll
        for (int a = 0; a < 2; ++a)
#pragma unroll
            for (int b = 0; b < 2; ++b)
#pragma unroll
                for (int m = 0; m < 4; ++m)
#pragma unroll
                    for (int n = 0; n < 2; ++n) acc[a][b][m][n] = (f32x4){0.f, 0.f, 0.f, 0.f};
        cur = nxt; cA = nA; cB = nB; ++ui;
    }
    PG8_WAIT_V(0);
    if (wr == 0) PG8_BAR;
    PG8_BAR;
#undef PG8_SA
#undef PG8_SB
#undef PG8_STAGE
#undef PG8_LDA
#undef PG8_LDB
#undef PG8_MMA
#undef PG8_WAIT_V
#undef PG8_WAIT_L
#undef PG8_BAR
#undef PG8_SCHED
}
}

namespace att {
constexpr int D = 128, NW = 8, QBLK = 32, KVBLK = 64;
constexpr float SCALE = 0.088388347648318440f;
constexpr float THR = 8.f;
#ifndef ATT_SDEPTH
#define ATT_SDEPTH 1
#endif
constexpr int LDQ = INW, LDK = INW, LDO = INW / 2;
constexpr int SHM_V = KVBLK * D * 2, SHM_K = KVBLK * D * 2;
constexpr int OFF_WS = 2 * SHM_V + 2 * SHM_K, OFF_TAB = OFF_WS + NW * 64 * 4, SHM_ATTN = OFF_TAB + 768 * 4;
#define KSWZ(row, colB) ((row) * 256 + ((colB) ^ (((row) & 7) << 4)))
#define SBAR() __builtin_amdgcn_sched_barrier(0)
__device__ __forceinline__ int crow(int r, int hi) { return (r & 3) + 8 * (r >> 2) + 4 * hi; }

__device__ __forceinline__ void partialSM(f32x16& p0, f32x16& p1, float& m_reg, float& mn, float& alpha) {
  constexpr float C = SCALE * 1.4426950408889634f;
  float pmax = p0[0];
#pragma unroll
  for (int r = 1; r < 16; ++r) pmax = fmaxf(pmax, p0[r]);
#pragma unroll
  for (int r = 0; r < 16; ++r) pmax = fmaxf(pmax, p1[r]);
  { auto rr = __builtin_amdgcn_permlane32_swap(__float_as_uint(pmax), __float_as_uint(pmax), false, false);
    pmax = fmaxf(__uint_as_float(rr[0]), __uint_as_float(rr[1])); }
  if (__builtin_expect(__all(pmax - m_reg <= THR / SCALE), 1)) { mn = m_reg; alpha = 1.f; }
  else { mn = fmaxf(m_reg, pmax); alpha = __builtin_amdgcn_exp2f((m_reg - mn) * C); m_reg = mn; }
  float mnC = -mn * C;
#pragma unroll
  for (int r = 0; r < 16; ++r) p0[r] = fmaf(p0[r], C, mnC);
#pragma unroll
  for (int r = 0; r < 16; ++r) p1[r] = fmaf(p1[r], C, mnC);
#pragma unroll
  for (int r = 0; r < 16; ++r) p0[r] = __builtin_amdgcn_exp2f(p0[r]);
}
__device__ __forceinline__ void finishSM(f32x16& p0, f32x16& p1, float alpha, float& l_reg, bf16x8& pa0, bf16x8& pa1, bf16x8& pa2, bf16x8& pa3) {
#pragma unroll
  for (int r = 0; r < 16; ++r) p1[r] = __builtin_amdgcn_exp2f(p1[r]);
  float ps = 0;
#pragma unroll
  for (int r = 0; r < 16; ++r) ps += p0[r];
#pragma unroll
  for (int r = 0; r < 16; ++r) ps += p1[r];
  { auto rr = __builtin_amdgcn_permlane32_swap(__float_as_uint(ps), __float_as_uint(ps), false, false);
    ps = __uint_as_float(rr[0]) + __uint_as_float(rr[1]); }
  l_reg = l_reg * alpha + ps;
#define PK4(P, BASE, OUT) do { unsigned a0 = cvt_pk_bf16(P[BASE + 0], P[BASE + 1]), a1 = cvt_pk_bf16(P[BASE + 2], P[BASE + 3]);   \
    unsigned b0 = cvt_pk_bf16(P[BASE + 4], P[BASE + 5]), b1 = cvt_pk_bf16(P[BASE + 6], P[BASE + 7]);                              \
    auto r0 = __builtin_amdgcn_permlane32_swap(a0, b0, false, false); auto r1 = __builtin_amdgcn_permlane32_swap(a1, b1, false, false); \
    u32x4 w = {r0[0], r1[0], r0[1], r1[1]}; OUT = *reinterpret_cast<bf16x8*>(&w); } while (0)
  PK4(p0, 0, pa0); PK4(p0, 8, pa1); PK4(p1, 0, pa2); PK4(p1, 8, pa3);
#undef PK4
}
template <bool NEAR>
__device__ __forceinline__ void qkt(f32x16& p0, f32x16& p1, const bf16_t* Ks, const bf16x8 (&qr)[8], int r32, int hi, float cfar, const float* tabp) {
  if (!NEAR) {
#pragma unroll
    for (int r = 0; r < 16; ++r) { p0[r] = cfar; p1[r] = cfar; }
  } else {
#pragma unroll
    for (int r = 0; r < 16; ++r) { p0[r] = tabp[(r & 3) + 8 * (r >> 2)]; p1[r] = tabp[32 + (r & 3) + 8 * (r >> 2)]; }
  }
#pragma unroll
  for (int d0 = 0; d0 < 8; ++d0) { int cb = (d0 * 16 + hi * 8) * 2;
    bf16x8 b0 = *reinterpret_cast<const bf16x8*>((const char*)Ks + KSWZ(r32, cb));
    bf16x8 b1 = *reinterpret_cast<const bf16x8*>((const char*)Ks + KSWZ(32 + r32, cb));
    p0 = __builtin_amdgcn_mfma_f32_32x32x16_bf16(b0, qr[d0], p0, 0, 0, 0);
    p1 = __builtin_amdgcn_mfma_f32_32x32x16_bf16(b1, qr[d0], p1, 0, 0, 0); }
}
__device__ __forceinline__ int v_st(int k, int c) { const int kk = (k & ~0xC) | ((k & 4) << 1) | ((k & 8) >> 1); return ((kk >> 3) * 4 + (c >> 5)) * 512 + ((kk & 7) * 32 + (c & 31)) * 2; }
__device__ __forceinline__ int v_rd_base(int lane) { return ((lane & 3) << 3) | (((lane >> 2) & 3) << 6) | (((lane >> 4) & 1) << 5) | (((lane >> 5) & 1) << 8); }
constexpr int v_rd_off(int d0, int ks, int half) { return d0 * 512 + ks * 4096 + half * 2048; }
template <int OFF> __device__ __forceinline__ s16x4 tr_read(int vb) {
  s16x4 r; asm volatile("ds_read_b64_tr_b16 %0, %1 offset:%2" : "=&v"(r) : "v"(vb), "i"(OFF) : "memory"); return r;
}
template <int D0> __device__ __forceinline__ void pv_one(f32x16& od, int vb, bf16x8 pa0, bf16x8 pa1, bf16x8 pa2, bf16x8 pa3) {
  const s16x4 l0 = tr_read<v_rd_off(D0, 0, 0)>(vb), h0 = tr_read<v_rd_off(D0, 0, 1)>(vb), l1 = tr_read<v_rd_off(D0, 1, 0)>(vb), h1 = tr_read<v_rd_off(D0, 1, 1)>(vb);
  const s16x4 l2 = tr_read<v_rd_off(D0, 2, 0)>(vb), h2 = tr_read<v_rd_off(D0, 2, 1)>(vb), l3 = tr_read<v_rd_off(D0, 3, 0)>(vb), h3 = tr_read<v_rd_off(D0, 3, 1)>(vb);
  asm volatile("s_waitcnt lgkmcnt(0)" ::: "memory"); SBAR();
#define PK(L, H) (bf16x8){L[0], L[1], L[2], L[3], H[0], H[1], H[2], H[3]}
  od = __builtin_amdgcn_mfma_f32_32x32x16_bf16(pa0, PK(l0, h0), od, 0, 0, 0);
  od = __builtin_amdgcn_mfma_f32_32x32x16_bf16(pa1, PK(l1, h1), od, 0, 0, 0);
  od = __builtin_amdgcn_mfma_f32_32x32x16_bf16(pa2, PK(l2, h2), od, 0, 0, 0);
  od = __builtin_amdgcn_mfma_f32_32x32x16_bf16(pa3, PK(l3, h3), od, 0, 0, 0);
#undef PK
}
__device__ __forceinline__ void pv_d0(f32x16* o, int vb, bf16x8 pa0, bf16x8 pa1, bf16x8 pa2, bf16x8 pa3) {
  pv_one<0>(o[0], vb, pa0, pa1, pa2, pa3); pv_one<1>(o[1], vb, pa0, pa1, pa2, pa3); pv_one<2>(o[2], vb, pa0, pa1, pa2, pa3); pv_one<3>(o[3], vb, pa0, pa1, pa2, pa3);
}

template <int SDEPTH>
__device__ __forceinline__ void attn_range(const bf16_t* __restrict__ Kh, const bf16_t* __restrict__ Vh, int NT, float cfar, const bf16x8 (&qr)[8],
                                           float& m_reg, float& l_reg, f32x16 (&o)[4], char* lds, int tid, int wid, int r32, int hi) {
  bf16_t* V_lds = (bf16_t*)lds; bf16_t* K_lds = (bf16_t*)(lds + 2 * SHM_V);
  float* al_l = (float*)(lds + OFF_WS) + wid * 64 + 32;
  const int sr = tid >> 4, sc = (tid & 15) * 8, vst0 = v_st(sr, sc), vst1 = v_st(32 + sr, sc);
  const int vb0 = (int)(uintptr_t)V_lds + v_rd_base(tid & 63);
  struct { bf16x8 vs0, vs1, ks0, ks1; } sr_[SDEPTH];
#define SLOAD(i, k0) do { sr_[i].vs0 = *reinterpret_cast<const bf16x8*>(&Vh[(long)((k0) + sr) * LDK + sc]); sr_[i].vs1 = *reinterpret_cast<const bf16x8*>(&Vh[(long)((k0) + 32 + sr) * LDK + sc]); \
    sr_[i].ks0 = *reinterpret_cast<const bf16x8*>(&Kh[(long)((k0) + sr) * LDK + sc]); sr_[i].ks1 = *reinterpret_cast<const bf16x8*>(&Kh[(long)((k0) + 32 + sr) * LDK + sc]); } while (0)
#define SWRITE(b, i) do { *(bf16x8*)((char*)V_lds + (b) * SHM_V + vst0) = sr_[i].vs0;          \
    *(bf16x8*)((char*)V_lds + (b) * SHM_V + vst1) = sr_[i].vs1; int kc = sc * 2;               \
    *(bf16x8*)((char*)K_lds + (b) * SHM_K + KSWZ(sr, kc)) = sr_[i].ks0;                       \
    *(bf16x8*)((char*)K_lds + (b) * SHM_K + KSWZ(32 + sr, kc)) = sr_[i].ks1; } while (0)
#define SWAIT() do { if constexpr (SDEPTH == 2) asm volatile("s_waitcnt vmcnt(4)" ::: "memory"); else asm volatile("s_waitcnt vmcnt(0)" ::: "memory"); } while (0)
#define RESC(a) do { if (__any((a) < 1.f)) { if (hi == 0) al_l[r32] = (a); asm volatile("s_waitcnt lgkmcnt(0)" ::: "memory"); \
    _Pragma("unroll") for (int d = 0; d < 4; ++d) _Pragma("unroll") for (int r = 0; r < 16; ++r) o[d][r] *= al_l[crow(r, hi)]; } } while (0)
#define QKT(P0, P1, KB, jj) qkt<false>(P0, P1, KB, qr, r32, hi, cfar, nullptr)
  f32x16 pA0, pA1, pB0, pB1; float mnA, mnB, alA, alB; bf16x8 pa0, pa1, pa2, pa3;
  constexpr int SE = 0, SO = SDEPTH - 1;
  SLOAD(SE, 0); asm volatile("s_waitcnt vmcnt(0)" ::: "memory"); SWRITE(0, SE); __syncthreads();
  QKT(pA0, pA1, K_lds, 0); partialSM(pA0, pA1, m_reg, mnA, alA);
  SLOAD(SO, KVBLK); if constexpr (SDEPTH == 2) { if (2 < NT) SLOAD(SE, 2 * KVBLK); }
  SWAIT(); SWRITE(1, SO); __syncthreads();
  RESC(alA);
  for (int j = 1; j + 1 < NT; j += 2) {
    SBAR(); QKT(pB0, pB1, (bf16_t*)((char*)K_lds + SHM_K), j);
    finishSM(pA0, pA1, alA, l_reg, pa0, pa1, pa2, pa3); SBAR();
    SLOAD(SO, (j + SDEPTH) * KVBLK); SBAR();
    pv_d0(o, vb0, pa0, pa1, pa2, pa3); partialSM(pB0, pB1, m_reg, mnB, alB);
    __syncthreads(); SWAIT(); SWRITE(0, SE);
    RESC(alB); __syncthreads();
    SBAR(); QKT(pA0, pA1, K_lds, j + 1);
    finishSM(pB0, pB1, alB, l_reg, pa0, pa1, pa2, pa3); SBAR();
    if (SDEPTH == 1 || j + 3 < NT) SLOAD(SE, (j + 1 + SDEPTH) * KVBLK); SBAR();
    pv_d0(o, vb0 + (int)SHM_V, pa0, pa1, pa2, pa3); partialSM(pA0, pA1, m_reg, mnA, alA);
    __syncthreads(); SWAIT(); SWRITE(1, SO);
    RESC(alA); __syncthreads();
  }
  SBAR(); QKT(pB0, pB1, (bf16_t*)((char*)K_lds + SHM_K), NT - 1);
  finishSM(pA0, pA1, alA, l_reg, pa0, pa1, pa2, pa3); SBAR();
  pv_d0(o, vb0, pa0, pa1, pa2, pa3); partialSM(pB0, pB1, m_reg, mnB, alB);
  __syncthreads(); RESC(alB);
  finishSM(pB0, pB1, alB, l_reg, pa0, pa1, pa2, pa3); SBAR();
  pv_d0(o, vb0 + (int)SHM_V, pa0, pa1, pa2, pa3);
#undef SLOAD
#undef SWRITE
#undef SWAIT
#undef RESC
#undef QKT
}

__device__ __forceinline__ void attn_near(const bf16_t* __restrict__ Kh, const bf16_t* __restrict__ Vh, int NT, const float* tabl, const bf16x8 (&qr)[8],
                                          float& m_reg, float& l_reg, f32x16 (&o)[4], char* lds, int tid, int wid, int r32, int hi) {
  bf16_t* V_lds = (bf16_t*)lds; bf16_t* K_lds = (bf16_t*)(lds + 2 * SHM_V);
  float* al_l = (float*)(lds + OFF_WS) + wid * 64 + 32;
  const int sr = tid >> 4, sc = (tid & 15) * 8, vst0 = v_st(sr, sc), vst1 = v_st(32 + sr, sc);
  const int vb0 = (int)(uintptr_t)V_lds + v_rd_base(tid & 63);
#pragma unroll 1
  for (int j = 0; j < NT; ++j) {
    const long k0 = (long)j * KVBLK;
    const bf16x8 vs0 = *reinterpret_cast<const bf16x8*>(&Vh[(k0 + sr) * LDK + sc]), vs1 = *reinterpret_cast<const bf16x8*>(&Vh[(k0 + 32 + sr) * LDK + sc]);
    const bf16x8 ks0 = *reinterpret_cast<const bf16x8*>(&Kh[(k0 + sr) * LDK + sc]), ks1 = *reinterpret_cast<const bf16x8*>(&Kh[(k0 + 32 + sr) * LDK + sc]);
    __syncthreads();
    *(bf16x8*)((char*)V_lds + vst0) = vs0; *(bf16x8*)((char*)V_lds + vst1) = vs1;
    *(bf16x8*)((char*)K_lds + KSWZ(sr, sc * 2)) = ks0; *(bf16x8*)((char*)K_lds + KSWZ(32 + sr, sc * 2)) = ks1;
    __syncthreads();
    f32x16 p0, p1; float mn, al; bf16x8 pa0, pa1, pa2, pa3;
    qkt<true>(p0, p1, K_lds, qr, r32, hi, 0.f, tabl + j * KVBLK);
    partialSM(p0, p1, m_reg, mn, al);
    if (__any(al < 1.f)) { if (hi == 0) al_l[r32] = al; asm volatile("s_waitcnt lgkmcnt(0)" ::: "memory");
#pragma unroll
      for (int d = 0; d < 4; ++d)
#pragma unroll
        for (int r = 0; r < 16; ++r) o[d][r] *= al_l[crow(r, hi)]; }
    finishSM(p0, p1, al, l_reg, pa0, pa1, pa2, pa3); SBAR();
    pv_d0(o, vb0, pa0, pa1, pa2, pa3);
  }
  __syncthreads();
}

__device__ __forceinline__ void attn_body(const bf16_t* __restrict__ Qb, const bf16_t* __restrict__ Kh, const bf16_t* __restrict__ Vh, float* Ob, int seq, int q0, float lam, bool SUBTRACT, char* lds) {
  int tid = threadIdx.x; asm volatile("" : "+v"(tid));
  const int wid = __builtin_amdgcn_readfirstlane(tid >> 6), lane = tid & 63, r32 = lane & 31, hi = lane >> 5;
  float* li_l = (float*)(lds + OFF_WS) + wid * 64;
  const float* tab = (const float*)(lds + OFF_TAB);
  const int NT = seq / KVBLK;
  int jn0 = q0 / KVBLK - 2, jn1 = q0 / KVBLK + 6; jn0 = jn0 < 0 ? 0 : jn0; jn1 = jn1 > NT ? NT : jn1;
  float m_reg = -1e30f, l_reg = 0; f32x16 o[4] = {}; bf16x8 qr[8];
  const bf16_t* Qw = Qb + (long)(wid * QBLK + r32) * LDQ + hi * 8;
#pragma unroll
  for (int d0 = 0; d0 < 8; ++d0) qr[d0] = *reinterpret_cast<const bf16x8*>(Qw + d0 * 16);
  { const float* tabl = tab + (384 + 4 * hi - (q0 + wid * QBLK + r32 - jn0 * KVBLK));
    attn_near(Kh + (long)jn0 * KVBLK * LDK, Vh + (long)jn0 * KVBLK * LDK, jn1 - jn0, tabl, qr, m_reg, l_reg, o, lds, tid, wid, r32, hi); }
#pragma unroll 1
  for (int rg = 0; rg < 2; ++rg) {
    int rr = rg; asm volatile("" : "+s"(rr));
    const int ja = rr ? jn1 : 0, nt = rr ? NT - jn1 : jn0;
    const float cfar = __uint_as_float(__builtin_amdgcn_readfirstlane(__float_as_uint(tab[rr ? 767 : 0])));
    if (nt > 0) attn_range<ATT_SDEPTH>(Kh + (long)ja * KVBLK * LDK, Vh + (long)ja * KVBLK * LDK, nt, cfar, qr, m_reg, l_reg, o, lds, tid, wid, r32, hi);
  }
  if (hi == 0) li_l[r32] = l_reg; asm volatile("s_waitcnt lgkmcnt(0)" ::: "memory");
  float rli[16];
#pragma unroll
  for (int r = 0; r < 16; ++r) rli[r] = __builtin_amdgcn_rcpf(li_l[crow(r, hi)]);
  int r32e = r32, hie = hi; asm volatile("" : "+v"(r32e), "+v"(hie));
  float* Ow = Ob + (long)(wid * QBLK) * LDO + (4 * hie) * LDO + r32e;
  if (SUBTRACT) {
#pragma unroll
    for (int r = 0; r < 16; ++r) {
#pragma unroll
      for (int d0 = 0; d0 < 4; ++d0) { float* op = Ow + ((r & 3) + 8 * (r >> 2)) * LDO + d0 * 32; *op = *op - lam * (o[d0][r] * rli[r]); }
      asm volatile("" ::: "memory"); }
  } else {
#pragma unroll
    for (int r = 0; r < 16; ++r) {
#pragma unroll
      for (int d0 = 0; d0 < 4; ++d0) Ow[((r & 3) + 8 * (r >> 2)) * LDO + d0 * 32] = o[d0][r] * rli[r]; }
  }
  asm volatile("s_waitcnt vmcnt(0)" ::: "memory");
  __syncthreads();
}
}

namespace att2 {
using att::crow; using att::partialSM; using att::finishSM; using att::KVBLK; using att::QBLK; using att::LDQ; using att::LDK; using att::LDO;
constexpr int KBUF = 16384, VBUF = 32768, OFF_K = 0, OFF_V = 2 * KBUF, OFF_WS = OFF_V + 3 * VBUF, OFF_TAB = OFF_WS + 2048, SHM = OFF_TAB + 768 * 4;
#define A2_WAIT_V(n) asm volatile("s_waitcnt vmcnt(" #n ")" ::: "memory")
#define A2_BAR() do { asm volatile("" ::: "memory"); __builtin_amdgcn_s_barrier(); asm volatile("" ::: "memory"); } while (0)
template <int OFF> __device__ __forceinline__ s16x4 tr_read(int vb) {
  s16x4 r; asm volatile("ds_read_b64_tr_b16 %0, %1 offset:%2" : "=&v"(r) : "v"(vb), "i"(OFF) : "memory"); return r;
}
constexpr int v_off(int d0, int ks, int half) { return (d0 >> 2) * 16384 + (d0 & 3) * 512 + ks * 4096 + half * 2048; }
struct VFrag { s16x4 l0, h0, l1, h1; };
template <int D0, int SUB> __device__ __forceinline__ void v_read(VFrag& f, int vb) {
  f.l0 = tr_read<v_off(D0, 2 * SUB, 0)>(vb); f.h0 = tr_read<v_off(D0, 2 * SUB, 1)>(vb); f.l1 = tr_read<v_off(D0, 2 * SUB + 1, 0)>(vb); f.h1 = tr_read<v_off(D0, 2 * SUB + 1, 1)>(vb);
}
__device__ __forceinline__ void v_mma(f32x16& od, const VFrag& f, bf16x8 pa0, bf16x8 pa1) {
#define PK(L, H) (bf16x8){L[0], L[1], L[2], L[3], H[0], H[1], H[2], H[3]}
  od = __builtin_amdgcn_mfma_f32_32x32x16_bf16(pa0, PK(f.l0, f.h0), od, 0, 0, 0);
  od = __builtin_amdgcn_mfma_f32_32x32x16_bf16(pa1, PK(f.l1, f.h1), od, 0, 0, 0);
#undef PK
}
#define A2_LWAIT(n) do { asm volatile("s_waitcnt lgkmcnt(" #n ")" ::: "memory"); __builtin_amdgcn_sched_barrier(0); } while (0)
template <int SUB> __device__ __forceinline__ void pv_all(f32x16 (&o)[8], int vb, bf16x8 pa0, bf16x8 pa1, VFrag& fa) {
  VFrag fb;
  __builtin_amdgcn_s_setprio(1);
  v_read<1, SUB>(fb, vb); A2_LWAIT(4); v_mma(o[0], fa, pa0, pa1); __builtin_amdgcn_sched_barrier(0);
  v_read<2, SUB>(fa, vb); A2_LWAIT(4); v_mma(o[1], fb, pa0, pa1); __builtin_amdgcn_sched_barrier(0);
  v_read<3, SUB>(fb, vb); A2_LWAIT(4); v_mma(o[2], fa, pa0, pa1); __builtin_amdgcn_sched_barrier(0);
  v_read<4, SUB>(fa, vb); A2_LWAIT(4); v_mma(o[3], fb, pa0, pa1); __builtin_amdgcn_sched_barrier(0);
  v_read<5, SUB>(fb, vb); A2_LWAIT(4); v_mma(o[4], fa, pa0, pa1); __builtin_amdgcn_sched_barrier(0);
  v_read<6, SUB>(fa, vb); A2_LWAIT(4); v_mma(o[5], fb, pa0, pa1); __builtin_amdgcn_sched_barrier(0);
  v_read<7, SUB>(fb, vb); A2_LWAIT(4); v_mma(o[6], fa, pa0, pa1); __builtin_amdgcn_sched_barrier(0);
  A2_LWAIT(0); v_mma(o[7], fb, pa0, pa1);
  __builtin_amdgcn_s_setprio(0);
}
struct Ctx { LAS unsigned char* lds; unsigned voffK, voffV; int wid, r32, hi, vb0; LAS float* al_l; };
__device__ __forceinline__ void issueK(const Ctx& c, int buf, const char* g) {
#pragma unroll
  for (int i = 0; i < 2; ++i) __builtin_amdgcn_global_load_lds((const unsigned*)(g + (size_t)i * (32 * LDK * 2) + c.voffK), (LAS unsigned*)(c.lds + OFF_K + buf * KBUF + c.wid * 1024 + i * 8192), 16, 0, 0);
}
__device__ __forceinline__ void issueV(const Ctx& c, int buf, const char* g) {
#pragma unroll
  for (int i = 0; i < 4; ++i) __builtin_amdgcn_global_load_lds((const unsigned*)(g + (size_t)(i & 1) * (32 * LDK * 2) + (i >> 1) * 256 + c.voffV), (LAS unsigned*)(c.lds + OFF_V + buf * VBUF + c.wid * 1024 + i * 8192), 16, 0, 0);
}
template <bool NEAR, int SUB, int DMA = 0>
__device__ __forceinline__ void qk_sm(const Ctx& c, const LAS unsigned char* Ks, const bf16x8 (&qr)[8], float cfar, const LAS float* tabp, float& m_reg, float& l_reg, f32x16 (&o)[8], bf16x8& pa0, bf16x8& pa1,
                                      VFrag& fa, int vbp, int dbuf = 0, const char* dsrc = nullptr, int dbuf2 = 0, const char* dsrc2 = nullptr) {
  constexpr float C = att::SCALE * 1.4426950408889634f;
  f32x16 p;
  if (!NEAR) {
#pragma unroll
    for (int r = 0; r < 16; ++r) p[r] = 0.f;
  } else {
#pragma unroll
    for (int r = 0; r < 16; ++r) p[r] = tabp[32 * SUB + (r & 3) + 8 * (r >> 2)];
  }
  { const int kb = (int)(unsigned)(uintptr_t)Ks + c.r32 * 256 + ((c.hi << 4) ^ ((c.r32 & 7) << 4));
    bf16x8 ka, kbf, kc;
#define K_RD(dst, d0) asm volatile("ds_read_b128 %0, %1 offset:%2" : "=&v"(dst) : "v"(kb ^ ((d0) << 5)), "i"(SUB * 8192) : "memory")
    __builtin_amdgcn_s_setprio(1);
    K_RD(ka, 0); K_RD(kbf, 1); K_RD(kc, 2);
    A2_LWAIT(2); p = __builtin_amdgcn_mfma_f32_32x32x16_bf16(ka, qr[0], p, 0, 0, 0); __builtin_amdgcn_sched_barrier(0); K_RD(ka, 3);
    A2_LWAIT(2); p = __builtin_amdgcn_mfma_f32_32x32x16_bf16(kbf, qr[1], p, 0, 0, 0); __builtin_amdgcn_sched_barrier(0); K_RD(kbf, 4);
    A2_LWAIT(2); p = __builtin_amdgcn_mfma_f32_32x32x16_bf16(kc, qr[2], p, 0, 0, 0); __builtin_amdgcn_sched_barrier(0); K_RD(kc, 5);
    A2_LWAIT(2); p = __builtin_amdgcn_mfma_f32_32x32x16_bf16(ka, qr[3], p, 0, 0, 0); __builtin_amdgcn_sched_barrier(0); K_RD(ka, 6);
    A2_LWAIT(2); p = __builtin_amdgcn_mfma_f32_32x32x16_bf16(kbf, qr[4], p, 0, 0, 0); __builtin_amdgcn_sched_barrier(0); K_RD(kbf, 7);
    A2_LWAIT(2); p = __builtin_amdgcn_mfma_f32_32x32x16_bf16(kc, qr[5], p, 0, 0, 0); __builtin_amdgcn_sched_barrier(0);
    A2_LWAIT(1); p = __builtin_amdgcn_mfma_f32_32x32x16_bf16(ka, qr[6], p, 0, 0, 0); __builtin_amdgcn_sched_barrier(0);
    A2_LWAIT(0); p = __builtin_amdgcn_mfma_f32_32x32x16_bf16(kbf, qr[7], p, 0, 0, 0);
    __builtin_amdgcn_s_setprio(0);
#undef K_RD
  }
  if (DMA == 1) { __builtin_amdgcn_sched_barrier(0); issueK(c, dbuf, dsrc); __builtin_amdgcn_sched_barrier(0); }
  if (DMA == 3) { __builtin_amdgcn_sched_barrier(0); issueK(c, dbuf, dsrc); issueV(c, dbuf2, dsrc2); __builtin_amdgcn_sched_barrier(0); }
  if (DMA == 2) { __builtin_amdgcn_sched_barrier(0); issueV(c, dbuf, dsrc); __builtin_amdgcn_sched_barrier(0); }
  v_read<0, SUB>(fa, vbp);
  float pmax = p[0];
#pragma unroll
  for (int r = 1; r < 16; ++r) pmax = fmaxf(pmax, p[r]);
  { auto rr = __builtin_amdgcn_permlane32_swap(__float_as_uint(pmax), __float_as_uint(pmax), false, false);
    pmax = fmaxf(__uint_as_float(rr[0]), __uint_as_float(rr[1])); }
  if (!NEAR) pmax += cfar;
  float mn, alpha;
  if (__builtin_expect(__all(pmax - m_reg <= att::THR / att::SCALE), 1)) { mn = m_reg; alpha = 1.f; }
  else { mn = fmaxf(m_reg, pmax); alpha = __builtin_amdgcn_exp2f((m_reg - mn) * C); m_reg = mn;
    if (__any(alpha < 1.f)) { if (c.hi == 0) c.al_l[c.r32] = alpha; asm volatile("s_waitcnt lgkmcnt(0)" ::: "memory");
#pragma unroll
      for (int d = 0; d < 8; ++d)
#pragma unroll
        for (int r = 0; r < 16; ++r) o[d][r] *= c.al_l[crow(r, c.hi)]; } }
  const float mnC = NEAR ? -mn * C : (cfar - mn) * C;
  float ps = 0.f;
#pragma unroll
  for (int r = 0; r < 16; ++r) { p[r] = __builtin_amdgcn_exp2f(fmaf(p[r], C, mnC)); ps += p[r]; }
  { auto rr = __builtin_amdgcn_permlane32_swap(__float_as_uint(ps), __float_as_uint(ps), false, false);
    ps = __uint_as_float(rr[0]) + __uint_as_float(rr[1]); }
  l_reg = l_reg * alpha + ps;
#define PK4(P, BASE, OUT) do { unsigned a0 = cvt_pk_bf16(P[BASE + 0], P[BASE + 1]), a1 = cvt_pk_bf16(P[BASE + 2], P[BASE + 3]);   \
    unsigned b0 = cvt_pk_bf16(P[BASE + 4], P[BASE + 5]), b1 = cvt_pk_bf16(P[BASE + 6], P[BASE + 7]);                              \
    auto r0 = __builtin_amdgcn_permlane32_swap(a0, b0, false, false); auto r1 = __builtin_amdgcn_permlane32_swap(a1, b1, false, false); \
    u32x4 w = {r0[0], r1[0], r0[1], r1[1]}; OUT = *reinterpret_cast<bf16x8*>(&w); } while (0)
  PK4(p, 0, pa0); PK4(p, 8, pa1);
#undef PK4
}
template <bool NEAR, int SUB>
__device__ __forceinline__ void sub_tile(const Ctx& c, const LAS unsigned char* Ks, int vb, const bf16x8 (&qr)[8], float cfar, const LAS float* tabp, float& m_reg, float& l_reg, f32x16 (&o)[8]) {
  bf16x8 pa0, pa1; VFrag fa;
  qk_sm<NEAR, SUB>(c, Ks, qr, cfar, tabp, m_reg, l_reg, o, pa0, pa1, fa, vb);
  __builtin_amdgcn_sched_barrier(0);
  pv_all<SUB>(o, vb, pa0, pa1, fa);
}
__device__ __forceinline__ void far_run(const Ctx& c, const char* gK, const char* gV, int NT, int nleft, int nskip, float cneg, float cpos, const bf16x8 (&qr)[8], float& m_reg, float& l_reg, f32x16 (&o)[8]) {
  constexpr size_t TSTEP = (size_t)KVBLK * LDK * 2;
  const bool roleB = c.wid >= 4;
#define KT(t_) ((t_) < nleft ? (t_) : (t_) + nskip)
  issueV(c, 0, gV + (size_t)KT(0) * TSTEP); issueK(c, 0, gK + (size_t)KT(0) * TSTEP);
  bf16x8 pa0, pa1; VFrag fa;
  int vcur = 0, vprev = 0;
#pragma unroll 1
  for (int t = 0; t < NT; ++t) {
    const int t1l = (t + 1 < NT) ? t + 1 : NT - 1, t1 = KT(t1l);
    const float cfar = t < nleft ? cneg : cpos;
    const int vnext = vcur == 2 ? 0 : vcur + 1;
    const LAS unsigned char* Ks = c.lds + OFF_K + (t & 1) * KBUF;
    const int vbc = c.vb0 + vcur * VBUF;
    A2_WAIT_V(0); A2_BAR();
    if (roleB && t > 0) pv_all<1>(o, c.vb0 + vprev * VBUF, pa0, pa1, fa);
    qk_sm<false, 0, 3>(c, Ks, qr, cfar, nullptr, m_reg, l_reg, o, pa0, pa1, fa, vbc, (t + 1) & 1, gK + (size_t)t1 * TSTEP, vnext, gV + (size_t)t1 * TSTEP);
    __builtin_amdgcn_sched_barrier(0);
    pv_all<0>(o, vbc, pa0, pa1, fa);
    qk_sm<false, 1, 0>(c, Ks, qr, cfar, nullptr, m_reg, l_reg, o, pa0, pa1, fa, vbc);
    __builtin_amdgcn_sched_barrier(0);
    if (!roleB) pv_all<1>(o, vbc, pa0, pa1, fa);
    vprev = vcur; vcur = vnext;
  }
  if (roleB) pv_all<1>(o, c.vb0 + vprev * VBUF, pa0, pa1, fa);
  A2_WAIT_V(0); A2_BAR();
#undef KT
}
__device__ __forceinline__ void near_run(const Ctx& c, const char* gK, const char* gV, int NT, const LAS float* tabl, const bf16x8 (&qr)[8], float& m_reg, float& l_reg, f32x16 (&o)[8]) {
  constexpr size_t TSTEP = (size_t)KVBLK * LDK * 2;
  issueK(c, 0, gK); issueV(c, 0, gV);
#pragma unroll 1
  for (int j = 0; j < NT; ++j) {
    const int jn = (j + 1 < NT) ? j + 1 : NT - 1, b = j & 1;
    A2_WAIT_V(0); A2_BAR();
    issueK(c, b ^ 1, gK + (size_t)jn * TSTEP); issueV(c, b ^ 1, gV + (size_t)jn * TSTEP);
    sub_tile<true, 0>(c, c.lds + OFF_K + b * KBUF, c.vb0 + b * VBUF, qr, 0.f, tabl + j * KVBLK, m_reg, l_reg, o);
    sub_tile<true, 1>(c, c.lds + OFF_K + b * KBUF, c.vb0 + b * VBUF, qr, 0.f, tabl + j * KVBLK, m_reg, l_reg, o);
  }
  A2_WAIT_V(0); A2_BAR();
}
__device__ __forceinline__ void attn_body(const bf16_t* __restrict__ Qb, const bf16_t* __restrict__ Kh, const bf16_t* __restrict__ Vh, bf16_t* Ob, int seq, int q0, float lam, bool SUBTRACT, LAS unsigned char* lds,
                                          bf16_t* Dst, const float* __restrict__ sub_norm, const float* __restrict__ q_gain) {
  int tid = threadIdx.x; asm volatile("" : "+v"(tid));
  const int wid = __builtin_amdgcn_readfirstlane(tid >> 6), lane = tid & 63, r32 = lane & 31, hi = lane >> 5;
  Ctx c; c.lds = lds; c.wid = wid; c.r32 = r32; c.hi = hi;
  c.vb0 = (int)(unsigned)(uintptr_t)(lds + OFF_V) + att::v_rd_base(lane);
  c.al_l = (LAS float*)(lds + OFF_WS) + wid * 64 + 32;
  LAS float* li_l = (LAS float*)(lds + OFF_WS) + wid * 64;
  const LAS float* tab = (const LAS float*)(lds + OFF_TAB);
  { const int P = wid * 1024 + lane * 16, row = P >> 8, cb = (P & 255) ^ ((row & 7) << 4); c.voffK = (unsigned)(row * LDK * 2 + cb); }
  { const int P = wid * 1024 + lane * 16, sub = P >> 9, w = P & 511;
    const int kk = (sub >> 2) * 8 + (w >> 6), k = (kk & ~0xC) | ((kk & 4) << 1) | ((kk & 8) >> 1), col = (sub & 3) * 32 + ((w & 63) >> 1);
    c.voffV = (unsigned)(k * LDK * 2 + col * 2); }
  const int NT = seq / KVBLK;
  int jn0 = q0 / KVBLK - 2, jn1 = q0 / KVBLK + 6; jn0 = jn0 < 0 ? 0 : jn0; jn1 = jn1 > NT ? NT : jn1;
  float m_reg = -1e30f, l_reg = 0; f32x16 o[8] = {}; bf16x8 qr[8];
  const bf16_t* Qw = Qb + (long)(wid * QBLK + r32) * LDQ + hi * 8;
#pragma unroll
  for (int d0 = 0; d0 < 8; ++d0) qr[d0] = *reinterpret_cast<const bf16x8*>(Qw + d0 * 16);
  {
    float f[8][8]; float ss = 0.f;
#pragma unroll
    for (int d0 = 0; d0 < 8; ++d0) { unpack8(*reinterpret_cast<const u32x4*>(&qr[d0]), f[d0]);
#pragma unroll
      for (int e = 0; e < 8; ++e) ss += f[d0][e] * f[d0][e]; }
    { auto rr = __builtin_amdgcn_permlane32_swap(__float_as_uint(ss), __float_as_uint(ss), false, false); ss = __uint_as_float(rr[0]) + __uint_as_float(rr[1]); }
    const float rstd = rsqrtf(ss * (1.0f / 128.0f) + EPS);
#pragma unroll
    for (int d0 = 0; d0 < 8; ++d0) { const f32x4 g0 = *(const f32x4*)(q_gain + d0 * 16 + hi * 8), g1 = *(const f32x4*)(q_gain + d0 * 16 + hi * 8 + 4);
      u32x4 w; w.x = cvt_pk_bf16(f[d0][0] * rstd * g0[0], f[d0][1] * rstd * g0[1]); w.y = cvt_pk_bf16(f[d0][2] * rstd * g0[2], f[d0][3] * rstd * g0[3]);
      w.z = cvt_pk_bf16(f[d0][4] * rstd * g1[0], f[d0][5] * rstd * g1[1]); w.w = cvt_pk_bf16(f[d0][6] * rstd * g1[2], f[d0][7] * rstd * g1[3]);
      qr[d0] = *reinterpret_cast<bf16x8*>(&w); }
  }
  constexpr size_t TSTEP = (size_t)KVBLK * LDK * 2;
  { const LAS float* tabl = tab + (384 + 4 * hi - (q0 + wid * QBLK + r32 - jn0 * KVBLK));
    near_run(c, (const char*)Kh + (size_t)jn0 * TSTEP, (const char*)Vh + (size_t)jn0 * TSTEP, jn1 - jn0, tabl, qr, m_reg, l_reg, o); }
  { const float cneg = __uint_as_float(__builtin_amdgcn_readfirstlane(__float_as_uint(tab[0]))), cpos = __uint_as_float(__builtin_amdgcn_readfirstlane(__float_as_uint(tab[767])));
    const int nfar = jn0 + (NT - jn1);
    if (nfar > 0) far_run(c, (const char*)Kh, (const char*)Vh, nfar, jn0, jn1 - jn0, cneg, cpos, qr, m_reg, l_reg, o); }
  if (hi == 0) li_l[r32] = l_reg; asm volatile("s_waitcnt lgkmcnt(0)" ::: "memory");
  float rli[16];
#pragma unroll
  for (int r = 0; r < 16; ++r) rli[r] = __builtin_amdgcn_rcpf(li_l[crow(r, hi)]);
  int r32e = r32, hie = hi; asm volatile("" : "+v"(r32e), "+v"(hie));
  bf16_t* Ow = Ob + (long)(wid * QBLK) * LDQ + (4 * hie) * LDQ + r32e;
  if (SUBTRACT) {
    float g[8];
#pragma unroll
    for (int d0 = 0; d0 < 8; ++d0) g[d0] = sub_norm[d0 * 32 + r32e] * 0.8f;
    bf16_t* Dw = Dst + (long)(wid * QBLK + 4 * hie) * LDQ + r32e;
#pragma unroll
    for (int r = 0; r < 16; ++r) { float v[8]; float ss = 0.f;
#pragma unroll
      for (int d0 = 0; d0 < 8; ++d0) { v[d0] = __uint_as_float((unsigned)Ow[((r & 3) + 8 * (r >> 2)) * LDQ + d0 * 32] << 16) - lam * (o[d0][r] * rli[r]); ss += v[d0] * v[d0]; }
      ss += __shfl_xor(ss, 1); ss += __shfl_xor(ss, 2); ss += __shfl_xor(ss, 4); ss += __shfl_xor(ss, 8); ss += __shfl_xor(ss, 16);
      const float rs = rsqrtf(ss * (1.0f / 256.0f) + EPS);
#pragma unroll
      for (int d0 = 0; d0 < 8; ++d0) { const float w = v[d0] * rs * g[d0]; Dw[((r & 3) + 8 * (r >> 2)) * LDQ + d0 * 32] = (bf16_t)(cvt_pk_bf16(w, w) & 0xffffu); }
      asm volatile("" ::: "memory"); }
  } else {
#pragma unroll
    for (int r = 0; r < 16; ++r) {
#pragma unroll
      for (int d0 = 0; d0 < 8; ++d0) { const float w = o[d0][r] * rli[r]; Ow[((r & 3) + 8 * (r >> 2)) * LDQ + d0 * 32] = (bf16_t)(cvt_pk_bf16(w, w) & 0xffffu); } }
  }
  asm volatile("s_waitcnt vmcnt(0)" ::: "memory");
  __syncthreads();
}
}

__device__ void transpose_cvt(unsigned char* lds, const float* __restrict__ src, bf16_t* __restrict__ dst, int K, int N, int mode, int which, const float* __restrict__ gain = nullptr, int srcld = 0) {
    bf16_t* tile = (bf16_t*)lds;
    const int t = threadIdx.x, ntn = N / 64, ntiles = (K / 64) * ntn; if (srcld == 0) srcld = N;
    for (int tl = blockIdx.x; tl < ntiles; tl += gridDim.x) {
        const int tk = tl / ntn, tn = tl % ntn;
        const int kk = t >> 4, n4 = (t & 15) * 4;
#pragma unroll
        for (int i = 0; i < 2; ++i) { const int k = kk + 32 * i;
            f32x4 v = *(const f32x4*)(src + (size_t)(tk * 64 + k) * srcld + tn * 64 + n4);
            if (gain) v = v * gain[tk * 64 + k];
            const unsigned w0 = cvt_pk_bf16(v[0], v[1]), w1 = cvt_pk_bf16(v[2], v[3]);
            tile[(n4 + 0) * 72 + k] = (bf16_t)(w0 & 0xffff); tile[(n4 + 1) * 72 + k] = (bf16_t)(w0 >> 16);
            tile[(n4 + 2) * 72 + k] = (bf16_t)(w1 & 0xffff); tile[(n4 + 3) * 72 + k] = (bf16_t)(w1 >> 16); }
        __syncthreads();
        { const int n = t >> 3, k8 = (t & 7) * 8; const u32x4 v = *(const u32x4*)(tile + n * 72 + k8);
          const int gn = tn * 64 + n; const int drow = mode ? (gn >> 7) * 256 + which * 128 + (gn & 127) : gn;
          *(u32x4*)(dst + (size_t)drow * K + tk * 64 + k8) = v; }
        __syncthreads();
    }
}
__device__ void rmsnorm_rows(const float* __restrict__ src, const float* __restrict__ gain, bf16_t* __restrict__ dst) {
    const int lane = threadIdx.x & 63, gw = blockIdx.x * 8 + (threadIdx.x >> 6), nw = gridDim.x * 8;
    for (int row = gw; row < T; row += nw) {
        const f32x4* p = (const f32x4*)(src + (size_t)row * DM);
        f32x4 v[8]; float ss = 0.f;
#pragma unroll
        for (int j = 0; j < 8; ++j) { v[j] = p[lane + 64 * j]; ss += v[j][0] * v[j][0] + v[j][1] * v[j][1] + v[j][2] * v[j][2] + v[j][3] * v[j][3]; }
        ss = wave_sum(ss);
        const float rstd = rsqrtf(ss * (1.0f / DM) + EPS);
#pragma unroll
        for (int j = 0; j < 8; ++j) { const f32x4 g = ((const f32x4*)gain)[lane + 64 * j];
            u32x2 w; w.x = cvt_pk_bf16(v[j][0] * rstd * g[0], v[j][1] * rstd * g[1]); w.y = cvt_pk_bf16(v[j][2] * rstd * g[2], v[j][3] * rstd * g[3]);
            *(u32x2*)(dst + (size_t)row * DM + (lane + 64 * j) * 4) = w; }
    }
}
__device__ void cvt_rows(const float* __restrict__ src, bf16_t* __restrict__ dst, size_t n8) {
    for (size_t i = (size_t)blockIdx.x * 512 + threadIdx.x; i < n8; i += (size_t)gridDim.x * 512) {
        const f32x4 a = *(const f32x4*)(src + i * 8), b = *(const f32x4*)(src + i * 8 + 4);
        u32x4 w; w.x = cvt_pk_bf16(a[0], a[1]); w.y = cvt_pk_bf16(a[2], a[3]); w.z = cvt_pk_bf16(b[0], b[1]); w.w = cvt_pk_bf16(b[2], b[3]);
        *(u32x4*)(dst + i * 8) = w; }
}
__device__ void conv_pass(bf16_t* proj, const float* __restrict__ conv_w) {
    const int lane = threadIdx.x & 63, gw = blockIdx.x * 8 + (threadIdx.x >> 6), nw = gridDim.x * 8;
    for (int it = gw; it < (T / 16) * 2; it += nw) {
        const int t0 = (it >> 1) * 16, ch = (it & 1) * 512 + lane * 8;
        float w0[8], w1[8], w2[8];
#pragma unroll
        for (int e = 0; e < 8; ++e) { w0[e] = conv_w[ch + e]; w1[e] = conv_w[CW + ch + e]; w2[e] = conv_w[2 * CW + ch + e]; }
        float zp[8], zc[8], zn[8], fa[8], fc[8];
        if ((t0 % SEQ) == 0) {
#pragma unroll
            for (int e = 0; e < 8; ++e) zp[e] = 0.f;
        } else { const bf16_t* r = proj + (size_t)(t0 - 1) * INW + ch; unpack8(*(const u32x4*)r, fa);
#pragma unroll
            for (int e = 0; e < 8; ++e) zp[e] = fa[e]; }
        { const bf16_t* r = proj + (size_t)t0 * INW + ch; unpack8(*(const u32x4*)r, fa);
#pragma unroll
          for (int e = 0; e < 8; ++e) zc[e] = fa[e]; }
        for (int i = 0; i < 16; i += 4) {
            u32x4 zw[4], bw[4]; bool zz[4];
#pragma unroll
            for (int k = 0; k < 4; ++k) { const int tt = t0 + i + k + 1; zz[k] = (tt % SEQ) == 0;
                zw[k] = zz[k] ? (u32x4){0u, 0u, 0u, 0u} : *(const u32x4*)(proj + (size_t)tt * INW + ch);
                bw[k] = *(const u32x4*)(proj + (size_t)(t0 + i + k) * INW + 2 * CW + ch); }
#pragma unroll
            for (int k = 0; k < 4; ++k) { const int t = t0 + i + k;
                unpack8(zw[k], zn); float fb[8]; unpack8(bw[k], fb);
                float y[8];
#pragma unroll
                for (int e = 0; e < 8; ++e) y[e] = fb[e] * (w0[e] * zp[e] + w1[e] * zc[e] + w2[e] * zn[e]);
                u32x4 w; w.x = cvt_pk_bf16(y[0], y[1]); w.y = cvt_pk_bf16(y[2], y[3]); w.z = cvt_pk_bf16(y[4], y[5]); w.w = cvt_pk_bf16(y[6], y[7]);
                *(u32x4*)(proj + (size_t)t * INW + 2 * CW + ch) = w;
#pragma unroll
                for (int e = 0; e < 8; ++e) { zp[e] = zc[e]; zc[e] = zn[e]; } }
        }
    }
}
__device__ void knorm_pass(bf16_t* proj, const float* __restrict__ qg, const float* __restrict__ kg) {
    const int lane = threadIdx.x & 63, gw = blockIdx.x * 8 + (threadIdx.x >> 6), nw = gridDim.x * 8;
    for (int t = gw; t < T; t += nw) {
        bf16_t* p = proj + (size_t)t * INW + 3 * CW;
#pragma unroll
        for (int j = 2; j < 4; ++j) { const int idx = (j * 64 + lane) * 8; float f[8]; unpack8(*(const u32x4*)(p + idx), f);
            float ss = 0.f;
#pragma unroll
            for (int e = 0; e < 8; ++e) ss += f[e] * f[e];
            ss += __shfl_xor(ss, 8); ss += __shfl_xor(ss, 4); ss += __shfl_xor(ss, 2); ss += __shfl_xor(ss, 1);
            const float rstd = rsqrtf(ss * (1.0f / 128.0f) + EPS);
            const float* g = (j < 2 ? qg : kg) + (idx & 127);
#pragma unroll
            for (int e = 0; e < 8; ++e) f[e] = f[e] * rstd * g[e];
            u32x4 w; w.x = cvt_pk_bf16(f[0], f[1]); w.y = cvt_pk_bf16(f[2], f[3]); w.z = cvt_pk_bf16(f[4], f[5]); w.w = cvt_pk_bf16(f[6], f[7]);
            *(u32x4*)(p + idx) = w; }
    }
}
__device__ void attn_post(bf16_t* proj, const float* __restrict__ sub_norm) {
    const int lane = threadIdx.x & 63, gw = blockIdx.x * 8 + (threadIdx.x >> 6), nw = gridDim.x * 8;
    const f32x4 g = ((const f32x4*)sub_norm)[lane];
    for (int t = gw; t < T; t += nw) {
        const f32x4* O = (const f32x4*)((const float*)proj + (size_t)t * (INW / 2));
        bf16_t* dst = proj + (size_t)t * INW + 3 * CW;
#pragma unroll
        for (int h = 0; h < NH; ++h) { const f32x4 v = O[h * 64 + lane];
            const float ss = wave_sum(v[0] * v[0] + v[1] * v[1] + v[2] * v[2] + v[3] * v[3]);
            const float rstd = rsqrtf(ss * (1.0f / 256.0f) + EPS) * 0.8f;
            u32x2 w; w.x = cvt_pk_bf16(v[0] * rstd * g[0], v[1] * rstd * g[1]); w.y = cvt_pk_bf16(v[2] * rstd * g[2], v[3] * rstd * g[3]);
            *(u32x2*)(dst + h * 256 + lane * 4) = w; }
    }
}
__device__ __forceinline__ int t5_bucket(int rel) {
    const int ret = rel > 0 ? 16 : 0; const int n = rel < 0 ? -rel : rel;
    if (n < 8) return ret + n;
    int large = 8 + (int)(logf((float)n * 0.125f) / 2.7725887f * 8.0f);
    large = large < 15 ? large : 15;
    return ret + large;
}

#define XB_TMO      128
#define XB_XCNT(j)  (256  + 64 * (j))
#define XB_XSUB(j)  (1280 + 64 * (j))
#define XB_XGEN(j)  (2304 + 64 * (j))
#define XB_TOP      3328
#define XB_TOPGEN   3392
#define XCD_BAR_WORDS 3456
#define XB_SPIN_CAP (1u << 18)

__device__ __forceinline__ unsigned xb_ld(unsigned* p)              { return __hip_atomic_load(p, __ATOMIC_RELAXED, __HIP_MEMORY_SCOPE_AGENT); }
__device__ __forceinline__ unsigned xb_add(unsigned* p, unsigned v) { return __hip_atomic_fetch_add(p, v, __ATOMIC_RELAXED, __HIP_MEMORY_SCOPE_AGENT); }
__device__ __forceinline__ unsigned xb_xcc_id() { return (unsigned)__builtin_amdgcn_s_getreg((3 << 11) | 20) & 0xFu; }
#define XB_SPIN(cond, bar) do { unsigned _sp = 0; while (cond) { __builtin_amdgcn_s_sleep(1); \
    if ((++_sp & 255u) == 0u) { if (xb_ld(&(bar)[XB_TMO])) break; if (_sp > XB_SPIN_CAP) { atomicAdd(&(bar)[XB_TMO], 1u); break; } } } } while (0)

struct XcdBarrier {
    unsigned* bar; unsigned x;
    volatile LAS unsigned* st;
};

__device__ __forceinline__ XcdBarrier xcd_barrier_post(unsigned* bar, volatile LAS unsigned* st) {
    XcdBarrier b; b.bar = bar; b.x = xb_xcc_id(); b.st = st;
    if (threadIdx.x == 0) (void)xb_add(&bar[XB_XCNT(b.x)], 1u);
    return b;
}
__device__ __forceinline__ void xcd_barrier_complete(unsigned* bar, unsigned x, unsigned& nloc, unsigned& nx) {
    const unsigned G = gridDim.x * gridDim.y * gridDim.z;
    unsigned sum, cnt, mine, sp = 0u;
    for (;;) {
        sum = 0u; cnt = 0u; mine = 0u;
#pragma unroll
        for (unsigned j = 0; j < 16; ++j) { const unsigned c = xb_ld(&bar[XB_XCNT(j)]); sum += c; cnt += (c > 0u) ? 1u : 0u; mine = (j == x) ? c : mine; }
        if (sum == G) break;
        __builtin_amdgcn_s_sleep(1);
        if ((++sp & 255u) == 0u) { if (xb_ld(&bar[XB_TMO])) break; if (sp > XB_SPIN_CAP) { atomicAdd(&bar[XB_TMO], 1u); break; } }
    }
    nloc = mine > 0u ? mine : 1u; nx = cnt > 0u ? cnt : 1u;
}

__device__ __forceinline__ void xcd_barrier(const XcdBarrier& b) {
    asm volatile("s_waitcnt vmcnt(0)" ::: "memory");
    __syncthreads();
    if (threadIdx.x == 0) {
        unsigned* bar = b.bar;
        __builtin_amdgcn_s_waitcnt(0);
        unsigned nloc = b.st[0], nx = b.st[1];
        if (nloc == 0u) { xcd_barrier_complete(bar, b.x, nloc, nx); b.st[0] = nloc; b.st[1] = nx; }
        const unsigned old = xb_add(&bar[XB_XSUB(b.x)], 1u);
        const unsigned gen = old / nloc;
        if (old + 1u == (gen + 1u) * nloc) {
            __builtin_amdgcn_fence(__ATOMIC_RELEASE, "agent");
            asm volatile("s_waitcnt vmcnt(0)" ::: "memory");
            const unsigned og = xb_add(&bar[XB_TOP], 1u);
            const unsigned tg = og / nx;
            if (og + 1u == (tg + 1u) * nx) xb_add(&bar[XB_TOPGEN], 1u);
            else XB_SPIN(xb_ld(&bar[XB_TOPGEN]) == tg, bar);
            __builtin_amdgcn_fence(__ATOMIC_ACQUIRE, "agent");
            xb_add(&bar[XB_XGEN(b.x)], 1u);
            asm volatile("s_waitcnt vmcnt(0)" ::: "memory");
        } else {
            XB_SPIN(xb_ld(&bar[XB_XGEN(b.x)]) == gen, bar);
            __builtin_amdgcn_fence(__ATOMIC_ACQUIRE, "agent");
            asm volatile("s_waitcnt vmcnt(0)" ::: "memory");
        }
    }
    __syncthreads();
}

__global__ void __launch_bounds__(512, 2) mega(Params P) {
    extern __shared__ __attribute__((aligned(16))) unsigned char lds[];
    cg::grid_group grid = cg::this_grid();
    LAS unsigned char* ldsl = (LAS unsigned char*)lds;
    const int G = gridDim.x, lo = P.ph_lo, hi = P.ph_hi;
    volatile LAS unsigned* xbst = (volatile LAS unsigned*)(ldsl + LDS_XB);
    if (threadIdx.x < 4) xbst[threadIdx.x] = 0u;
    __syncthreads();
    unsigned char* ws = P.ws;
    const float* x = P.in[0]; const float* pin = P.in[1];
    bf16_t* W13_1 = (bf16_t*)(ws + WS_W13_1); bf16_t* W2_1 = (bf16_t*)(ws + WS_W2_1); bf16_t* W13_2 = (bf16_t*)(ws + WS_W13_2); bf16_t* W2_2 = (bf16_t*)(ws + WS_W2_2);
    bf16_t* WIG = (bf16_t*)(ws + WS_WIG); bf16_t* WA = (bf16_t*)(ws + WS_WA); bf16_t* WB = (bf16_t*)(ws + WS_WB); bf16_t* WO = (bf16_t*)(ws + WS_WO);
    bf16_t* WPG = (bf16_t*)(ws + WS_WPG); bf16_t* WPP = (bf16_t*)(ws + WS_WPP);
    bf16_t* RA = (bf16_t*)(ws + WS_A); bf16_t* PROJ = (bf16_t*)(ws + WS_PROJ); bf16_t* GATES = (bf16_t*)(ws + WS_GATES); bf16_t* GB = (bf16_t*)(ws + WS_G);
    bf16_t* PP = (bf16_t*)(ws + WS_PP); bf16_t* P16 = (bf16_t*)(ws + WS_P16); bf16_t* RB = (bf16_t*)(ws + WS_RB);
    float* RSS1 = (float*)(ws + WS_RSS); float* RSS2 = RSS1 + T; float* RSS3 = RSS2 + T;
    float* out = P.out;
#ifndef PHASE_MASK
#define PHASE_MASK 0x1FFFF
#endif
#define IN(k) (((PHASE_MASK >> (k)) & 1) && lo <= (k) && (k) < hi)
#define SYNC(k) do { if (lo <= (k) && (k) + 1 < hi) xcd_barrier(xbar); } while (0)

    if (IN(0)) {
        for (int i = blockIdx.x * 512 + threadIdx.x; i < 3 * T; i += G * 512) RSS1[i] = 0.f;
        if (blockIdx.x == 0) for (int i = threadIdx.x; i < XCD_BAR_WORDS; i += 512) ((unsigned*)(ws + WS_XBAR))[i] = 0u;
        cvt_rows(pin, P16, (size_t)T * PLE / 8);
        transpose_cvt(lds, P.in[3], W13_1, DM, FF, 1, 0); transpose_cvt(lds, P.in[4], W13_1, DM, FF, 1, 1); transpose_cvt(lds, P.in[5], W2_1, FF, DM, 0, 0);
        transpose_cvt(lds, P.in[22], W13_2, DM, FF, 1, 0, P.in[21]); transpose_cvt(lds, P.in[23], W13_2, DM, FF, 1, 1, P.in[21]); transpose_cvt(lds, P.in[24], W2_2, FF, DM, 0, 0);
        transpose_cvt(lds, P.in[7], WIG, DM, CW, 1, 0, P.in[6], INW); transpose_cvt(lds, P.in[7] + CW, WIG, DM, CW, 1, 1, P.in[6], INW);
        transpose_cvt(lds, P.in[7] + 2 * CW, WIG + (size_t)2 * CW * DM, DM, INW - 2 * CW, 0, 0, P.in[6], INW); transpose_cvt(lds, P.in[19], WIG + (size_t)INW * DM, DM, 2 * DM, 0, 0, P.in[6]);
        transpose_cvt(lds, P.in[17], WA, CW, DM, 0, 0); transpose_cvt(lds, P.in[18], WB, AW, DM, 0, 0);
        transpose_cvt(lds, P.in[20], WO, DM, DM, 0, 0); transpose_cvt(lds, P.in[26], WPG, DM, DM, 0, 0, P.in[25]); transpose_cvt(lds, P.in[27], WPP, PLE, DM, 0, 0);
        rmsnorm_rows(x, P.in[2], RA);
    }
    if (lo <= 0 && 1 < hi) grid.sync();
    XcdBarrier xbar = xcd_barrier_post((unsigned*)(ws + WS_XBAR), xbst);
    if (IN(1)) { pg8::Gemm g{RA, W13_1, T, 2 * FF, DM, DM}; pg8::StaticOrder S; S.init(T, 2 * FF, G, (int)blockIdx.x); pg8::EpiSwiGLU E{GB, FF, nullptr}; pg8::gemm_phase(ldsl, g, S, E); }
    SYNC(1);
    if (IN(2)) { pg8::Gemm g{GB, W2_1, T, DM, FF, FF}; pg8::StaticOrder S; S.init(T, DM, G, (int)blockIdx.x); pg8::EpiRes<false> E{x, DM, 0.5f, RA, RSS1}; pg8::gemm_phase(ldsl, g, S, E); }
    SYNC(2);
    if (IN(4)) { pg8::Gemm g{RA, WIG, T, INW + 2 * DM, DM, DM}; pg8::StaticOrder S; S.init(T, INW + 2 * DM, G, (int)blockIdx.x); pg8::EpiProjGate E{PROJ, INW, GATES, 2 * DM, INW / 256, RSS1}; pg8::gemm_phase(ldsl, g, S, E); }
    SYNC(4);
    if (IN(5)) knorm_pass(PROJ, P.in[9], P.in[10]);
    SYNC(5);
    if (IN(6)) {
        LAS float* tab = (LAS float*)(ldsl + att2::OFF_TAB);
        float s1 = 0.f, s2 = 0.f;
        { const int l = threadIdx.x & 63; s1 = P.in[11][l] * P.in[12][l] + P.in[11][l + 64] * P.in[12][l + 64]; s2 = P.in[13][l] * P.in[14][l] + P.in[13][l + 64] * P.in[14][l + 64]; s1 = wave_sum(s1); s2 = wave_sum(s2); }
        const float lam = __uint_as_float(__builtin_amdgcn_readfirstlane(__float_as_uint(__expf(s1) - __expf(s2) + 0.2f)));
        for (int it = blockIdx.x; it < NB * NH * (SEQ / 256); it += G) {
            const int bh = it & 7, qb = it >> 3, b = bh >> 2, h = bh & 3, q0 = qb * 256;
            __syncthreads();
            for (int i = threadIdx.x; i < 768; i += 512) tab[i] = P.in[16][t5_bucket(i - 384) * NH + h] * (1.0f / att::SCALE);
            __syncthreads();
            const bf16_t* rowq = PROJ + (size_t)(b * SEQ + q0) * INW; const bf16_t* rowk = PROJ + (size_t)(b * SEQ) * INW;
            bf16_t* Ob = PROJ + (size_t)(b * SEQ + q0) * INW + CW + h * 256;
#pragma unroll 1
            for (int sub = 0; sub < 2; ++sub) {
                int sb = sub; asm volatile("" : "+s"(sb));
                int seqv = SEQ; asm volatile("" : "+s"(seqv));
                att2::attn_body(rowq + 3 * CW + h * 256 + sb * 128, rowk + 4 * CW + h * 256 + sb * 128, rowk + 5 * CW + h * 256, Ob, seqv, q0, lam, sb != 0, ldsl, (bf16_t*)rowq + 3 * CW + h * 256, P.in[15], P.in[9]);
            }
        }
    }
    if (IN(6)) conv_pass(PROJ, P.in[8]);
    SYNC(6);
    if (IN(8)) { pg8::Gemm g{PROJ + 2 * CW, WA, T, DM, CW, INW}; pg8::StaticOrder S; S.init(T, DM, G, (int)blockIdx.x); pg8::EpiGated<false> E{PROJ + 4 * CW, INW, GATES, 2 * DM, 0}; pg8::gemm_phase(ldsl, g, S, E); }
    if (IN(9)) { pg8::Gemm g{PROJ + 3 * CW, WB, T, DM, AW, INW}; pg8::StaticOrder S; S.init(T, DM, G, (int)blockIdx.x); pg8::EpiGated<true> E{PROJ + 4 * CW, INW, GATES, 2 * DM, DM}; pg8::gemm_phase(ldsl, g, S, E); }
    SYNC(9);
    if (IN(10)) { pg8::Gemm g{PROJ + 4 * CW, WO, T, DM, DM, INW}; pg8::StaticOrder S; S.init(T, DM, G, (int)blockIdx.x); pg8::EpiRes<true> E{RA, DM, 1.0f, RB, RSS2}; pg8::gemm_phase(ldsl, g, S, E); }
    SYNC(10);
    if (IN(12)) { pg8::Gemm g{RB, W13_2, T, 2 * FF, DM, DM}; pg8::StaticOrder S; S.init(T, 2 * FF, G, (int)blockIdx.x); pg8::EpiSwiGLU E{GB, FF, RSS2}; pg8::gemm_phase(ldsl, g, S, E); }
    SYNC(12);
    if (IN(13)) { pg8::Gemm g{GB, W2_2, T, DM, FF, FF}; pg8::StaticOrder S; S.init(T, DM, G, (int)blockIdx.x); pg8::EpiRes<true> E{RB, DM, 0.5f, RA, RSS3}; pg8::gemm_phase(ldsl, g, S, E); }
    if (IN(15)) { pg8::Gemm g{P16, WPP, T, DM, PLE, PLE}; pg8::StaticOrder S; S.init(T, DM, G, (int)blockIdx.x); pg8::EpiBf16NP E{PP, DM}; pg8::gemm_phase(ldsl, g, S, E); }
    SYNC(13);
    if (IN(16)) { pg8::Gemm g{RA, WPG, T, DM, DM, DM}; pg8::StaticOrder S; S.init(T, DM, G, (int)blockIdx.x); pg8::EpiFinal E{RA, out, DM, PP, RSS3}; pg8::gemm_phase(ldsl, g, S, E); }
#undef IN
#undef SYNC
}

extern "C" void kernel_launch(void* const* d_in, const int* in_sizes, int n_in, void* d_out, int out_size, void* d_ws, size_t ws_size, hipStream_t stream) {
    static int grid_blocks = 0;
    if (grid_blocks == 0) {
        if (n_in != 28 || in_sizes[0] != T * DM || out_size != T * DM || ws_size < WS_END) {
            fprintf(stderr, "kernel_launch: shape/workspace mismatch: n_in %d in0 %d out %d ws %zu (need %zu)\n", n_in, n_in > 0 ? in_sizes[0] : -1, out_size, ws_size, (size_t)WS_END); grid_blocks = -1; return; }
        int dev = 0, cus = 0, per_cu = 0;
        hipGetDevice(&dev); hipDeviceGetAttribute(&cus, hipDeviceAttributeMultiprocessorCount, dev);
        if (hipFuncSetAttribute((const void*)mega, hipFuncAttributeMaxDynamicSharedMemorySize, LDS_BYTES) != hipSuccess) { fprintf(stderr, "kernel_launch: hipFuncSetAttribute failed\n"); grid_blocks = -1; return; }
        if (hipOccupancyMaxActiveBlocksPerMultiprocessor(&per_cu, (const void*)mega, 512, LDS_BYTES) != hipSuccess || per_cu < 1) { fprintf(stderr, "kernel_launch: occupancy query says %d\n", per_cu); per_cu = 1; }
        (void)hipGetLastError();
        grid_blocks = cus * 1;
        if (grid_blocks % 8 != 0) grid_blocks -= grid_blocks % 8;
    }
    if (grid_blocks < 0) return;
    Params p{};
    for (int i = 0; i < 28; ++i) p.in[i] = (const float*)d_in[i];
    p.out = (float*)d_out; p.ws = (unsigned char*)d_ws; p.ph_lo = 0; p.ph_hi = 17;
    void* args[] = {&p};
    hipError_t e = hipLaunchCooperativeKernel((const void*)mega, dim3(grid_blocks), dim3(512), args, LDS_BYTES, stream);
    if (e != hipSuccess) fprintf(stderr, "cooperative launch failed: %s (grid %d)\n", hipGetErrorString(e), grid_blocks);
}
```
